# Optimizing an MI355X kernel written in HIP

```python
import math
import jax, jax.numpy as jnp
from jax import lax
import numpy as np

D_MODEL = 1024
BATCH = 2
SEQ = 8192
DEPTH = 1

RET_HEADS = 4
RET_QK_DIM = 64
RET_V_DIM = 128
RET_CHUNK = 128
RET_WIDTH = RET_HEADS * RET_V_DIM
ROPE_BASE = 10000.0
SWA_HEADS = 8
SWA_KV_HEADS = 2
SWA_HEAD_DIM = 64
SWA_WINDOW = 128
SWA_WIDTH = SWA_HEADS * SWA_HEAD_DIM
MIX_WIDTH = RET_WIDTH + SWA_WIDTH
IN_SIZES = (RET_HEADS * RET_QK_DIM, RET_HEADS * RET_QK_DIM, RET_WIDTH, RET_WIDTH,
            SWA_WIDTH, SWA_KV_HEADS * SWA_HEAD_DIM, SWA_KV_HEADS * SWA_HEAD_DIM)
IN_WIDTH = sum(IN_SIZES)
REL_BUCKETS = 32
REL_MAX_DIST = 128
N_EXPERTS = 256
TOP_K = 8
N_GROUPS = 8
TOPK_GROUPS = 4
EXPERT_DIM = 256
SHARED_DIM = 256
ROUTED_SCALE = 2.5
MOE_BLOCK = 128
LN_EPS = 1e-5
GN_EPS = 1e-6
DEEPNORM_ALPHA = (2 * DEPTH) ** 0.25
DEEPNORM_BETA = (8 * DEPTH) ** -0.25

kernel_name = "hybrid_retention_swa_moe_deepnorm"


def layer_norm(x, g, b):
    x32 = x.astype(jnp.float32)
    mu = jnp.mean(x32, axis=-1, keepdims=True)
    var = jnp.mean(jnp.square(x32 - mu), axis=-1, keepdims=True)
    y = (x32 - mu) * lax.rsqrt(var + LN_EPS) * g.astype(jnp.float32) + b.astype(jnp.float32)
    return y.astype(x.dtype)


def rotary(x, pos):
    half = x.shape[-1] // 2
    inv = ROPE_BASE ** (-jnp.arange(half, dtype=jnp.float32) / half)
    ang = pos.astype(jnp.float32)[:, None] * inv[None, :]
    cos = jnp.cos(ang)[None, :, None, :]
    sin = jnp.sin(ang)[None, :, None, :]
    x32 = x.astype(jnp.float32)
    x1, x2 = x32[..., :half], x32[..., half:]
    return jnp.concatenate([x1 * cos - x2 * sin, x1 * sin + x2 * cos], axis=-1).astype(x.dtype)


def retention_chunkwise(q, k, v):
    B, S, H, dk = q.shape
    dv = v.shape[-1]
    C = RET_CHUNK
    NC = S // C
    log_gamma = jnp.log(1.0 - 2.0 ** (-5.0 - jnp.arange(H, dtype=jnp.float32)))
    qc = q.astype(jnp.float32).reshape(B, NC, C, H, dk)
    kc = k.astype(jnp.float32).reshape(B, NC, C, H, dk)
    vc = v.astype(jnp.float32).reshape(B, NC, C, H, dv)
    idx = jnp.arange(C, dtype=jnp.float32)
    diff = idx[:, None] - idx[None, :]
    intra_decay = jnp.where(diff[None] >= 0,
                            jnp.exp(jnp.maximum(diff, 0.0)[None] * log_gamma[:, None, None]), 0.0)
    zeta = jnp.exp((C - 1.0 - idx)[None, :] * log_gamma[:, None])
    xi = jnp.exp((idx + 1.0)[None, :] * log_gamma[:, None])
    chunk_decay = jnp.exp(C * log_gamma)
    scores = jnp.einsum('bnihd,bnjhd->bnhij', qc, kc) * intra_decay
    intra = jnp.einsum('bnhij,bnjhe->bnihe', scores, vc)
    kv = jnp.einsum('bnjhd,bnjhe->bnhde', kc * zeta.T[None, None, :, :, None], vc)

    def step(state, kv_n):
        return state * chunk_decay[None, :, None, None] + kv_n, state

    _, states = lax.scan(step, jnp.zeros((B, H, dk, dv), jnp.float32), jnp.moveaxis(kv, 1, 0))
    states = jnp.moveaxis(states, 0, 1)
    inter = jnp.einsum('bnihd,bnhde->bnihe', qc, states) * xi.T[None, None, :, :, None]
    return (intra + inter).reshape(B, S, H, dv)


def t5_causal_bucket(dist):
    n = jnp.maximum(dist, 0)
    max_exact = REL_BUCKETS // 2
    ratio = jnp.log(jnp.maximum(n, 1).astype(jnp.float32) / max_exact) / math.log(REL_MAX_DIST / max_exact)
    large = max_exact + (ratio * (REL_BUCKETS - max_exact)).astype(jnp.int32)
    large = jnp.minimum(large, REL_BUCKETS - 1)
    return jnp.where(n < max_exact, n, large)


def sliding_window_gqa(q, k, v, rel_bias, sinks):
    B, S, H, d = q.shape
    Hk = k.shape[2]
    G = H // Hk
    W = SWA_WINDOW
    NB = S // W
    qb = q.reshape(B, NB, W, Hk, G, d)
    kb = k.reshape(B, NB, W, Hk, d)
    vb = v.reshape(B, NB, W, Hk, d)
    pad = ((0, 0), (1, 0), (0, 0), (0, 0), (0, 0))
    kcat = jnp.concatenate([jnp.pad(kb, pad)[:, :-1], kb], axis=2)
    vcat = jnp.concatenate([jnp.pad(vb, pad)[:, :-1], vb], axis=2)
    logits = jnp.einsum('bnikgd,bnjkd->bnkgij', qb, kcat).astype(jnp.float32) * (d ** -0.5)
    i = jnp.arange(W)
    j = jnp.arange(2 * W)
    dist = i[:, None] + W - j[None, :]
    band = (dist >= 0) & (dist < W)
    first_ok = (jnp.arange(NB)[:, None] > 0) | (j[None, :] >= W)
    mask = band[None, :, :] & first_ok[:, None, :]
    bias = rel_bias.astype(jnp.float32)[t5_causal_bucket(dist)]
    bias = jnp.transpose(bias, (2, 0, 1)).reshape(Hk, G, W, 2 * W)
    logits = jnp.where(mask[None, :, None, None], logits + bias[None, None], -jnp.inf)
    sink = jnp.broadcast_to(sinks.astype(jnp.float32).reshape(Hk, G)[None, None, :, :, None, None],
                            logits.shape[:-1] + (1,))
    probs = jax.nn.softmax(jnp.concatenate([logits, sink], axis=-1), axis=-1)[..., :-1]
    out = jnp.einsum('bnkgij,bnjkd->bnikgd', probs.astype(v.dtype), vcat)
    return out.reshape(B, S, H * d)


def hybrid_mixer(h, w_in, w_out, rel_bias, sinks):
    B, S, _ = h.shape
    pos = jnp.arange(S)
    split_pts = np.cumsum(IN_SIZES)[:-1].tolist()
    q_r, k_r, v_r, g_r, q_s, k_s, v_s = jnp.split(h @ w_in, split_pts, axis=-1)
    q_r = rotary(q_r.reshape(B, S, RET_HEADS, RET_QK_DIM), pos)
    k_r = rotary(k_r.reshape(B, S, RET_HEADS, RET_QK_DIM), pos) * (RET_QK_DIM ** -0.5)
    ret = retention_chunkwise(q_r, k_r, v_r.reshape(B, S, RET_HEADS, RET_V_DIM))
    mu = jnp.mean(ret, axis=-1, keepdims=True)
    var = jnp.mean(jnp.square(ret - mu), axis=-1, keepdims=True)
    ret = ((ret - mu) * lax.rsqrt(var + GN_EPS)).reshape(B, S, RET_WIDTH).astype(h.dtype)
    ret = jax.nn.silu(g_r) * ret
    swa = sliding_window_gqa(q_s.reshape(B, S, SWA_HEADS, SWA_HEAD_DIM),
                             k_s.reshape(B, S, SWA_KV_HEADS, SWA_HEAD_DIM),
                             v_s.reshape(B, S, SWA_KV_HEADS, SWA_HEAD_DIM), rel_bias, sinks)
    return jnp.concatenate([ret, swa], axis=-1) @ w_out


def moe_ffn(h, w_router, router_bias, w_gate, w_up, w_down, ws_gate, ws_up, ws_down):
    B, S, D = h.shape
    T = B * S
    E = N_EXPERTS
    xf = h.reshape(T, D)
    scores = jax.nn.sigmoid((xf @ w_router).astype(jnp.float32))
    choice = scores + router_bias.astype(jnp.float32)
    grp_score = lax.top_k(choice.reshape(T, N_GROUPS, E // N_GROUPS), 2)[0].sum(-1)
    _, top_grp = lax.top_k(grp_score, TOPK_GROUPS)
    grp_mask = jnp.any(top_grp[:, :, None] == jnp.arange(N_GROUPS)[None, None, :], axis=1)
    masked = jnp.where(jnp.repeat(grp_mask, E // N_GROUPS, axis=1), choice, -jnp.inf)
    _, top_idx = lax.top_k(masked, TOP_K)
    top_w = jnp.take_along_axis(scores, top_idx, axis=1)
    top_w = top_w / jnp.sum(top_w, axis=-1, keepdims=True) * ROUTED_SCALE
    flat_e = top_idx.reshape(-1)
    flat_tok = jnp.repeat(jnp.arange(T, dtype=jnp.int32), TOP_K)
    flat_w = top_w.reshape(-1)
    counts = jnp.bincount(flat_e, length=E)
    padded = (counts + MOE_BLOCK - 1) // MOE_BLOCK * MOE_BLOCK
    pad_end = jnp.cumsum(padded)
    pad_start = pad_end - padded
    start = jnp.cumsum(counts) - counts
    order = jnp.argsort(flat_e)
    se = flat_e[order]
    dest = pad_start[se] + jnp.arange(T * TOP_K) - start[se]
    n_rows = T * TOP_K + E * MOE_BLOCK
    n_blocks = n_rows // MOE_BLOCK
    row_tok = jnp.full((n_rows,), T, jnp.int32).at[dest].set(flat_tok[order])
    row_w = jnp.zeros((n_rows,), jnp.float32).at[dest].set(flat_w[order])
    blk_e = jnp.minimum(jnp.searchsorted(pad_end, jnp.arange(n_blocks) * MOE_BLOCK, side='right'), E - 1)

    def expert_block(args):
        e, tok, wt = args
        xb = xf[jnp.minimum(tok, T - 1)]
        y = (jax.nn.silu(xb @ w_gate[e]) * (xb @ w_up[e])) @ w_down[e]
        return (y * wt[:, None]).astype(xf.dtype)

    y_rows = lax.map(expert_block, (blk_e, row_tok.reshape(n_blocks, MOE_BLOCK),
                                    row_w.reshape(n_blocks, MOE_BLOCK)))
    routed = jax.ops.segment_sum(y_rows.reshape(n_rows, D), row_tok, num_segments=T)
    shared = (jax.nn.silu(xf @ ws_gate) * (xf @ ws_up)) @ ws_down
    return (routed + shared).reshape(B, S, D)


def setup_inputs(seed: int = 0) -> dict:
    key = jax.random.key(seed)
    ks = jax.random.split(key, 24)
    f32 = jnp.float32

    def nrm(k, shape, scale):
        return jax.random.normal(k, shape, f32) * scale

    beta = DEEPNORM_BETA
    col_scale = jnp.concatenate([jnp.full((n,), beta if c in (2, 6) else 1.0, f32)
                                 for c, n in enumerate(IN_SIZES)])
    return {
        "x": nrm(ks[0], (BATCH, SEQ, D_MODEL), 1.0),
        "ln_in_g": 1.0 + nrm(ks[1], (D_MODEL,), 0.02),
        "ln_in_b": nrm(ks[2], (D_MODEL,), 0.02),
        "w_in": nrm(ks[3], (DEPTH, D_MODEL, IN_WIDTH), D_MODEL ** -0.5) * col_scale,
        "w_out": nrm(ks[4], (DEPTH, MIX_WIDTH, D_MODEL), MIX_WIDTH ** -0.5 * beta),
        "rel_bias": nrm(ks[5], (REL_BUCKETS, SWA_HEADS), 0.5),
        "attn_sinks": nrm(ks[6], (DEPTH, SWA_HEADS), 1.0),
        "ln_mix_g": 1.0 + nrm(ks[7], (DEPTH, D_MODEL), 0.02),
        "ln_mix_b": nrm(ks[8], (DEPTH, D_MODEL), 0.02),
        "w_router": nrm(ks[9], (DEPTH, D_MODEL, N_EXPERTS), D_MODEL ** -0.5),
        "router_bias": nrm(ks[10], (DEPTH, N_EXPERTS), 0.01),
        "w_gate": nrm(ks[11], (DEPTH, N_EXPERTS, D_MODEL, EXPERT_DIM), D_MODEL ** -0.5 * beta),
        "w_up": nrm(ks[12], (DEPTH, N_EXPERTS, D_MODEL, EXPERT_DIM), D_MODEL ** -0.5 * beta),
        "w_down": nrm(ks[13], (DEPTH, N_EXPERTS, EXPERT_DIM, D_MODEL), EXPERT_DIM ** -0.5 * beta),
        "ws_gate": nrm(ks[14], (DEPTH, D_MODEL, SHARED_DIM), D_MODEL ** -0.5 * beta),
        "ws_up": nrm(ks[15], (DEPTH, D_MODEL, SHARED_DIM), D_MODEL ** -0.5 * beta),
        "ws_down": nrm(ks[16], (DEPTH, SHARED_DIM, D_MODEL), SHARED_DIM ** -0.5 * beta),
        "ln_ffn_g": 1.0 + nrm(ks[17], (DEPTH, D_MODEL), 0.02),
        "ln_ffn_b": nrm(ks[18], (DEPTH, D_MODEL), 0.02),
    }


def reference(x, ln_in_g, ln_in_b, w_in, w_out, rel_bias, attn_sinks, ln_mix_g, ln_mix_b,
              w_router, router_bias, w_gate, w_up, w_down, ws_gate, ws_up, ws_down,
              ln_ffn_g, ln_ffn_b):
    h = layer_norm(x, ln_in_g, ln_in_b)
    for l in range(DEPTH):
        mix = hybrid_mixer(h, w_in[l], w_out[l], rel_bias, attn_sinks[l])
        h = layer_norm(DEEPNORM_ALPHA * h + mix, ln_mix_g[l], ln_mix_b[l])
        ffn = moe_ffn(h, w_router[l], router_bias[l], w_gate[l], w_up[l], w_down[l],
                      ws_gate[l], ws_up[l], ws_down[l])
        h = layer_norm(DEEPNORM_ALPHA * h + ffn, ln_ffn_g[l], ln_ffn_b[l])
    return h
```

```cpp
#include <hip/hip_runtime.h>
#include <cstdio>
#include <cstdint>

#ifndef MK_N_LAUNCHES
#define MK_N_LAUNCHES 1
#endif

#define LAS __attribute__((address_space(3)))
typedef unsigned short bf16;
typedef short bf16x8 __attribute__((ext_vector_type(8)));
typedef short s16x4 __attribute__((ext_vector_type(4)));
typedef float f32x4 __attribute__((ext_vector_type(4)));
typedef float f32x2 __attribute__((ext_vector_type(2)));
typedef unsigned u32x4 __attribute__((ext_vector_type(4)));
typedef unsigned u32x2 __attribute__((ext_vector_type(2)));
typedef __bf16 bf2_t __attribute__((ext_vector_type(2)));

constexpr int T_TOK = 16384, SEQ = 8192, DM = 1024, INW = 2304, NEXP = 256;
constexpr int NPHASE = 9;
constexpr float ALPHA = 1.189207115002721f;
constexpr int LCAP = 16384;

constexpr size_t MiB = 1u << 20;
constexpr size_t WS_CTL = 0, CTL_BYTES = 1 * MiB;
constexpr size_t WS_COS = 1 * MiB, WS_SIN = 2 * MiB;
constexpr size_t WS_H0B = 4 * MiB;
constexpr size_t WS_PROJ = 36 * MiB;
constexpr size_t WS_MIXIN = 108 * MiB;
constexpr size_t WS_PRE1 = 140 * MiB;
constexpr size_t WS_H1B = 204 * MiB;
constexpr size_t WS_KVT = 236 * MiB;
constexpr size_t WS_STATE = 252 * MiB;
constexpr size_t WS_LISTS = 260 * MiB;
constexpr size_t WS_ROWW = 276 * MiB;
constexpr size_t WS_YROWS = 280 * MiB;
constexpr size_t WS_WIMG = 576 * MiB;
constexpr int WIMG_IN = 0, WIMG_OUT = 144, WIMG_RT = 208, WIMG_N = 224;
constexpr size_t WS_WT_IN = 620 * MiB;
constexpr size_t WS_WT_OUT = 624 * MiB;
constexpr size_t WS_LIST2 = 584 * MiB;
constexpr size_t WS_END = 626 * MiB;
constexpr int CW_BAR = 4096;
constexpr int CW_CNT = 16384;

constexpr int L_BS0 = 0, L_AS0 = 65536, L_ACTLO = 114688, L_TAB = 147456, LDS_BYTES = 163840;
constexpr int TB_MISC = 0;
constexpr int TB_RTOK = 256;
constexpr int TB_RYROW = 768;
constexpr int TB_RW = 1280;
constexpr int TB_PREFIX = 2048;
constexpr int TB_HIST = 4096;
constexpr int TB_BASE = 5120;
constexpr int TB_SEL = 6144;
constexpr int TB_SELW = 10496;
constexpr int TB_CNT = 12544;
constexpr int TB_UNIT = 10240;

__device__ __forceinline__ unsigned pk2(float lo, float hi) { f32x2 v = {lo, hi}; bf2_t r = __builtin_convertvector(v, bf2_t); return __builtin_bit_cast(unsigned, r); }
__device__ __forceinline__ float bflo(unsigned u) { return __uint_as_float(u << 16); }
__device__ __forceinline__ float bfhi(unsigned u) { return __uint_as_float(u & 0xffff0000u); }
__device__ __forceinline__ float wave_sum(float v) {
#pragma unroll
    for (int o = 1; o < 64; o <<= 1) v += __shfl_xor(v, o);
    return v;
}
#define VM_WAIT() asm volatile("s_waitcnt vmcnt(0)" ::: "memory")
#define ALL_WAIT() asm volatile("s_waitcnt vmcnt(0) lgkmcnt(0)" ::: "memory")
#define BLOCK_SYNC() do { ALL_WAIT(); __syncthreads(); } while (0)

#define XB_TMO      128
#define XB_XCNT(j)  (256  + 64 * (j))
#define XB_XSUB(j)  (1280 + 64 * (j))
#define XB_XGEN(j)  (2304 + 64 * (j))
#define XB_TOP      3328
#define XB_TOPGEN   3392
#define XCD_BAR_WORDS 3456
#define XB_SPIN_CAP (1u << 18)
__device__ __forceinline__ unsigned xb_ld(unsigned* p)              { return __hip_atomic_load(p, __ATOMIC_RELAXED, __HIP_MEMORY_SCOPE_AGENT); }
__device__ __forceinline__ unsigned xb_add(unsigned* p, unsigned v) { return __hip_atomic_fetch_add(p, v, __ATOMIC_RELAXED, __HIP_MEMORY_SCOPE_AGENT); }
__device__ __forceinline__ unsigned xb_xcc_id() { return (unsigned)__builtin_amdgcn_s_getreg((3 << 11) | 20) & 0xFu; }
#define XB_SPIN(cond, bar) do { unsigned _sp = 0; while (cond) { __builtin_amdgcn_s_sleep(1); \
    if ((++_sp & 255u) == 0u) { if (xb_ld(&(bar)[XB_TMO])) break; if (_sp > XB_SPIN_CAP) { atomicAdd(&(bar)[XB_TMO], 1u); break; } } } } while (0)
struct XcdBarrier { unsigned* bar; unsigned x; volatile LAS unsigned* st; };
__device__ __forceinline__ XcdBarrier xcd_barrier_post(unsigned* bar, volatile LAS unsigned* st) {
    XcdBarrier b; b.bar = bar; b.x = xb_xcc_id(); b.st = st;
    if (threadIdx.x == 0) (void)xb_add(&bar[XB_XCNT(b.x)], 1u);
    return b;
}
__device__ __forceinline__ void xcd_barrier_complete(unsigned* bar, unsigned x, unsigned& nloc, unsigned& nx) {
    const unsigned G = gridDim.x * gridDim.y * gridDim.z;
    unsigned sum, cnt, mine, sp = 0u;
    for (;;) {
        sum = 0u; cnt = 0u; mine = 0u;
#pragma unroll
        for (unsigned j = 0; j < 16; ++j) { const unsigned c = xb_ld(&bar[XB_XCNT(j)]); sum += c; cnt += (c > 0u) ? 1u : 0u; mine = (j == x) ? c : mine; }
        if (sum == G) break;
        __builtin_amdgcn_s_sleep(1);
        if ((++sp & 255u) == 0u) { if (xb_ld(&bar[XB_TMO])) break; if (sp > XB_SPIN_CAP) { atomicAdd(&bar[XB_TMO], 1u); break; } }
    }
    nloc = mine > 0u ? mine : 1u; nx = cnt > 0u ? cnt : 1u;
}
__device__ __forceinline__ void xcd_barrier(const XcdBarrier& b) {
    asm volatile("s_waitcnt vmcnt(0)" ::: "memory");
    __syncthreads();
    if (threadIdx.x == 0) {
        unsigned* bar = b.bar;
        __builtin_amdgcn_s_waitcnt(0);
        unsigned nloc = b.st[0], nx = b.st[1];
        if (nloc == 0u) { xcd_barrier_complete(bar, b.x, nloc, nx); b.st[0] = nloc; b.st[1] = nx; }
        const unsigned old = xb_add(&bar[XB_XSUB(b.x)], 1u);
        const unsigned gen = old / nloc;
        if (old + 1u == (gen + 1u) * nloc) {
            __builtin_amdgcn_fence(__ATOMIC_RELEASE, "agent");
            asm volatile("s_waitcnt vmcnt(0)" ::: "memory");
            const unsigned og = xb_add(&bar[XB_TOP], 1u);
            const unsigned tg = og / nx;
            if (og + 1u == (tg + 1u) * nx) xb_add(&bar[XB_TOPGEN], 1u);
            else XB_SPIN(xb_ld(&bar[XB_TOPGEN]) == tg, bar);
            __builtin_amdgcn_fence(__ATOMIC_ACQUIRE, "agent");
            xb_add(&bar[XB_XGEN(b.x)], 1u);
            asm volatile("s_waitcnt vmcnt(0)" ::: "memory");
        } else {
            XB_SPIN(xb_ld(&bar[XB_XGEN(b.x)]) == gen, bar);
            __builtin_amdgcn_fence(__ATOMIC_ACQUIRE, "agent");
            asm volatile("s_waitcnt vmcnt(0)" ::: "memory");
        }
    }
    __syncthreads();
}


namespace pg8 {
#define PG8_LAS __attribute__((address_space(3)))
typedef unsigned short bf16_t;
constexpr int BM = 256, BK = 64, HALF = 128, HTB = HALF * BK * 2;
__host__ __device__ __forceinline__ int lds_byte(int r, int c) { const int st = (r >> 4) * 2 + (c >> 5), rr = r & 15, cc = c & 31, ob = rr * 64 + cc * 2; return st * 1024 + (ob ^ (((ob >> 9) & 1) << 5)); }
__host__ __device__ __forceinline__ void stage_rc(int b, int& R, int& C) { const int st = b / 1024, sb = b % 1024, swz = sb ^ (((sb >> 9) & 1) << 5); R = (st >> 1) * 16 + swz / 64; C = (st & 1) * 32 + (swz % 64) / 2; }
struct Unit { int pm, pn; };
struct Gemm { const bf16_t* A; const bf16_t* Bt; int K; };
template <class Epi, class Sched>
__device__ __forceinline__ void gemm_phase(PG8_LAS unsigned char* lds, const Gemm g, const Sched& S, const Epi& E) {
    const int tid = threadIdx.x, wid = __builtin_amdgcn_readfirstlane(tid >> 6), lane = tid & 63, wr = wid >> 2, wc = wid & 3, fr = lane & 15, fq = lane >> 4;
    const int K = g.K, nt = K / BK;
    unsigned voffA[2], voffB[2];
#pragma unroll
    for (int i = 0; i < 2; ++i) { int R, C; stage_rc(tid * 16 + i * 8192, R, C); voffA[i] = (unsigned)(R * K + C) * 2u; voffB[i] = (unsigned)(R * K + C) * 2u; }
    const size_t kstep = (size_t)(BK * 2);
    const size_t hstep = (size_t)HALF * K * 2;
    const size_t tstep = 2 * hstep;
    const unsigned ldsw = (unsigned)wid * 1024u;
    const int aoff = lds_byte(wr * 64 + fr, fq * 8), boff = lds_byte(wc * 32 + fr, fq * 8);
#define PG8_SA(b, h) (((b) * 2 + (h)) * HTB)
#define PG8_SB(b, h) ((4 + (b) * 2 + (h)) * HTB)
#define PG8_STAGE(bufoff, gbase, voff) do { _Pragma("unroll") for (int _i = 0; _i < 2; ++_i) \
        __builtin_amdgcn_global_load_lds((const unsigned*)((const char*)(gbase) + (voff)[_i]), (PG8_LAS unsigned*)(lds + (bufoff) + ldsw + _i * 8192), 16, 0, 0); } while (0)
#define PG8_LDA(dst, b, h) do { _Pragma("unroll") for (int m = 0; m < 4; ++m) _Pragma("unroll") for (int k = 0; k < 2; ++k) dst[m][k] = *(const PG8_LAS bf16x8*)(lds + PG8_SA(b, h) + aoff + m * 2048 + k * 1024); } while (0)
#define PG8_LDB(dst, b, h) do { _Pragma("unroll") for (int n = 0; n < 2; ++n) _Pragma("unroll") for (int k = 0; k < 2; ++k) dst[n][k] = *(const PG8_LAS bf16x8*)(lds + PG8_SB(b, h) + boff + n * 2048 + k * 1024); } while (0)
#define PG8_MMA(ai, bj, At, Bt) do { __builtin_amdgcn_s_setprio(1); _Pragma("unroll") for (int m = 0; m < 4; ++m) _Pragma("unroll") for (int n = 0; n < 2; ++n) _Pragma("unroll") for (int k = 0; k < 2; ++k) \
        acc[ai][bj][m][n] = __builtin_amdgcn_mfma_f32_16x16x32_bf16(Bt[n][k], At[m][k], acc[ai][bj][m][n], 0, 0, 0); __builtin_amdgcn_s_setprio(0); } while (0)
#define PG8_WAIT_V(n) asm volatile("s_waitcnt vmcnt(" #n ")" ::: "memory")
#define PG8_WAIT_L(n) asm volatile("s_waitcnt lgkmcnt(" #n ")" ::: "memory")
#define PG8_BAR __builtin_amdgcn_s_barrier()
#define PG8_SCHED __builtin_amdgcn_sched_barrier(0)
    Unit cur, nxt; int ui = 0;
    if (!S.next(0, cur)) return;
    f32x4 acc[2][2][4][2];
#pragma unroll
    for (int a = 0; a < 2; ++a)
#pragma unroll
        for (int b = 0; b < 2; ++b)
#pragma unroll
            for (int m = 0; m < 4; ++m)
#pragma unroll
                for (int n = 0; n < 2; ++n) acc[a][b][m][n] = (f32x4){0.f, 0.f, 0.f, 0.f};
    bf16x8 At[4][2], B0[2][2], B1[2][2];
    const char* cA = (const char*)g.A + (size_t)cur.pm * tstep; const char* cB = (const char*)g.Bt + (size_t)cur.pn * tstep;
    PG8_STAGE(PG8_SB(0, 0), cB, voffB); PG8_STAGE(PG8_SA(0, 0), cA, voffA); PG8_STAGE(PG8_SB(0, 1), cB + hstep, voffB); PG8_STAGE(PG8_SA(0, 1), cA + hstep, voffA);
    if (wr == 1) PG8_BAR;
    PG8_WAIT_V(4); PG8_BAR;
    PG8_STAGE(PG8_SB(1, 0), cB + kstep, voffB); PG8_STAGE(PG8_SA(1, 0), cA + kstep, voffA); PG8_STAGE(PG8_SB(1, 1), cB + hstep + kstep, voffB);
    PG8_WAIT_V(6); PG8_BAR;
    for (;;) {
        const bool has_next = S.next(ui + 1, nxt);
        const char* nA = has_next ? (const char*)g.A + (size_t)nxt.pm * tstep : cA; const char* nB = has_next ? (const char*)g.Bt + (size_t)nxt.pn * tstep : cB;
        for (int t = 0; t < nt; t += 2) {
            const bool last = (t == nt - 2);
            const char* a1 = cA + (size_t)(t + 1) * kstep;
            const char* a2 = last ? nA : cA + (size_t)(t + 2) * kstep; const char* b2 = last ? nB : cB + (size_t)(t + 2) * kstep;
            const char* a3 = a2 + kstep; const char* b3 = b2 + kstep;
            PG8_LDB(B0, 0, 0); PG8_SCHED; PG8_LDA(At, 0, 0); PG8_STAGE(PG8_SA(1, 1), a1 + hstep, voffA);
            PG8_WAIT_L(8); PG8_BAR; PG8_WAIT_L(0); PG8_MMA(0, 0, At, B0); PG8_BAR; PG8_SCHED;
            PG8_LDB(B1, 0, 1); PG8_STAGE(PG8_SB(0, 0), b2, voffB);
            PG8_BAR; PG8_WAIT_L(0); PG8_MMA(0, 1, At, B1); PG8_BAR;
            PG8_LDA(At, 0, 1); PG8_STAGE(PG8_SA(0, 0), a2, voffA);
            PG8_BAR; PG8_WAIT_L(0); PG8_MMA(1, 0, At, B0); PG8_BAR; PG8_SCHED;
            PG8_STAGE(PG8_SB(0, 1), b2 + hstep, voffB);
            PG8_WAIT_V(6); PG8_BAR; PG8_MMA(1, 1, At, B1); PG8_BAR;
            PG8_LDB(B0, 1, 0); PG8_SCHED; PG8_LDA(At, 1, 0); PG8_STAGE(PG8_SA(0, 1), a2 + hstep, voffA);
            PG8_WAIT_L(8); PG8_BAR; PG8_WAIT_L(0); PG8_MMA(0, 0, At, B0); PG8_BAR; PG8_SCHED;
            PG8_LDB(B1, 1, 1); PG8_STAGE(PG8_SB(1, 0), b3, voffB);
            PG8_BAR; PG8_WAIT_L(0); PG8_MMA(0, 1, At, B1); PG8_BAR;
            PG8_LDA(At, 1, 1); PG8_STAGE(PG8_SA(1, 0), a3, voffA);
            PG8_BAR; PG8_WAIT_L(0); PG8_MMA(1, 0, At, B0); PG8_BAR; PG8_SCHED;
            PG8_STAGE(PG8_SB(1, 1), b3 + hstep, voffB);
            PG8_WAIT_V(6); PG8_BAR; PG8_MMA(1, 1, At, B1); PG8_BAR;
        }
            E(acc, cur, wr, wc, fr, fq);
            if (!has_next) break;
#pragma unroll
        for (int a = 0; a < 2; ++a)
#pragma unroll
            for (int b = 0; b < 2; ++b)
#pragma unroll
                for (int m = 0; m < 4; ++m)
#pragma unroll
                    for (int n = 0; n < 2; ++n) acc[a][b][m][n] = (f32x4){0.f, 0.f, 0.f, 0.f};
        cur = nxt; cA = nA; cB = nB; ++ui;
    }
    PG8_WAIT_V(0);
    if (wr == 0) PG8_BAR;
    PG8_BAR;
#undef PG8_SA
#undef PG8_SB
#undef PG8_STAGE
#undef PG8_LDA
#undef PG8_LDB
#undef PG8_MMA
#undef PG8_WAIT_V
#undef PG8_WAIT_L
#undef PG8_BAR
#undef PG8_SCHED
}
}

struct Args {
    const float* in[19];
    float* out;
    unsigned char* ws;
    int ph_lo, ph_hi;
};
struct Frame {
    LAS unsigned char* lds;
    int tid, lane, wave, vcu, G;
    unsigned char* ws;
};

template <int MT, int KH0 = 0, int KH1 = 2>
__device__ __forceinline__ void mma_ktile(f32x4 (&acc)[MT][4], LAS const unsigned char* As, LAS const unsigned char* Bs, const unsigned (&foa)[2], const unsigned (&fob)[2][2]) {
#pragma unroll
    for (int kh = KH0; kh < KH1; ++kh) {
        bf16x8 af[MT], bfr[4];
#pragma unroll
        for (int m = 0; m < MT; ++m) af[m] = *(LAS const bf16x8*)(As + m * 2048 + foa[kh]);
#pragma unroll
        for (int n = 0; n < 4; ++n) bfr[n] = *(LAS const bf16x8*)(Bs + n * 2048 + fob[kh][n & 1]);
#pragma unroll
        for (int m = 0; m < MT; ++m)
#pragma unroll
            for (int n = 0; n < 4; ++n)
                acc[m][n] = __builtin_amdgcn_mfma_f32_16x16x32_bf16(bfr[n], af[m], acc[m][n], 0, 0, 0);
    }
}
__device__ __forceinline__ void loadB32(f32x4 (&r)[8], const float* p, size_t ldb) {
#pragma unroll
    for (int i = 0; i < 8; ++i) { r[i] = *(const f32x4*)p; p += ldb; }
}
__device__ __forceinline__ void storeB32(const f32x4 (&r)[8], LAS unsigned char* Bs, int n0, int c) {
#pragma unroll
    for (int j = 0; j < 4; ++j) {
        u32x4 w; w.x = pk2(r[0][j], r[1][j]); w.y = pk2(r[2][j], r[3][j]); w.z = pk2(r[4][j], r[5][j]); w.w = pk2(r[6][j], r[7][j]);
        const int n = n0 + j, x = (n >> 3) & 3, g = ((x & 1) << 1) | (x >> 1);
        *(LAS u32x4*)(Bs + n * 128 + ((c ^ (n & 7) ^ g) << 4)) = w;
    }
}
template <int MT>
__device__ __forceinline__ void dmaA(LAS unsigned char* As, const bf16* p0, const bf16* p1, int wave) {
    __builtin_amdgcn_global_load_lds((const unsigned*)p0, (LAS unsigned*)(As + wave * 1024), 16, 0, 0);
    if (MT == 4) __builtin_amdgcn_global_load_lds((const unsigned*)p1, (LAS unsigned*)(As + wave * 1024 + 8192), 16, 0, 0);
}
#define LGKM_BAR() do { asm volatile("s_waitcnt lgkmcnt(0)" ::: "memory"); __builtin_amdgcn_s_barrier(); asm volatile("" ::: "memory"); } while (0)
template <bool A_LDS>
__device__ __forceinline__ int a_tile_off(int t) { return A_LDS ? ((t < 2) ? L_ACTLO + t * 16384 : L_AS0 + (t - 2) * 16384) : L_AS0 + (t % 3) * 16384; }
template <bool A_LDS, int MT = 4>
__device__ __forceinline__ void gemm_loop(f32x4 (&acc)[MT][4], const Frame& F, const bf16* ap0, const bf16* ap1, const float* bp, size_t ldb, int nk, int rot = 0) {
    LAS unsigned char* lds = F.lds;
    const int lane = F.lane, wave = F.wave, wr = wave >> 2, wc = wave & 3, fr = lane & 15, fq = lane >> 4;
    unsigned foa[2], fob[2][2];
#pragma unroll
    for (int kh = 0; kh < 2; ++kh) {
        foa[kh] = (unsigned)(fr * 128 + ((((4 * kh + fq)) ^ (fr & 7)) << 4));
#pragma unroll
        for (int par = 0; par < 2; ++par) fob[kh][par] = (unsigned)(fr * 128 + (((4 * kh + fq) ^ (fr & 7) ^ ((fr >> 3) << 1) ^ par) << 4));
    }
    const int n0 = 4 * lane;
    const float* bpp = bp + (size_t)(8 * wave) * ldb;
    const size_t tstep = 64 * ldb;
    f32x4 r0[8], r1[8];
#define WAITV(more) do { if (more) { if (A_LDS) asm volatile("s_waitcnt vmcnt(8)" ::: "memory"); else if (MT == 4) asm volatile("s_waitcnt vmcnt(10)" ::: "memory"); else asm volatile("s_waitcnt vmcnt(9)" ::: "memory"); } else asm volatile("s_waitcnt vmcnt(0)" ::: "memory"); } while (0)
#define KT(t) (((t) ^ rot) & (nk - 1))
#define ENDWAIT(nb, na) do { if (nb) { if (A_LDS) asm volatile("s_waitcnt vmcnt(8)" ::: "memory"); else if (MT == 4) asm volatile("s_waitcnt vmcnt(10)" ::: "memory"); else asm volatile("s_waitcnt vmcnt(9)" ::: "memory"); } \
                             else if ((na) && !A_LDS) { if (MT == 4) asm volatile("s_waitcnt vmcnt(2)" ::: "memory"); else asm volatile("s_waitcnt vmcnt(1)" ::: "memory"); } \
                             else asm volatile("s_waitcnt vmcnt(0)" ::: "memory"); } while (0)
    loadB32(r0, bpp + (size_t)KT(0) * tstep, ldb);
    if (!A_LDS) dmaA<MT>(lds + L_AS0, ap0 + KT(0) * 64, ap1 + KT(0) * 64, wave);
    if (nk > 1) { loadB32(r1, bpp + (size_t)KT(1) * tstep, ldb); if (!A_LDS) dmaA<MT>(lds + L_AS0 + 16384, ap0 + KT(1) * 64, ap1 + KT(1) * 64, wave); }
    __builtin_amdgcn_sched_barrier(0);
    WAITV(nk > 1);
    storeB32(r0, lds + L_BS0, n0, wave);
    if (nk > 2) loadB32(r0, bpp + (size_t)KT(2) * tstep, ldb);
    __builtin_amdgcn_sched_barrier(0);
    if (nk > 2) { asm volatile("s_waitcnt vmcnt(8)" ::: "memory"); } else asm volatile("s_waitcnt vmcnt(0)" ::: "memory");
    LGKM_BAR();
    for (int t = 0; t < nk; t += 2) {
        if (t + 1 < nk) storeB32(r1, lds + L_BS0 + 32768, n0, wave);
        if (t + 3 < nk) loadB32(r1, bpp + (size_t)KT(t + 3) * tstep, ldb);
        __builtin_amdgcn_sched_barrier(0);
        mma_ktile<MT, 0, 1>(acc, lds + (A_LDS ? a_tile_off<true>(KT(t)) : a_tile_off<false>(t)) + wr * (MT * 2048), lds + L_BS0 + wc * 8192, foa, fob);
        __builtin_amdgcn_sched_barrier(0);
        if (t + 2 < nk) { if (!A_LDS) dmaA<MT>(lds + a_tile_off<false>(t + 2), ap0 + KT(t + 2) * 64, ap1 + KT(t + 2) * 64, wave); }
        __builtin_amdgcn_sched_barrier(0);
        mma_ktile<MT, 1, 2>(acc, lds + (A_LDS ? a_tile_off<true>(KT(t)) : a_tile_off<false>(t)) + wr * (MT * 2048), lds + L_BS0 + wc * 8192, foa, fob);
        __builtin_amdgcn_sched_barrier(0);
        ENDWAIT(t + 3 < nk, t + 2 < nk);
        LGKM_BAR();
        if (t + 1 >= nk) break;
        if (t + 2 < nk) storeB32(r0, lds + L_BS0, n0, wave);
        if (t + 4 < nk) loadB32(r0, bpp + (size_t)KT(t + 4) * tstep, ldb);
        __builtin_amdgcn_sched_barrier(0);
        mma_ktile<MT, 0, 1>(acc, lds + (A_LDS ? a_tile_off<true>(KT(t + 1)) : a_tile_off<false>(t + 1)) + wr * (MT * 2048), lds + L_BS0 + 32768 + wc * 8192, foa, fob);
        __builtin_amdgcn_sched_barrier(0);
        if (t + 3 < nk) { if (!A_LDS) dmaA<MT>(lds + a_tile_off<false>(t + 3), ap0 + KT(t + 3) * 64, ap1 + KT(t + 3) * 64, wave); }
        __builtin_amdgcn_sched_barrier(0);
        mma_ktile<MT, 1, 2>(acc, lds + (A_LDS ? a_tile_off<true>(KT(t + 1)) : a_tile_off<false>(t + 1)) + wr * (MT * 2048), lds + L_BS0 + 32768 + wc * 8192, foa, fob);
        __builtin_amdgcn_sched_barrier(0);
        ENDWAIT(t + 4 < nk, t + 3 < nk);
        LGKM_BAR();
    }
#undef ENDWAIT
#undef WAITV
#undef KT
}
template <int OFF>
__device__ __forceinline__ void gld16(f32x4& d, const float* p) { asm volatile("global_load_dwordx4 %0, %1, off offset:%2" : "=&v"(d) : "v"(p), "n"(OFF) : "memory"); }
template <int LDB>
__device__ __forceinline__ void loadB32a(f32x4 (&r)[8], const float* p) {
    if (LDB == 256) {
        const float* q = p + 4 * LDB;
        gld16<-4096>(r[0], q); gld16<-3072>(r[1], q); gld16<-2048>(r[2], q); gld16<-1024>(r[3], q); gld16<0>(r[4], q); gld16<1024>(r[5], q); gld16<2048>(r[6], q); gld16<3072>(r[7], q);
    } else {
        const float* q0 = p + LDB; const float* q1 = p + 3 * LDB; const float* q2 = p + 5 * LDB; const float* q3 = p + 7 * LDB;
        gld16<-4096>(r[0], q0); gld16<0>(r[1], q0); gld16<-4096>(r[2], q1); gld16<0>(r[3], q1); gld16<-4096>(r[4], q2); gld16<0>(r[5], q2); gld16<-4096>(r[6], q3); gld16<0>(r[7], q3);
    }
}
#define TIE8(r) "+v"(r[0]), "+v"(r[1]), "+v"(r[2]), "+v"(r[3]), "+v"(r[4]), "+v"(r[5]), "+v"(r[6]), "+v"(r[7])
template <bool A_LDS, int NK, int LDB>
__device__ __forceinline__ void gemm_loopa(f32x4 (&acc)[4][4], const Frame& F, const bf16* ap0, const bf16* ap1, const float* bp, int rot) {
    static_assert(LDB == 256 || LDB == 1024, "row pitch of the f32 B source");
    constexpr int MT = 4;
    LAS unsigned char* lds = F.lds;
    const int lane = F.lane, wave = F.wave, wr = wave >> 2, wc = wave & 3, fr = lane & 15, fq = lane >> 4;
    unsigned foa[2], fob[2][2];
#pragma unroll
    for (int kh = 0; kh < 2; ++kh) {
        foa[kh] = (unsigned)(fr * 128 + ((((4 * kh + fq)) ^ (fr & 7)) << 4));
#pragma unroll
        for (int par = 0; par < 2; ++par) fob[kh][par] = (unsigned)(fr * 128 + (((4 * kh + fq) ^ (fr & 7) ^ ((fr >> 3) << 1) ^ par) << 4));
    }
    const int n0 = 4 * lane;
    const float* bpp = bp + (size_t)(8 * wave) * LDB;
    constexpr size_t tstep = (size_t)64 * LDB;
    f32x4 r0[8], r1[8];
#define KT(t) (((t) ^ rot) & (NK - 1))
#define XWAIT(nb, na, RS) do { if (nb) { if (A_LDS) asm volatile("s_waitcnt vmcnt(8)" : TIE8(RS) :: "memory"); else asm volatile("s_waitcnt vmcnt(10)" : TIE8(RS) :: "memory"); } \
                               else if ((na) && !A_LDS) asm volatile("s_waitcnt vmcnt(2)" : TIE8(RS) :: "memory"); \
                               else asm volatile("s_waitcnt vmcnt(0)" : TIE8(RS) :: "memory"); } while (0)
#define X_ATILE(t) (lds + (A_LDS ? a_tile_off<true>(KT(t)) : a_tile_off<false>(t)) + wr * (MT * 2048))
#define X_EVEN(t, H1, H2, H3) do { \
        if (H1) storeB32(r1, lds + L_BS0 + 32768, n0, wave); \
        if (H3) loadB32a<LDB>(r1, bpp + (size_t)KT((t) + 3) * tstep); \
        __builtin_amdgcn_sched_barrier(0); \
        mma_ktile<MT, 0, 1>(acc, X_ATILE(t), lds + L_BS0 + wc * 8192, foa, fob); \
        __builtin_amdgcn_sched_barrier(0); \
        if ((H2) && !A_LDS) dmaA<MT>(lds + a_tile_off<false>((t) + 2), ap0 + KT((t) + 2) * 64, ap1 + KT((t) + 2) * 64, wave); \
        __builtin_amdgcn_sched_barrier(0); \
        mma_ktile<MT, 1, 2>(acc, X_ATILE(t), lds + L_BS0 + wc * 8192, foa, fob); \
        __builtin_amdgcn_sched_barrier(0); \
        XWAIT(H3, H2, r0); \
        LGKM_BAR(); } while (0)
#define X_ODD(t, H2, H3, H4) do { \
        if (H2) storeB32(r0, lds + L_BS0, n0, wave); \
        if (H4) loadB32a<LDB>(r0, bpp + (size_t)KT((t) + 4) * tstep); \
        __builtin_amdgcn_sched_barrier(0); \
        mma_ktile<MT, 0, 1>(acc, X_ATILE((t) + 1), lds + L_BS0 + 32768 + wc * 8192, foa, fob); \
        __builtin_amdgcn_sched_barrier(0); \
        if ((H3) && !A_LDS) dmaA<MT>(lds + a_tile_off<false>((t) + 3), ap0 + KT((t) + 3) * 64, ap1 + KT((t) + 3) * 64, wave); \
        __builtin_amdgcn_sched_barrier(0); \
        mma_ktile<MT, 1, 2>(acc, X_ATILE((t) + 1), lds + L_BS0 + 32768 + wc * 8192, foa, fob); \
        __builtin_amdgcn_sched_barrier(0); \
        XWAIT(H4, H3, r1); \
        LGKM_BAR(); } while (0)
    loadB32a<LDB>(r0, bpp + (size_t)KT(0) * tstep);
    if (!A_LDS) dmaA<MT>(lds + L_AS0, ap0 + KT(0) * 64, ap1 + KT(0) * 64, wave);
    loadB32a<LDB>(r1, bpp + (size_t)KT(1) * tstep);
    if (!A_LDS) dmaA<MT>(lds + L_AS0 + 16384, ap0 + KT(1) * 64, ap1 + KT(1) * 64, wave);
    __builtin_amdgcn_sched_barrier(0);
    if (A_LDS) asm volatile("s_waitcnt vmcnt(8)" : TIE8(r0) :: "memory"); else asm volatile("s_waitcnt vmcnt(10)" : TIE8(r0) :: "memory");
    storeB32(r0, lds + L_BS0, n0, wave);
    loadB32a<LDB>(r0, bpp + (size_t)KT(2) * tstep);
    __builtin_amdgcn_sched_barrier(0);
    asm volatile("s_waitcnt vmcnt(8)" : TIE8(r1) :: "memory");
    LGKM_BAR();
    constexpr int T0 = (NK > 4) ? ((NK - 3) / 2) * 2 : 0;
#pragma unroll 1
    for (int t = 0; t < T0; t += 2) { X_EVEN(t, true, true, true); X_ODD(t, true, true, true); }
#pragma unroll
    for (int t = T0; t < NK; t += 2) { X_EVEN(t, t + 1 < NK, t + 2 < NK, t + 3 < NK); X_ODD(t, t + 2 < NK, t + 3 < NK, t + 4 < NK); }
#undef X_EVEN
#undef X_ODD
#undef X_ATILE
#undef XWAIT
#undef KT
}
__device__ __forceinline__ int swz4(int row) { return (0x78 >> (2 * ((row >> 2) & 3))) & 3; }
template <int MT>
__device__ __forceinline__ void gemm_ring(f32x4 (&acc)[MT][4], const Frame& F, const bf16* abase, const unsigned (&aoff)[2], const bf16* bblk, int nst) {
    LAS unsigned char* lds = F.lds;
    const int tid = F.tid, lane = F.lane, wave = F.wave, wr = wave >> 2, wc = wave & 3, fr = lane & 15, fq = lane >> 4;
    const unsigned fo = (unsigned)(fr * 64 + ((fq ^ swz4(fr)) << 4));
    const unsigned boff = (unsigned)(tid * 16);
    const bool a_wave = (MT != 2) || (wave < 4);
#define RG_STAGE(t) do { const int sl_ = ((t) & 3) * 32768; \
        _Pragma("unroll") for (int i = 0; i < 2; ++i) __builtin_amdgcn_global_load_lds((const unsigned*)((const char*)bblk + (size_t)(t) * 16384 + boff + i * 8192), (LAS unsigned*)(lds + sl_ + 16384 + wave * 1024 + i * 8192), 16, 0, 0); \
        if (MT == 8) { _Pragma("unroll") for (int i = 0; i < 2; ++i) __builtin_amdgcn_global_load_lds((const unsigned*)((const char*)abase + (size_t)(t) * 64 + aoff[i]), (LAS unsigned*)(lds + sl_ + wave * 1024 + i * 8192), 16, 0, 0); } \
        else if (a_wave) __builtin_amdgcn_global_load_lds((const unsigned*)((const char*)abase + (size_t)(t) * 64 + aoff[0]), (LAS unsigned*)(lds + sl_ + wave * 1024), 16, 0, 0); } while (0)
#define RG_WAIT(k) do { if (MT == 8) { if ((k) == 2) asm volatile("s_waitcnt vmcnt(8)" ::: "memory"); else if ((k) == 1) asm volatile("s_waitcnt vmcnt(4)" ::: "memory"); else asm volatile("s_waitcnt vmcnt(0)" ::: "memory"); } \
        else if (a_wave) { if ((k) == 2) asm volatile("s_waitcnt vmcnt(6)" ::: "memory"); else if ((k) == 1) asm volatile("s_waitcnt vmcnt(3)" ::: "memory"); else asm volatile("s_waitcnt vmcnt(0)" ::: "memory"); } \
        else { if ((k) == 2) asm volatile("s_waitcnt vmcnt(4)" ::: "memory"); else if ((k) == 1) asm volatile("s_waitcnt vmcnt(2)" ::: "memory"); else asm volatile("s_waitcnt vmcnt(0)" ::: "memory"); } } while (0)
    RG_STAGE(0);
    if (nst > 1) RG_STAGE(1);
    if (nst > 2) RG_STAGE(2);
#pragma unroll 1
    for (int t = 0; t < nst; ++t) {
        const int ahead = (nst - 1 - t) < 2 ? (nst - 1 - t) : 2;
        if (ahead == 2) RG_WAIT(2); else if (ahead == 1) RG_WAIT(1); else RG_WAIT(0);
        LGKM_BAR();
        __builtin_amdgcn_sched_barrier(0);
        {
            LAS const unsigned char* As = lds + (t & 3) * 32768 + wr * (MT * 1024);
            LAS const unsigned char* Bs = lds + (t & 3) * 32768 + 16384 + wc * 4096;
            bf16x8 bfr[4];
#pragma unroll
            for (int n = 0; n < 4; ++n) bfr[n] = *(LAS const bf16x8*)(Bs + n * 1024 + fo);
            constexpr int MH = MT > 4 ? 4 : MT;
#pragma unroll
            for (int m0 = 0; m0 < MT; m0 += MH) {
                bf16x8 af[MH];
#pragma unroll
                for (int m = 0; m < MH; ++m) af[m] = *(LAS const bf16x8*)(As + (m0 + m) * 1024 + fo);
#pragma unroll
                for (int m = 0; m < MH; ++m)
#pragma unroll
                    for (int n = 0; n < 4; ++n)
                        acc[m0 + m][n] = __builtin_amdgcn_mfma_f32_16x16x32_bf16(bfr[n], af[m], acc[m0 + m][n], 0, 0, 0);
                if (m0 == 0) {
                    __builtin_amdgcn_sched_barrier(0);
                    if (t + 3 < nst) RG_STAGE(t + 3);
                    __builtin_amdgcn_sched_barrier(0);
                }
            }
        }
        __builtin_amdgcn_sched_barrier(0);
    }
    LGKM_BAR();
#undef RG_STAGE
#undef RG_WAIT
}
__device__ __forceinline__ void ring_aoff(unsigned (&aoff)[2], int tid, int ld_elems) {
#pragma unroll
    for (int i = 0; i < 2; ++i) { const int p = tid + 512 * i, row = p >> 2, lc = (p & 3) ^ swz4(row); aoff[i] = (unsigned)(row * ld_elems + lc * 8) * 2u; }
}
template <int MT>
__device__ __forceinline__ void zero_accT(f32x4 (&acc)[MT][4]) {
#pragma unroll
    for (int m = 0; m < MT; ++m)
#pragma unroll
        for (int n = 0; n < 4; ++n) acc[m][n] = (f32x4){0.f, 0.f, 0.f, 0.f};
}
__device__ __forceinline__ void convert_block(const Frame& F, const float* colp, size_t ldb, int kt, bf16* blk) {
    f32x4 r[8];
    loadB32(r, colp + (size_t)(kt * 64 + 8 * F.wave) * ldb, ldb);
#pragma unroll
    for (int j = 0; j < 4; ++j) {
        u32x4 w; w.x = pk2(r[0][j], r[1][j]); w.y = pk2(r[2][j], r[3][j]); w.z = pk2(r[4][j], r[5][j]); w.w = pk2(r[6][j], r[7][j]);
        const int n = 4 * F.lane + j;
        *(u32x4*)((char*)blk + (F.wave >> 2) * 16384 + n * 64 + (((F.wave & 3) ^ swz4(n)) << 4)) = w;
    }
}
__device__ __forceinline__ void zero_acc(f32x4 (&acc)[4][4]) {
#pragma unroll
    for (int m = 0; m < 4; ++m)
#pragma unroll
        for (int n = 0; n < 4; ++n) acc[m][n] = (f32x4){0.f, 0.f, 0.f, 0.f};
}

__device__ __forceinline__ void phase0(const Frame& F, const float* x, const float* g, const float* b, const float* w_in, const float* w_out, const float* w_router) {
    const int gw = F.vcu * 8 + F.wave, NGW = F.G * 8;
    bf16* H0B = (bf16*)(F.ws + WS_H0B);
    f32x4 gv[4], bv[4];
#pragma unroll
    for (int c = 0; c < 4; ++c) { gv[c] = *(const f32x4*)(g + 4 * F.lane + 256 * c); bv[c] = *(const f32x4*)(b + 4 * F.lane + 256 * c); }
    for (int row = gw; row < T_TOK; row += NGW) {
        const float* xr = x + (size_t)row * DM + 4 * F.lane;
        f32x4 v[4]; float s = 0.f;
#pragma unroll
        for (int c = 0; c < 4; ++c) { v[c] = *(const f32x4*)(xr + 256 * c); s += (v[c].x + v[c].y) + (v[c].z + v[c].w); }
        const float mean = wave_sum(s) * (1.f / DM); float s2 = 0.f;
#pragma unroll
        for (int c = 0; c < 4; ++c) { v[c] = v[c] - mean; s2 += (v[c].x * v[c].x + v[c].y * v[c].y) + (v[c].z * v[c].z + v[c].w * v[c].w); }
        const float rstd = 1.f / sqrtf(wave_sum(s2) * (1.f / DM) + 1e-5f);
        bf16* orow = H0B + (size_t)row * DM + 4 * F.lane;
#pragma unroll
        for (int c = 0; c < 4; ++c) {
            const f32x4 y = v[c] * rstd * gv[c] + bv[c];
            u32x2 w; w.x = pk2(y.x, y.y); w.y = pk2(y.z, y.w);
            *(u32x2*)(orow + 256 * c) = w;
        }
    }
    {
        bf16* WIMG = (bf16*)(F.ws + WS_WIMG);
        for (int blk = F.vcu; blk < WIMG_N; blk += F.G) {
            const int s = 4 * F.lane;
            if (blk >= 128 && blk < WIMG_OUT) convert_block(F, w_in + (blk / 16) * 256 + s, INW, blk % 16, WIMG + (size_t)blk * 16384);
            else if (blk >= WIMG_RT) convert_block(F, w_router + s, NEXP, blk - WIMG_RT, WIMG + (size_t)blk * 16384);
        }
    }
    {
        bf16* WTI = (bf16*)(F.ws + WS_WT_IN); bf16* WTO = (bf16*)(F.ws + WS_WT_OUT);
        LAS float* scr = (LAS float*)(F.lds + F.wave * 8448);
        for (int it = gw; it < 1024 + 512; it += NGW) {
            const bool isin = it < 1024; const int r = isin ? it : it - 1024;
            const int nblk = isin ? 64 : 32, kb = r / nblk, nb = r % nblk, k0 = 64 * kb, n0 = 32 * nb, N = isin ? INW : DM;
            const float* W = isin ? w_in : w_out; bf16* WT = isin ? WTI : WTO;
#pragma unroll 8
            for (int i = 0; i < 32; ++i) { const int kk = 2 * i + (F.lane >> 5); scr[kk * 33 + (F.lane & 31)] = W[(size_t)(k0 + kk) * N + n0 + (F.lane & 31)]; }
            asm volatile("s_waitcnt lgkmcnt(0)" ::: "memory");
            const int c = F.lane & 7;
#pragma unroll
            for (int j = 0; j < 4; ++j) {
                const int n = (F.lane >> 3) + 8 * j; const LAS float* sp = scr + (8 * c) * 33 + n;
                u32x4 o; o.x = pk2(sp[0 * 33], sp[1 * 33]); o.y = pk2(sp[2 * 33], sp[3 * 33]); o.z = pk2(sp[4 * 33], sp[5 * 33]); o.w = pk2(sp[6 * 33], sp[7 * 33]);
                const int col = n0 + n;
                const int row = (isin && col < 512) ? ((col & ~48) | ((col & 16) << 1) | ((col & 32) >> 1)) : col;
                *(u32x4*)(WT + (size_t)row * DM + k0 + 8 * c) = o;
            }
            asm volatile("s_waitcnt lgkmcnt(0)" ::: "memory");
        }
    }
    float* COS = (float*)(F.ws + WS_COS); float* SIN = (float*)(F.ws + WS_SIN);
    for (int i = F.vcu * 512 + F.tid; i < SEQ * 32; i += F.G * 512) {
        const int pos = i >> 5, j = i & 31;
        const float inv = exp2f(-(float)j * (13.287712379549449f / 32.0f));
        const float ang = (float)pos * inv;
        double rev = (double)ang * 0.15915494309189535;
        rev -= __builtin_rint(rev);
        const float rv = (float)rev;
        COS[i] = __builtin_amdgcn_cosf(rv); SIN[i] = __builtin_amdgcn_sinf(rv);
    }
}

template <int MT>
__device__ __forceinline__ void p1_epilogue(f32x4 (&acc)[MT][4], const Frame& F, int row_base, int nt) {
    bf16* PROJ = (bf16*)(F.ws + WS_PROJ);
    const float* COS = (const float*)(F.ws + WS_COS); const float* SIN = (const float*)(F.ws + WS_SIN);
    const int lane = F.lane, wr = F.wave >> 2, wc = F.wave & 3, fr = lane & 15, fq = lane >> 4;
    const float scale = (nt == 1 || nt == 6 || nt == 7) ? 0.125f : 1.0f;
#pragma unroll
    for (int m = 0; m < MT; ++m) {
        const int row = row_base + wr * (16 * MT) + m * 16 + fr;
        if (nt < 2) {
            const int pos = row & (SEQ - 1);
#pragma unroll
            for (int n = 0; n < 2; ++n) {
                const f32x4 c = *(const f32x4*)(COS + pos * 32 + 16 * n + 4 * fq), s = *(const f32x4*)(SIN + pos * 32 + 16 * n + 4 * fq);
                const f32x4 x1 = acc[m][n], x2 = acc[m][n + 2];
                acc[m][n] = x1 * c - x2 * s; acc[m][n + 2] = x1 * s + x2 * c;
            }
        }
        bf16* orow = PROJ + (size_t)row * INW + nt * 256 + wc * 64 + 4 * fq;
#pragma unroll
        for (int n = 0; n < 4; ++n) {
            const f32x4 v = acc[m][n] * scale;
            u32x2 w; w.x = pk2(v.x, v.y); w.y = pk2(v.z, v.w);
            *(u32x2*)(orow + 16 * n) = w;
        }
        asm volatile("" ::: "memory");
    }
}
struct SchedP1 { int vcu, G; __device__ __forceinline__ bool next(int i, pg8::Unit& u) const { const int L = vcu + i * G; if (L >= 512) return false; u.pm = L >> 3; u.pn = L & 7; return true; } };
struct EpiP1 {
    bf16* PROJ; const float* COS; const float* SIN;
    __device__ __forceinline__ void operator()(const f32x4 (&acc)[2][2][4][2], const pg8::Unit& u, int wr, int wc, int fr, int fq) const {
        const float scale = (u.pn == 1 || u.pn == 6 || u.pn == 7) ? 0.125f : 1.0f;
#pragma unroll
        for (int ai = 0; ai < 2; ++ai)
#pragma unroll
            for (int m = 0; m < 4; ++m) {
                const int row = u.pm * 256 + ai * 128 + wr * 64 + m * 16 + fr;
                if (u.pn < 2) {
                    const int pos = row & (SEQ - 1), d0 = 16 * (wc & 1) + 4 * fq;
                    const f32x4 c = *(const f32x4*)(COS + pos * 32 + d0), s = *(const f32x4*)(SIN + pos * 32 + d0);
#pragma unroll
                    for (int bj = 0; bj < 2; ++bj) {
                        const f32x4 x1 = acc[ai][bj][m][0], x2 = acc[ai][bj][m][1];
                        const f32x4 o1 = (x1 * c - x2 * s) * scale, o2 = (x1 * s + x2 * c) * scale;
                        bf16* dst = PROJ + (size_t)row * INW + u.pn * 256 + bj * 128 + (wc >> 1) * 64 + d0;
                        u32x2 w1, w2; w1.x = pk2(o1.x, o1.y); w1.y = pk2(o1.z, o1.w); w2.x = pk2(o2.x, o2.y); w2.y = pk2(o2.z, o2.w);
                        *(u32x2*)dst = w1; *(u32x2*)(dst + 32) = w2;
                    }
                } else {
#pragma unroll
                    for (int bj = 0; bj < 2; ++bj)
#pragma unroll
                        for (int n = 0; n < 2; ++n) {
                            const f32x4 v = acc[ai][bj][m][n] * scale;
                            u32x2 w; w.x = pk2(v.x, v.y); w.y = pk2(v.z, v.w);
                            *(u32x2*)(PROJ + (size_t)row * INW + u.pn * 256 + bj * 128 + wc * 32 + 16 * n + 4 * fq) = w;
                        }
                }
                asm volatile("" ::: "memory");
            }
    }
};
__device__ __forceinline__ void phase1(const Frame& F) {
    const bf16* H0B = (const bf16*)(F.ws + WS_H0B);
    const bf16* WIMG = (const bf16*)(F.ws + WS_WIMG);
    {
        const pg8::Gemm g{H0B, (const bf16*)(F.ws + WS_WT_IN), DM};
        const SchedP1 S{F.vcu, F.G};
        const EpiP1 E{(bf16*)(F.ws + WS_PROJ), (const float*)(F.ws + WS_COS), (const float*)(F.ws + WS_SIN)};
        pg8::gemm_phase<EpiP1, SchedP1>(F.lds, g, S, E);
    }
    unsigned aoff[2]; ring_aoff(aoff, F.tid, DM);
    for (int mt = F.vcu; mt < 256; mt += F.G) {
        f32x4 acc[2][4]; zero_accT<2>(acc);
        gemm_ring<2>(acc, F, H0B + (size_t)mt * 64 * DM, aoff, WIMG + (size_t)(WIMG_IN + 8 * 16) * 16384, DM / 32);
        p1_epilogue<2>(acc, F, mt * 64, 8);
    }
}

__device__ __forceinline__ bf16x8 tr_frag(LAS const unsigned char* a0, LAS const unsigned char* a1) {
    const s16x4 lo = __builtin_amdgcn_ds_read_tr16_b64_v4i16((LAS s16x4*)a0);
    const s16x4 hi = __builtin_amdgcn_ds_read_tr16_b64_v4i16((LAS s16x4*)a1);
    bf16x8 r; r[0] = lo[0]; r[1] = lo[1]; r[2] = lo[2]; r[3] = lo[3]; r[4] = hi[0]; r[5] = hi[1]; r[6] = hi[2]; r[7] = hi[3];
    return r;
}
__device__ __forceinline__ int tr128_off(int row, int col) { return row * 128 + 32 * ((col >> 4) ^ ((row >> 1) & 3)) + 2 * (col & 15); }
__device__ __forceinline__ int tr256_off(int row, int col) { return row * 256 + 32 * ((col >> 4) ^ (row & 7)) + 2 * (col & 15); }
__device__ __forceinline__ bf16x8 pack_p(const f32x4& a, const f32x4& b) {
    u32x4 w; w.x = pk2(a.x, a.y); w.y = pk2(a.z, a.w); w.z = pk2(b.x, b.y); w.w = pk2(b.z, b.w);
    return __builtin_bit_cast(bf16x8, w);
}

__device__ __forceinline__ int t5_bucket(int n) {
    if (n < 16) return n;
    const float ratio = logf((float)n / 16.0f) / 2.0794415416798357f;
    int large = 16 + (int)(ratio * 16.0f);
    return large < 31 ? large : 31;
}
__device__ __forceinline__ void swa_unit(const Frame& F, int su, const float* rel_bias, const float* sinks) {
    LAS unsigned char* lds = F.lds;
    const bf16* PROJ = (const bf16*)(F.ws + WS_PROJ);
    bf16* MIXIN = (bf16*)(F.ws + WS_MIXIN);
    const int tid = F.tid, lane = F.lane, wave = F.wave, fr = lane & 15, fq = lane >> 4;
    const int b = su >> 7, nb = (su >> 1) & 63, kvh = su & 1;
    const int tok_prev = b * SEQ + (nb > 0 ? nb - 1 : 0) * 128, tok_cur = b * SEQ + nb * 128;
    constexpr int L_K = 0, L_V = 32768, L_BT = 65536;
#pragma unroll
    for (int i = 0; i < 4; ++i) {
        const int p = tid + 512 * i, row = p >> 3, pc = p & 7;
        const int tok = (row < 128 ? tok_prev + row : tok_cur + row - 128);
        const bf16* src = PROJ + (size_t)tok * INW;
        const int lck = pc ^ (row & 7);
        __builtin_amdgcn_global_load_lds((const unsigned*)(src + 2048 + kvh * 64 + lck * 8), (LAS unsigned*)(lds + L_K + wave * 1024 + i * 8192), 16, 0, 0);
        const int vcol = 16 * ((pc >> 1) ^ ((row >> 1) & 3)) + 8 * (pc & 1);
        __builtin_amdgcn_global_load_lds((const unsigned*)(src + 2176 + kvh * 64 + vcol), (LAS unsigned*)(lds + L_V + wave * 1024 + i * 8192), 16, 0, 0);
    }
    {
        const int g = tid >> 7, dist = tid & 127;
        ((LAS float*)(lds + L_BT))[tid] = rel_bias[t5_bucket(dist) * 8 + kvh * 4 + g];
    }
    BLOCK_SYNC();
#pragma unroll 1
    for (int task = wave; task < 32; task += 8) {
        const int g = task >> 3, a = task & 7, nj0 = a & ~1, head = kvh * 4 + g;
        const float sink = sinks[head];
        LAS const float* bt = (LAS const float*)(lds + L_BT) + g * 128;
        const int i = a * 16 + fr;
        bf16x8 qf[2];
#pragma unroll
        for (int kk = 0; kk < 2; ++kk)
            qf[kk] = *(const bf16x8*)(PROJ + (size_t)(tok_cur + i) * INW + 1536 + head * 64 + kk * 32 + fq * 8);
        f32x4 s[10];
#pragma unroll
        for (int nl = 0; nl < 10; ++nl) {
            s[nl] = (f32x4){0.f, 0.f, 0.f, 0.f};
            const int krow = 16 * (nj0 + nl) + fr;
#pragma unroll
            for (int kk = 0; kk < 2; ++kk) {
                const bf16x8 kf = *(LAS const bf16x8*)(lds + L_K + krow * 128 + (((kk * 4 + fq) ^ (fr & 7)) << 4));
                s[nl] = __builtin_amdgcn_mfma_f32_16x16x32_bf16(kf, qf[kk], s[nl], 0, 0, 0);
            }
        }
        float m = sink;
#pragma unroll
        for (int nl = 0; nl < 10; ++nl)
#pragma unroll
            for (int j = 0; j < 4; ++j) {
                const int jp = 16 * (nj0 + nl) + 4 * fq + j;
                const int dist = i + 128 - jp;
                const bool ok = (dist >= 0) && (dist < 128) && (nb > 0 || jp >= 128);
                const float v = ok ? s[nl][j] + bt[dist & 127] : -INFINITY;
                s[nl][j] = v; m = fmaxf(m, v);
            }
        m = fmaxf(m, __shfl_xor(m, 16)); m = fmaxf(m, __shfl_xor(m, 32));
        float d = 0.f;
#pragma unroll
        for (int nl = 0; nl < 10; ++nl)
#pragma unroll
            for (int j = 0; j < 4; ++j) { const float p = __expf(s[nl][j] - m); s[nl][j] = p; d += p; }
        d += __shfl_xor(d, 16); d += __shfl_xor(d, 32);
        const float inv = 1.0f / (d + __expf(sink - m));
        f32x4 o[4];
#pragma unroll
        for (int ne = 0; ne < 4; ++ne) o[ne] = (f32x4){0.f, 0.f, 0.f, 0.f};
#pragma unroll
        for (int ks = 0; ks < 5; ++ks) {
            const bf16x8 pf = pack_p(s[2 * ks], s[2 * ks + 1]);
            const int r0 = 16 * (nj0 + 2 * ks) + 4 * fq + (fr >> 2);
#pragma unroll
            for (int ne = 0; ne < 4; ++ne) {
                const bf16x8 vf = tr_frag(lds + L_V + tr128_off(r0, 16 * ne) + 8 * (fr & 3), lds + L_V + tr128_off(r0 + 16, 16 * ne) + 8 * (fr & 3));
                o[ne] = __builtin_amdgcn_mfma_f32_16x16x32_bf16(vf, pf, o[ne], 0, 0, 0);
            }
        }
        bf16* orow = MIXIN + (size_t)(tok_cur + i) * DM + 512 + head * 64 + 4 * fq;
#pragma unroll
        for (int ne = 0; ne < 4; ++ne) {
            const f32x4 v = o[ne] * inv;
            u32x2 w; w.x = pk2(v.x, v.y); w.y = pk2(v.z, v.w);
            *(u32x2*)(orow + 16 * ne) = w;
        }
    }
    BLOCK_SYNC();
}

__device__ __forceinline__ float ret_log2gamma(int h) { return log2f(1.0f - exp2f(-5.0f - (float)h)); }
__device__ __forceinline__ void stage_v256(const Frame& F, const bf16* PROJ, int tok0, int h, int L_V) {
#pragma unroll
    for (int i = 0; i < 4; ++i) {
        const int p = F.tid + 512 * i, row = p >> 4, pc = p & 15;
        const int col = 16 * ((pc >> 1) ^ (row & 7)) + 8 * (pc & 1);
        __builtin_amdgcn_global_load_lds((const unsigned*)(PROJ + (size_t)(tok0 + row) * INW + 512 + h * 128 + col), (LAS unsigned*)(F.lds + L_V + F.wave * 1024 + i * 8192), 16, 0, 0);
    }
}
__device__ __forceinline__ void kv_unit(const Frame& F, int ku) {
    LAS unsigned char* lds = F.lds;
    const bf16* PROJ = (const bf16*)(F.ws + WS_PROJ);
    float* KVT = (float*)(F.ws + WS_KVT);
    const int tid = F.tid, lane = F.lane, wave = F.wave, fr = lane & 15, fq = lane >> 4;
    const int b = ku >> 8, n = (ku >> 2) & 63, h = ku & 3;
    const int tok0 = b * SEQ + n * 128;
    constexpr int L_K = 0, L_V = 16384;
    const float l2g = ret_log2gamma(h);
    stage_v256(F, PROJ, tok0, h, L_V);
#pragma unroll
    for (int i = 0; i < 2; ++i) {
        const int p = tid + 512 * i, row = p >> 3, pc = p & 7;
        const int col = 16 * ((pc >> 1) ^ ((row >> 1) & 3)) + 8 * (pc & 1);
        const u32x4 kv = *(const u32x4*)(PROJ + (size_t)(tok0 + row) * INW + 256 + h * 64 + col);
        const float z = exp2f((float)(127 - row) * l2g);
        u32x4 w;
        w.x = pk2(bflo(kv.x) * z, bfhi(kv.x) * z); w.y = pk2(bflo(kv.y) * z, bfhi(kv.y) * z);
        w.z = pk2(bflo(kv.z) * z, bfhi(kv.z) * z); w.w = pk2(bflo(kv.w) * z, bfhi(kv.w) * z);
        *(LAS u32x4*)(lds + L_K + p * 16) = w;
    }
    BLOCK_SYNC();
    const int ne = wave;
    f32x4 acc[4];
#pragma unroll
    for (int nd = 0; nd < 4; ++nd) acc[nd] = (f32x4){0.f, 0.f, 0.f, 0.f};
#pragma unroll
    for (int ks = 0; ks < 4; ++ks) {
        const int r0 = 32 * ks + 4 * fq + (fr >> 2);
        const bf16x8 vf = tr_frag(lds + L_V + tr256_off(r0, 16 * ne) + 8 * (fr & 3), lds + L_V + tr256_off(r0 + 16, 16 * ne) + 8 * (fr & 3));
#pragma unroll
        for (int nd = 0; nd < 4; ++nd) {
            const bf16x8 kf = tr_frag(lds + L_K + tr128_off(r0, 16 * nd) + 8 * (fr & 3), lds + L_K + tr128_off(r0 + 16, 16 * nd) + 8 * (fr & 3));
            acc[nd] = __builtin_amdgcn_mfma_f32_16x16x32_bf16(kf, vf, acc[nd], 0, 0, 0);
        }
    }
    float* dst = KVT + (size_t)ku * 8192 + (16 * ne + fr) * 64 + 4 * fq;
#pragma unroll
    for (int nd = 0; nd < 4; ++nd) *(f32x4*)(dst + 16 * nd) = acc[nd];
    BLOCK_SYNC();
}

__device__ __forceinline__ void phase_scan(const Frame& F) {
    const float* KVT = (const float*)(F.ws + WS_KVT);
    bf16* ST = (bf16*)(F.ws + WS_STATE);
    for (int gid = F.vcu * 512 + F.tid; gid < 65536; gid += F.G * 512) {
        const int b = gid >> 15, h = (gid >> 13) & 3, ed = gid & 8191;
        const float cd = exp2f(128.0f * ret_log2gamma(h));
        float s = 0.f;
        const size_t base = (size_t)b * 64 * 4 * 8192 + (size_t)h * 8192 + ed;
#pragma unroll 8
        for (int n = 0; n < 64; ++n) {
            const size_t idx = base + (size_t)n * 4 * 8192;
            const float kv = KVT[idx];
            ST[idx] = (bf16)(pk2(s, 0.f) & 0xffffu);
            s = s * cd + kv;
        }
    }
}

__device__ __forceinline__ void ret_unit(const Frame& F, int ku) {
    LAS unsigned char* lds = F.lds;
    const bf16* PROJ = (const bf16*)(F.ws + WS_PROJ);
    const bf16* ST = (const bf16*)(F.ws + WS_STATE);
    bf16* MIXIN = (bf16*)(F.ws + WS_MIXIN);
    const int tid = F.tid, lane = F.lane, w = F.wave, fr = lane & 15, fq = lane >> 4;
    const int b = ku >> 8, n = (ku >> 2) & 63, h = ku & 3;
    const int tok0 = b * SEQ + n * 128;
    constexpr int L_K = 0, L_V = 16384;
    const float l2g = ret_log2gamma(h);
    stage_v256(F, PROJ, tok0, h, L_V);
#pragma unroll
    for (int i = 0; i < 2; ++i) {
        const int p = tid + 512 * i, row = p >> 3, pc = p & 7;
        const int lck = pc ^ (row & 7);
        __builtin_amdgcn_global_load_lds((const unsigned*)(PROJ + (size_t)(tok0 + row) * INW + 256 + h * 64 + lck * 8), (LAS unsigned*)(lds + L_K + w * 1024 + i * 8192), 16, 0, 0);
    }
    const int i_row = 16 * w + fr;
    const size_t tok = (size_t)tok0 + i_row;
    bf16x8 qf[2];
#pragma unroll
    for (int kk = 0; kk < 2; ++kk) qf[kk] = *(const bf16x8*)(PROJ + tok * INW + h * 64 + kk * 32 + fq * 8);
    const bf16* grow = PROJ + tok * INW + 1024 + h * 128 + 4 * fq;
    u32x2 ggv[8];
#pragma unroll
    for (int ne = 0; ne < 8; ++ne) ggv[ne] = *(const u32x2*)(grow + 16 * ne);
    f32x4 o[8];
#pragma unroll
    for (int ne = 0; ne < 8; ++ne) o[ne] = (f32x4){0.f, 0.f, 0.f, 0.f};
    const bf16* stb = ST + (size_t)ku * 8192;
    bf16x8 sf[8][2];
#pragma unroll
    for (int ne = 0; ne < 8; ++ne)
#pragma unroll
        for (int kk = 0; kk < 2; ++kk) sf[ne][kk] = *(const bf16x8*)(stb + (16 * ne + fr) * 64 + kk * 32 + fq * 8);
    __builtin_amdgcn_sched_barrier(0);
#pragma unroll
    for (int ne = 0; ne < 8; ++ne)
#pragma unroll
        for (int kk = 0; kk < 2; ++kk) o[ne] = __builtin_amdgcn_mfma_f32_16x16x32_bf16(sf[ne][kk], qf[kk], o[ne], 0, 0, 0);
    const float xi = exp2f((float)(i_row + 1) * l2g);
#pragma unroll
    for (int ne = 0; ne < 8; ++ne) o[ne] = o[ne] * xi;
    BLOCK_SYNC();
    f32x4 s[8];
#pragma unroll
    for (int nj = 0; nj < 8; ++nj) {
        s[nj] = (f32x4){0.f, 0.f, 0.f, 0.f};
        if (nj <= w) {
#pragma unroll
            for (int kk = 0; kk < 2; ++kk) {
                const bf16x8 kf = *(LAS const bf16x8*)(lds + L_K + (16 * nj + fr) * 128 + (((kk * 4 + fq) ^ (fr & 7)) << 4));
                s[nj] = __builtin_amdgcn_mfma_f32_16x16x32_bf16(kf, qf[kk], s[nj], 0, 0, 0);
            }
#pragma unroll
            for (int j = 0; j < 4; ++j) {
                const int jj = 16 * nj + 4 * fq + j;
                const int diff = i_row - jj;
                s[nj][j] = diff >= 0 ? s[nj][j] * exp2f((float)diff * l2g) : 0.f;
            }
        }
    }
#pragma unroll
    for (int ks = 0; ks < 4; ++ks) {
        if (2 * ks <= w) {
            const bf16x8 pf = pack_p(s[2 * ks], s[2 * ks + 1]);
            const int r0 = 32 * ks + 4 * fq + (fr >> 2);
#pragma unroll
            for (int ne = 0; ne < 8; ++ne) {
                const bf16x8 vf = tr_frag(lds + L_V + tr256_off(r0, 16 * ne) + 8 * (fr & 3), lds + L_V + tr256_off(r0 + 16, 16 * ne) + 8 * (fr & 3));
                o[ne] = __builtin_amdgcn_mfma_f32_16x16x32_bf16(vf, pf, o[ne], 0, 0, 0);
            }
        }
    }
    float sm = 0.f;
#pragma unroll
    for (int ne = 0; ne < 8; ++ne) sm += (o[ne].x + o[ne].y) + (o[ne].z + o[ne].w);
    sm += __shfl_xor(sm, 16); sm += __shfl_xor(sm, 32);
    const float mean = sm * (1.f / 128.f);
    float sq = 0.f;
#pragma unroll
    for (int ne = 0; ne < 8; ++ne) { o[ne] = o[ne] - mean; sq += (o[ne].x * o[ne].x + o[ne].y * o[ne].y) + (o[ne].z * o[ne].z + o[ne].w * o[ne].w); }
    sq += __shfl_xor(sq, 16); sq += __shfl_xor(sq, 32);
    const float rstd = 1.0f / sqrtf(sq * (1.f / 128.f) + 1e-6f);
    bf16* orow = MIXIN + tok * DM + h * 128 + 4 * fq;
#pragma unroll
    for (int ne = 0; ne < 8; ++ne) {
        const u32x2 gg = ggv[ne];
        const float g0 = bflo(gg.x), g1 = bfhi(gg.x), g2 = bflo(gg.y), g3 = bfhi(gg.y);
        const f32x4 v = o[ne] * rstd;
        const float y0 = v.x * g0 / (1.f + __expf(-g0)), y1 = v.y * g1 / (1.f + __expf(-g1)), y2 = v.z * g2 / (1.f + __expf(-g2)), y3 = v.w * g3 / (1.f + __expf(-g3));
        u32x2 wv; wv.x = pk2(y0, y1); wv.y = pk2(y2, y3);
        *(u32x2*)(orow + 16 * ne) = wv;
    }
    BLOCK_SYNC();
}

struct SchedP5 { int vcu, G; __device__ __forceinline__ bool next(int i, pg8::Unit& u) const { const int L = vcu + i * G; if (L >= 256) return false; u.pm = L >> 2; u.pn = L & 3; return true; } };
struct EpiP5 {
    const bf16* H0B; bf16* PRE1;
    __device__ __forceinline__ void operator()(const f32x4 (&acc)[2][2][4][2], const pg8::Unit& u, int wr, int wc, int fr, int fq) const {
#pragma unroll
        for (int ai = 0; ai < 2; ++ai)
#pragma unroll
            for (int m = 0; m < 4; ++m) {
                const size_t row = (size_t)(u.pm * 256 + ai * 128 + wr * 64 + m * 16 + fr);
#pragma unroll
                for (int bj = 0; bj < 2; ++bj)
#pragma unroll
                    for (int n = 0; n < 2; ++n) {
                        const size_t off = row * DM + u.pn * 256 + bj * 128 + wc * 32 + 16 * n + 4 * fq;
                        const u32x2 hh = *(const u32x2*)(H0B + off);
                        f32x4 v = acc[ai][bj][m][n];
                        v.x += ALPHA * bflo(hh.x); v.y += ALPHA * bfhi(hh.x); v.z += ALPHA * bflo(hh.y); v.w += ALPHA * bfhi(hh.y);
                        u32x2 pw; pw.x = pk2(v.x, v.y); pw.y = pk2(v.z, v.w);
                        *(u32x2*)(PRE1 + off) = pw;
                    }
                asm volatile("" ::: "memory");
            }
    }
};
__device__ __forceinline__ void phase_outproj(const Frame& F) {
    const pg8::Gemm g{(const bf16*)(F.ws + WS_MIXIN), (const bf16*)(F.ws + WS_WT_OUT), DM};
    const SchedP5 S{F.vcu, F.G};
    const EpiP5 E{(const bf16*)(F.ws + WS_H0B), (bf16*)(F.ws + WS_PRE1)};
    pg8::gemm_phase<EpiP5, SchedP5>(F.lds, g, S, E);
}

__device__ __forceinline__ unsigned fkey(float f) { const unsigned u = __float_as_uint(f); return u ^ ((u >> 31) ? 0xffffffffu : 0x80000000u); }
__device__ __forceinline__ int lanes_below(unsigned long long m) { return (int)__builtin_amdgcn_mbcnt_hi((unsigned)(m >> 32), __builtin_amdgcn_mbcnt_lo((unsigned)m, 0u)); }
__device__ __forceinline__ void phase_router(const Frame& F, const float* g, const float* bb, const float* w_router, const float* rbias) {
    LAS unsigned char* lds = F.lds;
    const bf16* PRE1 = (const bf16*)(F.ws + WS_PRE1);
    bf16* H1B = (bf16*)(F.ws + WS_H1B);
    unsigned* gcnt = (unsigned*)(F.ws + WS_CTL) + CW_CNT;
    u32x2* LIST2 = (u32x2*)(F.ws + WS_LIST2);
    const int tid = F.tid, lane = F.lane, wave = F.wave, wr = wave >> 2, wc = wave & 3, fr = lane & 15, fq = lane >> 4;
    LAS float* selw = (LAS float*)(lds + L_TAB + TB_SELW);
    LAS int* hist = (LAS int*)(lds + L_TAB + TB_HIST);
    LAS int* basee = (LAS int*)(lds + L_TAB + TB_BASE);
    LAS int* sel = (LAS int*)(lds + L_TAB + TB_SEL);
    for (int mt = F.vcu; mt < 256; mt += F.G) {
        const int row0 = mt * 64;
        asm volatile("" ::: "memory");
        {
            f32x4 gv[4], bv[4];
#pragma unroll
            for (int c = 0; c < 4; ++c) { gv[c] = *(const f32x4*)(g + 4 * lane + 256 * c); bv[c] = *(const f32x4*)(bb + 4 * lane + 256 * c); }
#pragma unroll 1
            for (int batch = 0; batch < 2; ++batch) {
                f32x4 v[4][4];
#pragma unroll
                for (int r = 0; r < 4; ++r)
#pragma unroll
                    for (int c = 0; c < 4; ++c) { const u32x2 pw = *(const u32x2*)(PRE1 + (size_t)(row0 + wave * 8 + batch * 4 + r) * DM + 4 * lane + 256 * c); v[r][c] = (f32x4){bflo(pw.x), bfhi(pw.x), bflo(pw.y), bfhi(pw.y)}; }
#pragma unroll
                for (int r = 0; r < 4; ++r) {
                    float s = 0.f;
#pragma unroll
                    for (int c = 0; c < 4; ++c) s += (v[r][c].x + v[r][c].y) + (v[r][c].z + v[r][c].w);
                    const float mean = wave_sum(s) * (1.f / DM); float s2 = 0.f;
#pragma unroll
                    for (int c = 0; c < 4; ++c) { v[r][c] = v[r][c] - mean; s2 += (v[r][c].x * v[r][c].x + v[r][c].y * v[r][c].y) + (v[r][c].z * v[r][c].z + v[r][c].w * v[r][c].w); }
                    const float rstd = 1.f / sqrtf(wave_sum(s2) * (1.f / DM) + 1e-5f);
                    bf16* orow = H1B + (size_t)(row0 + wave * 8 + batch * 4 + r) * DM + 4 * lane;
#pragma unroll
                    for (int c = 0; c < 4; ++c) {
                        const f32x4 y = v[r][c] * rstd * gv[c] + bv[c];
                        u32x2 wv; wv.x = pk2(y.x, y.y); wv.y = pk2(y.z, y.w);
                        *(u32x2*)(orow + 256 * c) = wv;
                    }
                }
            }
        }
        if (tid < 256) hist[tid] = 0;
        BLOCK_SYNC();
        asm volatile("" ::: "memory");
        unsigned aoff[2]; ring_aoff(aoff, tid, DM);
        f32x4 acc[2][4]; zero_accT<2>(acc);
        gemm_ring<2>(acc, F, H1B + (size_t)row0 * DM, aoff, (const bf16*)(F.ws + WS_WIMG) + (size_t)WIMG_RT * 16384, DM / 32);
        LAS float* sc = (LAS float*)lds;
#pragma unroll
        for (int m = 0; m < 2; ++m) {
            const int row = wr * 32 + m * 16 + fr;
#pragma unroll
            for (int n = 0; n < 4; ++n) {
                f32x4 v = acc[m][n];
                v.x = 1.f / (1.f + __expf(-v.x)); v.y = 1.f / (1.f + __expf(-v.y)); v.z = 1.f / (1.f + __expf(-v.z)); v.w = 1.f / (1.f + __expf(-v.w));
                *(LAS f32x4*)(sc + row * 260 + wc * 64 + n * 16 + 4 * fq) = v;
            }
        }
        BLOCK_SYNC();
        asm volatile("" ::: "memory");
        const f32x4 rb = *(const f32x4*)(rbias + 4 * lane);
        const int grp = lane >> 3;
#pragma unroll 1
        for (int r = 0; r < 8; ++r) {
            const int rl = wave * 8 + r;
            const f32x4 v = *(LAS const f32x4*)(sc + rl * 260 + 4 * lane);
            const f32x4 ch = v + rb;
            float a1 = fmaxf(ch.x, ch.y), a2 = fminf(ch.x, ch.y);
            { const float b1 = fmaxf(ch.z, ch.w), b2 = fminf(ch.z, ch.w); const float n1 = fmaxf(a1, b1), n2 = fmaxf(fminf(a1, b1), fmaxf(a2, b2)); a1 = n1; a2 = n2; }
#pragma unroll
            for (int o = 1; o < 8; o <<= 1) {
                const float b1 = __shfl_xor(a1, o), b2 = __shfl_xor(a2, o);
                const float n1 = fmaxf(a1, b1), n2 = fmaxf(fminf(a1, b1), fmaxf(a2, b2));
                a1 = n1; a2 = n2;
            }
            const float gsum = a1 + a2;
            int rank = 0;
#pragma unroll
            for (int j = 0; j < 8; ++j) { const float sj = __shfl(gsum, 8 * j); rank += (sj > gsum || (sj == gsum && j < grp)) ? 1 : 0; }
            const bool gsel = rank < 4;
            unsigned key[4];
            key[0] = gsel ? fkey(ch.x) : 0u; key[1] = gsel ? fkey(ch.y) : 0u; key[2] = gsel ? fkey(ch.z) : 0u; key[3] = gsel ? fkey(ch.w) : 0u;
            unsigned tau = 0u;
#pragma unroll 1
            for (int bit = 31; bit >= 0; --bit) {
                const unsigned cand = tau | (1u << bit);
                const int cnt = __popcll(__ballot(key[0] >= cand)) + __popcll(__ballot(key[1] >= cand)) + __popcll(__ballot(key[2] >= cand)) + __popcll(__ballot(key[3] >= cand));
                if (cnt >= 8) tau = cand;
            }
            unsigned long long gm[4], em[4];
            int ngt = 0;
#pragma unroll
            for (int j = 0; j < 4; ++j) { gm[j] = __ballot(key[j] > tau); em[j] = __ballot(key[j] == tau); ngt += __popcll(gm[j]); }
            const int need = 8 - ngt;
            int eqb = lanes_below(em[0]) + lanes_below(em[1]) + lanes_below(em[2]) + lanes_below(em[3]);
            bool s[4];
#pragma unroll
            for (int j = 0; j < 4; ++j) { const bool eq = key[j] == tau; s[j] = (key[j] > tau) || (eq && eqb < need); eqb += eq ? 1 : 0; }
            unsigned long long sm[4];
#pragma unroll
            for (int j = 0; j < 4; ++j) sm[j] = __ballot(s[j]);
            int kpos = lanes_below(sm[0]) + lanes_below(sm[1]) + lanes_below(sm[2]) + lanes_below(sm[3]);
            const float wl = (s[0] ? v.x : 0.f) + (s[1] ? v.y : 0.f) + (s[2] ? v.z : 0.f) + (s[3] ? v.w : 0.f);
            const float wscale = 2.5f / wave_sum(wl);
#pragma unroll
            for (int j = 0; j < 4; ++j) {
                if (s[j]) {
                    selw[rl * 8 + kpos] = v[j] * wscale;
                    const int e = 4 * lane + j;
                    const int lpos = __hip_atomic_fetch_add(hist + e, 1, __ATOMIC_RELAXED, __HIP_MEMORY_SCOPE_WORKGROUP);
                    sel[rl * 8 + kpos] = (e << 16) | lpos;
                    ++kpos;
                }
            }
        }
        BLOCK_SYNC();
        if (tid < 256) { const int c = hist[tid]; basee[tid] = c > 0 ? (int)__hip_atomic_fetch_add(gcnt + tid, (unsigned)c, __ATOMIC_RELAXED, __HIP_MEMORY_SCOPE_AGENT) : 0; }
        BLOCK_SYNC();
        {
            const int sv = sel[tid], e = sv >> 16, lpos = sv & 0xffff;
            u32x2 ent; ent.x = (unsigned)(mt * 512 + tid); ent.y = __float_as_uint(selw[tid]);
            LIST2[(size_t)e * LCAP + basee[e] + lpos] = ent;
        }
        BLOCK_SYNC();
    }
}

__device__ __forceinline__ void phase_moe(const Frame& F, const float* w_gate, const float* w_up, const float* w_down, const float* ws_gate, const float* ws_up, const float* ws_down) {
    LAS unsigned char* lds = F.lds;
    const bf16* H1B = (const bf16*)(F.ws + WS_H1B);
    const unsigned* gcnt = (const unsigned*)(F.ws + WS_CTL) + CW_CNT;
    const u32x2* LIST2 = (const u32x2*)(F.ws + WS_LIST2);
    bf16* YROWS = (bf16*)(F.ws + WS_YROWS);
    const int tid = F.tid, lane = F.lane, wave = F.wave, wr = wave >> 2, wc = wave & 3, fr = lane & 15, fq = lane >> 4;
    const int lchunk = (tid & 7) ^ ((tid >> 3) & 7);
    LAS int* prefix = (LAS int*)(lds + L_TAB + TB_PREFIX);
    LAS int* rtok = (LAS int*)(lds + L_TAB + TB_RTOK);
    LAS int* ryrow = (LAS int*)(lds + L_TAB + TB_RYROW);
    LAS float* rw = (LAS float*)(lds + L_TAB + TB_RW);
    LAS int* cntl = (LAS int*)(lds + L_TAB + TB_CNT);
    if (tid < 256) cntl[tid] = (int)gcnt[tid];
    if (wave == 0) {
        int c4[4], loc = 0;
#pragma unroll
        for (int j = 0; j < 4; ++j) { c4[j] = ((int)gcnt[lane * 4 + j] + 127) >> 7; loc += c4[j]; }
        int incl = loc;
#pragma unroll
        for (int o = 1; o < 64; o <<= 1) { const int t = __shfl_up(incl, o); if (lane >= o) incl += t; }
        int run = incl - loc;
#pragma unroll
        for (int j = 0; j < 4; ++j) { prefix[lane * 4 + j] = run; run += c4[j]; }
        if (lane == 63) prefix[256] = run;
    }
    BLOCK_SYNC();
    const int R = prefix[256];
    const int nr = (R > F.vcu) ? (R - F.vcu + F.G - 1) / F.G : 0;
    const int base = R % F.G, L = F.G - base;
    const bool lightonly = L >= 64;
    const int sd = (F.vcu - base + F.G) % F.G;
    const int ns = lightonly ? ((sd < L && sd < 128) ? (128 - sd + L - 1) / L : 0) : ((sd < 128) ? 1 : 0);
    const int sstep = lightonly ? L : F.G;
#define MOE_ITEM(it_, e_, tile_) do { if ((it_) >= nr) { e_ = 256; tile_ = sd + ((it_) - nr) * sstep; } else { const int u_ = F.vcu + (it_) * F.G; int lo_ = 0, hi_ = 255; \
        while (lo_ < hi_) { const int mid_ = (lo_ + hi_ + 1) >> 1; if (prefix[mid_] <= u_) lo_ = mid_; else hi_ = mid_ - 1; } e_ = lo_; tile_ = u_ - prefix[lo_]; } } while (0)
#define MOE_FETCH(e_, tile_, tok_, yr_, wv_) do { tok_ = 0; yr_ = -1; wv_ = 0.f; if (tid < 128) { const int idx_ = (tile_) * 128 + tid; \
        if ((e_) == 256) { tok_ = idx_; yr_ = idx_ * 9 + 8; wv_ = 1.0f; } \
        else if (idx_ < cntl[e_]) { const u32x2 en_ = LIST2[(size_t)(e_) * LCAP + idx_]; tok_ = (int)(en_.x >> 3); yr_ = tok_ * 9 + (int)(en_.x & 7u); wv_ = __uint_as_float(en_.y); } } } while (0)
    int ptok = 0, pyr = -1; float pwv = 0.f;
    if (nr + ns > 0) { int e0, t0; MOE_ITEM(0, e0, t0); MOE_FETCH(e0, t0, ptok, pyr, pwv); }
    for (int it = 0; it < nr + ns; ++it) {
        int e, tile;
        MOE_ITEM(it, e, tile);
        if (tid < 128) { rtok[tid] = ptok; ryrow[tid] = pyr; rw[tid] = pwv; }
        BLOCK_SYNC();
        const float* Wg = (e == 256) ? ws_gate : w_gate + (size_t)e * 262144;
        const float* Wu = (e == 256) ? ws_up : w_up + (size_t)e * 262144;
        const float* Wd = (e == 256) ? ws_down : w_down + (size_t)e * 262144;
        const bf16* ap0 = H1B + (size_t)rtok[tid >> 3] * DM + lchunk * 8;
        const bf16* ap1 = H1B + (size_t)rtok[(tid >> 3) + 64] * DM + lchunk * 8;
#pragma unroll 1
        for (int c0 = 0; c0 < 256; c0 += 128) {
            const int s = 4 * lane;
            const float* bp = ((s & 32) ? Wu : Wg) + c0 + 32 * (s >> 6) + (s & 31);
            f32x4 acc[4][4]; zero_acc(acc);
            gemm_loopa<false, DM / 64, 256>(acc, F, ap0, ap1, bp, tile & 3);
#pragma unroll
            for (int m = 0; m < 4; ++m) {
                const int row = wr * 64 + m * 16 + fr;
#pragma unroll
                for (int n = 0; n < 2; ++n) {
                    const f32x4 gt = acc[m][n], up = acc[m][n + 2];
                    const float a0 = gt.x / (1.f + __expf(-gt.x)) * up.x, a1 = gt.y / (1.f + __expf(-gt.y)) * up.y, a2 = gt.z / (1.f + __expf(-gt.z)) * up.z, a3 = gt.w / (1.f + __expf(-gt.w)) * up.w;
                    const int col = c0 + 32 * wc + 16 * n + 4 * fq, kt = col >> 6, c64 = col & 63;
                    u32x2 wv; wv.x = pk2(a0, a1); wv.y = pk2(a2, a3);
                    *(LAS u32x2*)(lds + a_tile_off<true>(kt) + row * 128 + (((c64 >> 3) ^ (row & 7)) << 4) + (c64 & 7) * 2) = wv;
                }
            }
        }
        BLOCK_SYNC();
        if (it + 1 < nr + ns) { int e1, t1; MOE_ITEM(it + 1, e1, t1); MOE_FETCH(e1, t1, ptok, pyr, pwv); }
#pragma unroll 1
        for (int nc = 0; nc < 4; ++nc) {
            const int s = 4 * lane, sl = s & 63;
            const float* bp = Wd + nc * 256 + (s & 192) + 16 * ((sl >> 2) & 3) + 4 * (sl >> 4) + (sl & 3);
            f32x4 acc[4][4]; zero_acc(acc);
            gemm_loopa<true, 4, DM>(acc, F, nullptr, nullptr, bp, tile & 3);
#pragma unroll
            for (int m = 0; m < 4; ++m) {
                const int row = wr * 64 + m * 16 + fr;
                const int yr = ryrow[row]; const float wv = rw[row];
                if (yr >= 0) {
                    bf16* dst = YROWS + (size_t)yr * DM + nc * 256 + wc * 64 + 16 * fq;
                    u32x4 w0, w1;
                    w0.x = pk2(acc[m][0].x * wv, acc[m][0].y * wv); w0.y = pk2(acc[m][0].z * wv, acc[m][0].w * wv);
                    w0.z = pk2(acc[m][1].x * wv, acc[m][1].y * wv); w0.w = pk2(acc[m][1].z * wv, acc[m][1].w * wv);
                    w1.x = pk2(acc[m][2].x * wv, acc[m][2].y * wv); w1.y = pk2(acc[m][2].z * wv, acc[m][2].w * wv);
                    w1.z = pk2(acc[m][3].x * wv, acc[m][3].y * wv); w1.w = pk2(acc[m][3].z * wv, acc[m][3].w * wv);
                    *(u32x4*)dst = w0; *(u32x4*)(dst + 8) = w1;
                }
            }
        }
        BLOCK_SYNC();
    }
}

__device__ __forceinline__ void phase_final(const Frame& F, const float* g, const float* b, float* out) {
    const bf16* H1B = (const bf16*)(F.ws + WS_H1B);
    const bf16* YROWS = (const bf16*)(F.ws + WS_YROWS);
    const int gw = F.vcu * 8 + F.wave, NGW = F.G * 8, lane = F.lane;
    f32x4 gv[4], bv[4];
#pragma unroll
    for (int c = 0; c < 2; ++c)
#pragma unroll
        for (int hh = 0; hh < 2; ++hh) { gv[2 * c + hh] = *(const f32x4*)(g + 8 * lane + 512 * c + 4 * hh); bv[2 * c + hh] = *(const f32x4*)(b + 8 * lane + 512 * c + 4 * hh); }
    for (int row = gw; row < T_TOK; row += NGW) {
        float v[16];
#pragma unroll
        for (int c = 0; c < 2; ++c) {
            const u32x4 hv = *(const u32x4*)(H1B + (size_t)row * DM + 8 * lane + 512 * c);
            v[8 * c + 0] = ALPHA * bflo(hv.x); v[8 * c + 1] = ALPHA * bfhi(hv.x); v[8 * c + 2] = ALPHA * bflo(hv.y); v[8 * c + 3] = ALPHA * bfhi(hv.y);
            v[8 * c + 4] = ALPHA * bflo(hv.z); v[8 * c + 5] = ALPHA * bfhi(hv.z); v[8 * c + 6] = ALPHA * bflo(hv.w); v[8 * c + 7] = ALPHA * bfhi(hv.w);
#pragma unroll
            for (int sidx = 0; sidx < 9; ++sidx) {
                const u32x4 yv = *(const u32x4*)(YROWS + ((size_t)row * 9 + sidx) * DM + 8 * lane + 512 * c);
                v[8 * c + 0] += bflo(yv.x); v[8 * c + 1] += bfhi(yv.x); v[8 * c + 2] += bflo(yv.y); v[8 * c + 3] += bfhi(yv.y);
                v[8 * c + 4] += bflo(yv.z); v[8 * c + 5] += bfhi(yv.z); v[8 * c + 6] += bflo(yv.w); v[8 * c + 7] += bfhi(yv.w);
            }
        }
        float s = 0.f;
#pragma unroll
        for (int i = 0; i < 16; ++i) s += v[i];
        const float mean = wave_sum(s) * (1.f / DM); float s2 = 0.f;
#pragma unroll
        for (int i = 0; i < 16; ++i) { v[i] -= mean; s2 += v[i] * v[i]; }
        const float rstd = 1.f / sqrtf(wave_sum(s2) * (1.f / DM) + 1e-5f);
        float* orow = out + (size_t)row * DM + 8 * lane;
#pragma unroll
        for (int c = 0; c < 2; ++c)
#pragma unroll
            for (int hh = 0; hh < 2; ++hh) {
                f32x4 y;
                y.x = v[8 * c + 4 * hh + 0] * rstd; y.y = v[8 * c + 4 * hh + 1] * rstd; y.z = v[8 * c + 4 * hh + 2] * rstd; y.w = v[8 * c + 4 * hh + 3] * rstd;
                y = y * gv[2 * c + hh] + bv[2 * c + hh];
                *(f32x4*)(orow + 512 * c + 4 * hh) = y;
            }
    }
}

__global__ void __launch_bounds__(512, 2) fwd_kernel(Args a) {
    extern __shared__ __attribute__((aligned(16))) unsigned char lds_raw[];
    Frame F;
    F.lds = (LAS unsigned char*)lds_raw;
    F.tid = threadIdx.x; F.lane = F.tid & 63; F.wave = __builtin_amdgcn_readfirstlane(F.tid >> 6);
    F.G = gridDim.x; { const int bx = blockIdx.x; F.vcu = (F.G % 8 == 0) ? (bx % 8) * (F.G / 8) + bx / 8 : bx; }
    F.ws = a.ws;
    volatile LAS unsigned* MISC = (volatile LAS unsigned*)(F.lds + L_TAB + TB_MISC);
    if (F.tid < 16) MISC[F.tid] = 0u;
    __syncthreads();
    unsigned* ctl = (unsigned*)(a.ws + WS_CTL);
    const int lo = a.ph_lo, hi = a.ph_hi;
    XcdBarrier bar; bar.bar = ctl + CW_BAR; bar.x = 0; bar.st = MISC + 8;
    if (hi - lo > 1) bar = xcd_barrier_post(ctl + CW_BAR, MISC + 8);
#define IN(k) (lo <= (k) && (k) < hi)
#define SEAM(k) do { if (IN(k) && IN((k) + 1)) xcd_barrier(bar); } while (0)
    if (IN(0)) { phase0(F, a.in[0], a.in[1], a.in[2], a.in[3], a.in[4], a.in[9]); }
    SEAM(0);
    if (IN(1)) { phase1(F); }
    SEAM(1);
    if (IN(2)) {
        for (int su = F.vcu; su < 256; su += F.G) swa_unit(F, su, a.in[5], a.in[6]);
        for (int ku = F.vcu; ku < 512; ku += F.G) kv_unit(F, ku);
    }
    SEAM(2);
    if (IN(3)) { phase_scan(F); }
    SEAM(3);
    if (IN(4)) { for (int ku = F.vcu; ku < 512; ku += F.G) ret_unit(F, ku); }
    SEAM(4);
    if (IN(5)) { phase_outproj(F); }
    SEAM(5);
    if (IN(6)) { phase_router(F, a.in[7], a.in[8], a.in[9], a.in[10]); }
    SEAM(6);
    if (IN(7)) { phase_moe(F, a.in[11], a.in[12], a.in[13], a.in[14], a.in[15], a.in[16]); }
    SEAM(7);
    if (IN(8)) { phase_final(F, a.in[17], a.in[18], a.out); }
#undef IN
#undef SEAM
}

extern "C" void kernel_launch(void* const* d_in, const int* in_sizes, int n_in, void* d_out, int out_size, void* d_ws, size_t ws_size, hipStream_t stream) {
    static int grid = 0;
    if (grid == 0) {
        if (n_in != 19 || out_size != T_TOK * DM || ws_size < WS_END) { fprintf(stderr, "kernel_launch: unexpected problem shape (n_in %d out %d ws %zu)\n", n_in, out_size, ws_size); grid = -1; return; }
        int dev = 0, cus = 0, per_cu = 0;
        if (hipGetDevice(&dev) != hipSuccess || hipDeviceGetAttribute(&cus, hipDeviceAttributeMultiprocessorCount, dev) != hipSuccess) { grid = -1; return; }
        if (hipFuncSetAttribute((const void*)fwd_kernel, hipFuncAttributeMaxDynamicSharedMemorySize, LDS_BYTES) != hipSuccess) { fprintf(stderr, "kernel_launch: hipFuncSetAttribute failed\n"); grid = -1; return; }
        if (hipOccupancyMaxActiveBlocksPerMultiprocessor(&per_cu, (const void*)fwd_kernel, 512, LDS_BYTES) != hipSuccess || per_cu < 1)
            fprintf(stderr, "kernel_launch: occupancy query reports %d\n", per_cu);
        (void)hipGetLastError();
        grid = cus;
    }
    if (grid < 0) return;
    (void)hipMemsetAsync((char*)d_ws + WS_CTL, 0, CTL_BYTES, stream);
    Args a{};
    for (int i = 0; i < 19; ++i) a.in[i] = (const float*)d_in[i];
    a.out = (float*)d_out; a.ws = (unsigned char*)d_ws;
    if (MK_N_LAUNCHES == 1) {
        a.ph_lo = 0; a.ph_hi = NPHASE;
        hipLaunchKernelGGL(fwd_kernel, dim3(grid), dim3(512), LDS_BYTES, stream, a);
    } else {
        for (int p = 0; p < NPHASE; ++p) {
            a.ph_lo = p; a.ph_hi = p + 1;
            hipLaunchKernelGGL(fwd_kernel, dim3(grid), dim3(512), LDS_BYTES, stream, a);
        }
    }
}
```

```cpp
#include <hip/hip_runtime.h>
#include <cstdio>
#include <cstdint>

#ifndef MK_N_LAUNCHES
#define MK_N_LAUNCHES 1
#endif

#define LAS __attribute__((address_space(3)))
typedef unsigned short bf16;
typedef short bf16x8 __attribute__((ext_vector_type(8)));
typedef short s16x4 __attribute__((ext_vector_type(4)));
typedef float f32x4 __attribute__((ext_vector_type(4)));
typedef float f32x2 __attribute__((ext_vector_type(2)));
typedef unsigned u32x4 __attribute__((ext_vector_type(4)));
typedef unsigned u32x2 __attribute__((ext_vector_type(2)));
typedef __bf16 bf2_t __attribute__((ext_vector_type(2)));

constexpr int T_TOK = 16384, SEQ = 8192, DM = 1024, INW = 2304, NEXP = 256;
constexpr int NPHASE = 9;
constexpr float ALPHA = 1.189207115002721f;
constexpr int LCAP = 16384;

constexpr size_t MiB = 1u << 20;
constexpr size_t WS_CTL = 0, CTL_BYTES = 1 * MiB;
constexpr size_t WS_COS = 1 * MiB, WS_SIN = 2 * MiB;
constexpr size_t WS_H0B = 4 * MiB;
constexpr size_t WS_PROJ = 36 * MiB;
constexpr size_t WS_MIXIN = 108 * MiB;
constexpr size_t WS_PRE1 = 140 * MiB;
constexpr size_t WS_H1B = 204 * MiB;
constexpr size_t WS_KVT = 236 * MiB;
constexpr size_t WS_STATE = 252 * MiB;
constexpr size_t WS_LISTS = 260 * MiB;
constexpr size_t WS_ROWW = 276 * MiB;
constexpr size_t WS_YROWS = 280 * MiB;
constexpr size_t WS_WIMG = 576 * MiB;
constexpr int WIMG_IN = 0, WIMG_OUT = 144, WIMG_RT = 208, WIMG_N = 224;
constexpr size_t WS_WT_IN = 620 * MiB;
constexpr size_t WS_WT_OUT = 624 * MiB;
constexpr size_t WS_LIST2 = 584 * MiB;
constexpr size_t WS_END = 626 * MiB;
constexpr int CW_BAR = 4096;
constexpr int CW_CNT = 16384;

constexpr int L_BS0 = 0, L_AS0 = 65536, L_ACTLO = 114688, L_TAB = 147456, LDS_BYTES = 163840;
constexpr int TB_MISC = 0;
constexpr int TB_RTOK = 256;
constexpr int TB_RYROW = 768;
constexpr int TB_RW = 1280;
constexpr int TB_PREFIX = 2048;
constexpr int TB_HIST = 4096;
constexpr int TB_BASE = 5120;
constexpr int TB_SEL = 6144;
constexpr int TB_SELW = 10496;
constexpr int TB_CNT = 12544;
constexpr int TB_UNIT = 10240;

__device__ __forceinline__ unsigned pk2(float lo, float hi) { f32x2 v = {lo, hi}; bf2_t r = __builtin_convertvector(v, bf2_t); return __builtin_bit_cast(unsigned, r); }
__device__ __forceinline__ float bflo(unsigned u) { return __uint_as_float(u << 16); }
__device__ __forceinline__ float bfhi(unsigned u) { return __uint_as_float(u & 0xffff0000u); }
__device__ __forceinline__ float wave_sum(float v) {
#pragma unroll
    for (int o = 1; o < 64; o <<= 1) v += __shfl_xor(v, o);
    return v;
}
#define VM_WAIT() asm volatile("s_waitcnt vmcnt(0)" ::: "memory")
#define ALL_WAIT() asm volatile("s_waitcnt vmcnt(0) lgkmcnt(0)" ::: "memory")
#define BLOCK_SYNC() do { ALL_WAIT(); __syncthreads(); } while (0)

#define XB_TMO      128
#define XB_XCNT(j)  (256  + 64 * (j))
#define XB_XSUB(j)  (1280 + 64 * (j))
#define XB_XGEN(j)  (2304 + 64 * (j))
#define XB_TOP      3328
#define XB_TOPGEN   3392
#define XCD_BAR_WORDS 3456
#define XB_SPIN_CAP (1u << 18)
__device__ __forceinline__ unsigned xb_ld(unsigned* p)              { return __hip_atomic_load(p, __ATOMIC_RELAXED, __HIP_MEMORY_SCOPE_AGENT); }
__device__ __forceinline__ unsigned xb_add(unsigned* p, unsigned v) { return __hip_atomic_fetch_add(p, v, __ATOMIC_RELAXED, __HIP_MEMORY_SCOPE_AGENT); }
__device__ __forceinline__ unsigned xb_xcc_id() { return (unsigned)__builtin_amdgcn_s_getreg((3 << 11) | 20) & 0xFu; }
#define XB_SPIN(cond, bar) do { unsigned _sp = 0; while (cond) { __builtin_amdgcn_s_sleep(1); \
    if ((++_sp & 255u) == 0u) { if (xb_ld(&(bar)[XB_TMO])) break; if (_sp > XB_SPIN_CAP) { atomicAdd(&(bar)[XB_TMO], 1u); break; } } } } while (0)
struct XcdBarrier { unsigned* bar; unsigned x; volatile LAS unsigned* st; };
__device__ __forceinline__ XcdBarrier xcd_barrier_post(unsigned* bar, volatile LAS unsigned* st) {
    XcdBarrier b; b.bar = bar; b.x = xb_xcc_id(); b.st = st;
    if (threadIdx.x == 0) (void)xb_add(&bar[XB_XCNT(b.x)], 1u);
    return b;
}
__device__ __forceinline__ void xcd_barrier_complete(unsigned* bar, unsigned x, unsigned& nloc, unsigned& nx) {
    const unsigned G = gridDim.x * gridDim.y * gridDim.z;
    unsigned sum, cnt, mine, sp = 0u;
    for (;;) {
        sum = 0u; cnt = 0u; mine = 0u;
#pragma unroll
        for (unsigned j = 0; j < 16; ++j) { const unsigned c = xb_ld(&bar[XB_XCNT(j)]); sum += c; cnt += (c > 0u) ? 1u : 0u; mine = (j == x) ? c : mine; }
        if (sum == G) break;
        __builtin_amdgcn_s_sleep(1);
        if ((++sp & 255u) == 0u) { if (xb_ld(&bar[XB_TMO])) break; if (sp > XB_SPIN_CAP) { atomicAdd(&bar[XB_TMO], 1u); break; } }
    }
    nloc = mine > 0u ? mine : 1u; nx = cnt > 0u ? cnt : 1u;
}
__device__ __forceinline__ void xcd_barrier(const XcdBarrier& b) {
    asm volatile("s_waitcnt vmcnt(0)" ::: "memory");
    __syncthreads();
    if (threadIdx.x == 0) {
        unsigned* bar = b.bar;
        __builtin_amdgcn_s_waitcnt(0);
        unsigned nloc = b.st[0], nx = b.st[1];
        if (nloc == 0u) { xcd_barrier_complete(bar, b.x, nloc, nx); b.st[0] = nloc; b.st[1] = nx; }
        const unsigned old = xb_add(&bar[XB_XSUB(b.x)], 1u);
        const unsigned gen = old / nloc;
        if (old + 1u == (gen + 1u) * nloc) {
            __builtin_amdgcn_fence(__ATOMIC_RELEASE, "agent");
            asm volatile("s_waitcnt vmcnt(0)" ::: "memory");
            const unsigned og = xb_add(&bar[XB_TOP], 1u);
            const unsigned tg = og / nx;
            if (og + 1u == (tg + 1u) * nx) xb_add(&bar[XB_TOPGEN], 1u);
            else XB_SPIN(xb_ld(&bar[XB_TOPGEN]) == tg, bar);
            __builtin_amdgcn_fence(__ATOMIC_ACQUIRE, "agent");
            xb_add(&bar[XB_XGEN(b.x)], 1u);
            asm volatile("s_waitcnt vmcnt(0)" ::: "memory");
        } else {
            XB_SPIN(xb_ld(&bar[XB_XGEN(b.x)]) == gen, bar);
            __builtin_amdgcn_fence(__ATOMIC_ACQUIRE, "agent");
            asm volatile("s_waitcnt vmcnt(0)" ::: "memory");
        }
    }
    __syncthreads();
}


namespace pg8 {
#define PG8_LAS __attribute__((address_space(3)))
typedef unsigned short bf16_t;
constexpr int BM = 256, BK = 64, HALF = 128, HTB = HALF * BK * 2;
__host__ __device__ __forceinline__ int lds_byte(int r, int c) { const int st = (r >> 4) * 2 + (c >> 5), rr = r & 15, cc = c & 31, ob = rr * 64 + cc * 2; return st * 1024 + (ob ^ (((ob >> 9) & 1) << 5)); }
__host__ __device__ __forceinline__ void stage_rc(int b, int& R, int& C) { const int st = b / 1024, sb = b % 1024, swz = sb ^ (((sb >> 9) & 1) << 5); R = (st >> 1) * 16 + swz / 64; C = (st & 1) * 32 + (swz % 64) / 2; }
struct Unit { int pm, pn; };
struct Gemm { const bf16_t* A; const bf16_t* Bt; int K; };
template <class Epi, class Sched>
__device__ __forceinline__ void gemm_phase(PG8_LAS unsigned char* lds, const Gemm g, const Sched& S, const Epi& E) {
    const int tid = threadIdx.x, wid = __builtin_amdgcn_readfirstlane(tid >> 6), lane = tid & 63, wr = wid >> 2, wc = wid & 3, fr = lane & 15, fq = lane >> 4;
    const int K = g.K, nt = K / BK;
    unsigned voffA[2], voffB[2];
#pragma unroll
    for (int i = 0; i < 2; ++i) { int R, C; stage_rc(tid * 16 + i * 8192, R, C); voffA[i] = (unsigned)(R * K + C) * 2u; voffB[i] = (unsigned)(R * K + C) * 2u; }
    const size_t kstep = (size_t)(BK * 2);
    const size_t hstep = (size_t)HALF * K * 2;
    const size_t tstep = 2 * hstep;
    const unsigned ldsw = (unsigned)wid * 1024u;
    const int aoff = lds_byte(wr * 64 + fr, fq * 8), boff = lds_byte(wc * 32 + fr, fq * 8);
#define PG8_SA(b, h) (((b) * 2 + (h)) * HTB)
#define PG8_SB(b, h) ((4 + (b) * 2 + (h)) * HTB)
#define PG8_STAGE(bufoff, gbase, voff) do { _Pragma("unroll") for (int _i = 0; _i < 2; ++_i) \
        __builtin_amdgcn_global_load_lds((const unsigned*)((const char*)(gbase) + (voff)[_i]), (PG8_LAS unsigned*)(lds + (bufoff) + ldsw + _i * 8192), 16, 0, 0); } while (0)
#define PG8_LDA(dst, b, h) do { _Pragma("unroll") for (int m = 0; m < 4; ++m) _Pragma("unroll") for (int k = 0; k < 2; ++k) dst[m][k] = *(const PG8_LAS bf16x8*)(lds + PG8_SA(b, h) + aoff + m * 2048 + k * 1024); } while (0)
#define PG8_LDB(dst, b, h) do { _Pragma("unroll") for (int n = 0; n < 2; ++n) _Pragma("unroll") for (int k = 0; k < 2; ++k) dst[n][k] = *(const PG8_LAS bf16x8*)(lds + PG8_SB(b, h) + boff + n * 2048 + k * 1024); } while (0)
#define PG8_MMA(ai, bj, At, Bt) do { __builtin_amdgcn_s_setprio(1); _Pragma("unroll") for (int m = 0; m < 4; ++m) _Pragma("unroll") for (int n = 0; n < 2; ++n) _Pragma("unroll") for (int k = 0; k < 2; ++k) \
        acc[ai][bj][m][n] = __builtin_amdgcn_mfma_f32_16x16x32_bf16(Bt[n][k], At[m][k], acc[ai][bj][m][n], 0, 0, 0); __builtin_amdgcn_s_setprio(0); } while (0)
#define PG8_WAIT_V(n) asm volatile("s_waitcnt vmcnt(" #n ")" ::: "memory")
#define PG8_WAIT_L(n) asm volatile("s_waitcnt lgkmcnt(" #n ")" ::: "memory")
#define PG8_BAR __builtin_amdgcn_s_barrier()
#define PG8_SCHED __builtin_amdgcn_sched_barrier(0)
    Unit cur, nxt; int ui = 0;
    if (!S.next(0, cur)) return;
    f32x4 acc[2][2][4][2];
#pragma unroll
    for (int a = 0; a < 2; ++a)
#pragma unroll
        for (int b = 0; b < 2; ++b)
#pragma unroll
            for (int m = 0; m < 4; ++m)
#pragma unroll
                for (int n = 0; n < 2; ++n) acc[a][b][m][n] = (f32x4){0.f, 0.f, 0.f, 0.f};
    bf16x8 At[4][2], B0[2][2], B1[2][2];
    const char* cA = (const char*)g.A + (size_t)cur.pm * tstep; const char* cB = (const char*)g.Bt + (size_t)cur.pn * tstep;
    PG8_STAGE(PG8_SB(0, 0), cB, voffB); PG8_STAGE(PG8_SA(0, 0), cA, voffA); PG8_STAGE(PG8_SB(0, 1), cB + hstep, voffB); PG8_STAGE(PG8_SA(0, 1), cA + hstep, voffA);
    if (wr == 1) PG8_BAR;
    PG8_WAIT_V(4); PG8_BAR;
    PG8_STAGE(PG8_SB(1, 0), cB + kstep, voffB); PG8_STAGE(PG8_SA(1, 0), cA + kstep, voffA); PG8_STAGE(PG8_SB(1, 1), cB + hstep + kstep, voffB);
    PG8_WAIT_V(6); PG8_BAR;
    for (;;) {
        const bool has_next = S.next(ui + 1, nxt);
        const char* nA = has_next ? (const char*)g.A + (size_t)nxt.pm * tstep : cA; const char* nB = has_next ? (const char*)g.Bt + (size_t)nxt.pn * tstep : cB;
        for (int t = 0; t < nt; t += 2) {
            const bool last = (t == nt - 2);
            const char* a1 = cA + (size_t)(t + 1) * kstep;
            const char* a2 = last ? nA : cA + (size_t)(t + 2) * kstep; const char* b2 = last ? nB : cB + (size_t)(t + 2) * kstep;
            const char* a3 = a2 + kstep; const char* b3 = b2 + kstep;
            PG8_LDB(B0, 0, 0); PG8_SCHED; PG8_LDA(At, 0, 0); PG8_STAGE(PG8_SA(1, 1), a1 + hstep, voffA);
            PG8_WAIT_L(8); PG8_BAR; PG8_WAIT_L(0); PG8_MMA(0, 0, At, B0); PG8_BAR; PG8_SCHED;
            PG8_LDB(B1, 0, 1); PG8_STAGE(PG8_SB(0, 0), b2, voffB);
            PG8_BAR; PG8_WAIT_L(0); PG8_MMA(0, 1, At, B1); PG8_BAR;
            PG8_LDA(At, 0, 1); PG8_STAGE(PG8_SA(0, 0), a2, voffA);
            PG8_BAR; PG8_WAIT_L(0); PG8_MMA(1, 0, At, B0); PG8_BAR; PG8_SCHED;
            PG8_STAGE(PG8_SB(0, 1), b2 + hstep, voffB);
            PG8_WAIT_V(6); PG8_BAR; PG8_MMA(1, 1, At, B1); PG8_BAR;
            PG8_LDB(B0, 1, 0); PG8_SCHED; PG8_LDA(At, 1, 0); PG8_STAGE(PG8_SA(0, 1), a2 + hstep, voffA);
            PG8_WAIT_L(8); PG8_BAR; PG8_WAIT_L(0); PG8_MMA(0, 0, At, B0); PG8_BAR; PG8_SCHED;
            PG8_LDB(B1, 1, 1); PG8_STAGE(PG8_SB(1, 0), b3, voffB);
            PG8_BAR; PG8_WAIT_L(0); PG8_MMA(0, 1, At, B1); PG8_BAR;
            PG8_LDA(At, 1, 1); PG8_STAGE(PG8_SA(1, 0), a3, voffA);
            PG8_BAR; PG8_WAIT_L(0); PG8_MMA(1, 0, At, B0); PG8_BAR; PG8_SCHED;
            PG8_STAGE(PG8_SB(1, 1), b3 + hstep, voffB);
            PG8_WAIT_V(6); PG8_BAR; PG8_MMA(1, 1, At, B1); PG8_BAR;
        }
            E(acc, cur, wr, wc, fr, fq);
            if (!has_next) break;
#pragma unroll
        for (int a = 0; a < 2; ++a)
#pragma unroll
            for (int b = 0; b < 2; ++b)
#pragma unroll
                for (int m = 0; m < 4; ++m)
#pragma unroll
                    for (int n = 0; n < 2; ++n) acc[a][b][m][n] = (f32x4){0.f, 0.f, 0.f, 0.f};
        cur = nxt; cA = nA; cB = nB; ++ui;
    }
    PG8_WAIT_V(0);
    if (wr == 0) PG8_BAR;
    PG8_BAR;
#undef PG8_SA
#undef PG8_SB
#undef PG8_STAGE
#undef PG8_LDA
#undef PG8_LDB
#undef PG8_MMA
#undef PG8_WAIT_V
#undef PG8_WAIT_L
#undef PG8_BAR
#undef PG8_SCHED
}
}

struct Args {
    const float* in[19];
    float* out;
    unsigned char* ws;
    int ph_lo, ph_hi;
};
struct Frame {
    LAS unsigned char* lds;
    int tid, lane, wave, vcu, G;
    unsigned char* ws;
};

template <int MT, int KH0 = 0, int KH1 = 2>
__device__ __forceinline__ void mma_ktile(f32x4 (&acc)[MT][4], LAS const unsigned char* As, LAS const unsigned char* Bs, const unsigned (&foa)[2], const unsigned (&fob)[2][2]) {
#pragma unroll
    for (int kh = KH0; kh < KH1; ++kh) {
        bf16x8 af[MT], bfr[4];
#pragma unroll
        for (int m = 0; m < MT; ++m) af[m] = *(LAS const bf16x8*)(As + m * 2048 + foa[kh]);
#pragma unroll
        for (int n = 0; n < 4; ++n) bfr[n] = *(LAS const bf16x8*)(Bs + n * 2048 + fob[kh][n & 1]);
#pragma unroll
        for (int m = 0; m < MT; ++m)
#pragma unroll
            for (int n = 0; n < 4; ++n)
                acc[m][n] = __builtin_amdgcn_mfma_f32_16x16x32_bf16(bfr[n], af[m], acc[m][n], 0, 0, 0);
    }
}
__device__ __forceinline__ void loadB32(f32x4 (&r)[8], const float* p, size_t ldb) {
#pragma unroll
    for (int i = 0; i < 8; ++i) { r[i] = *(const f32x4*)p; p += ldb; }
}
__device__ __forceinline__ void storeB32(const f32x4 (&r)[8], LAS unsigned char* Bs, int n0, int c) {
#pragma unroll
    for (int j = 0; j < 4; ++j) {
        u32x4 w; w.x = pk2(r[0][j], r[1][j]); w.y = pk2(r[2][j], r[3][j]); w.z = pk2(r[4][j], r[5][j]); w.w = pk2(r[6][j], r[7][j]);
        const int n = n0 + j, x = (n >> 3) & 3, g = ((x & 1) << 1) | (x >> 1);
        *(LAS u32x4*)(Bs + n * 128 + ((c ^ (n & 7) ^ g) << 4)) = w;
    }
}
template <int MT>
__device__ __forceinline__ void dmaA(LAS unsigned char* As, const bf16* p0, const bf16* p1, int wave) {
    __builtin_amdgcn_global_load_lds((const unsigned*)p0, (LAS unsigned*)(As + wave * 1024), 16, 0, 0);
    if (MT == 4) __builtin_amdgcn_global_load_lds((const unsigned*)p1, (LAS unsigned*)(As + wave * 1024 + 8192), 16, 0, 0);
}
#define LGKM_BAR() do { asm volatile("s_waitcnt lgkmcnt(0)" ::: "memory"); __builtin_amdgcn_s_barrier(); asm volatile("" ::: "memory"); } while (0)
template <bool A_LDS>
__device__ __forceinline__ int a_tile_off(int t) { return A_LDS ? ((t < 2) ? L_ACTLO + t * 16384 : L_AS0 + (t - 2) * 16384) : L_AS0 + (t % 3) * 16384; }
template <bool A_LDS, int MT = 4>
__device__ __forceinline__ void gemm_loop(f32x4 (&acc)[MT][4], const Frame& F, const bf16* ap0, const bf16* ap1, const float* bp, size_t ldb, int nk, int rot = 0) {
    LAS unsigned char* lds = F.lds;
    const int lane = F.lane, wave = F.wave, wr = wave >> 2, wc = wave & 3, fr = lane & 15, fq = lane >> 4;
    unsigned foa[2], fob[2][2];
#pragma unroll
    for (int kh = 0; kh < 2; ++kh) {
        foa[kh] = (unsigned)(fr * 128 + ((((4 * kh + fq)) ^ (fr & 7)) << 4));
#pragma unroll
        for (int par = 0; par < 2; ++par) fob[kh][par] = (unsigned)(fr * 128 + (((4 * kh + fq) ^ (fr & 7) ^ ((fr >> 3) << 1) ^ par) << 4));
    }
    const int n0 = 4 * lane;
    const float* bpp = bp + (size_t)(8 * wave) * ldb;
    const size_t tstep = 64 * ldb;
    f32x4 r0[8], r1[8];
#define WAITV(more) do { if (more) { if (A_LDS) asm volatile("s_waitcnt vmcnt(8)" ::: "memory"); else if (MT == 4) asm volatile("s_waitcnt vmcnt(10)" ::: "memory"); else asm volatile("s_waitcnt vmcnt(9)" ::: "memory"); } else asm volatile("s_waitcnt vmcnt(0)" ::: "memory"); } while (0)
#define KT(t) (((t) ^ rot) & (nk - 1))
#define ENDWAIT(nb, na) do { if (nb) { if (A_LDS) asm volatile("s_waitcnt vmcnt(8)" ::: "memory"); else if (MT == 4) asm volatile("s_waitcnt vmcnt(10)" ::: "memory"); else asm volatile("s_waitcnt vmcnt(9)" ::: "memory"); } \
                             else if ((na) && !A_LDS) { if (MT == 4) asm volatile("s_waitcnt vmcnt(2)" ::: "memory"); else asm volatile("s_waitcnt vmcnt(1)" ::: "memory"); } \
                             else asm volatile("s_waitcnt vmcnt(0)" ::: "memory"); } while (0)
    loadB32(r0, bpp + (size_t)KT(0) * tstep, ldb);
    if (!A_LDS) dmaA<MT>(lds + L_AS0, ap0 + KT(0) * 64, ap1 + KT(0) * 64, wave);
    if (nk > 1) { loadB32(r1, bpp + (size_t)KT(1) * tstep, ldb); if (!A_LDS) dmaA<MT>(lds + L_AS0 + 16384, ap0 + KT(1) * 64, ap1 + KT(1) * 64, wave); }
    __builtin_amdgcn_sched_barrier(0);
    WAITV(nk > 1);
    storeB32(r0, lds + L_BS0, n0, wave);
    if (nk > 2) loadB32(r0, bpp + (size_t)KT(2) * tstep, ldb);
    __builtin_amdgcn_sched_barrier(0);
    if (nk > 2) { asm volatile("s_waitcnt vmcnt(8)" ::: "memory"); } else asm volatile("s_waitcnt vmcnt(0)" ::: "memory");
    LGKM_BAR();
    for (int t = 0; t < nk; t += 2) {
        if (t + 1 < nk) storeB32(r1, lds + L_BS0 + 32768, n0, wave);
        if (t + 3 < nk) loadB32(r1, bpp + (size_t)KT(t + 3) * tstep, ldb);
        __builtin_amdgcn_sched_barrier(0);
        mma_ktile<MT, 0, 1>(acc, lds + (A_LDS ? a_tile_off<true>(KT(t)) : a_tile_off<false>(t)) + wr * (MT * 2048), lds + L_BS0 + wc * 8192, foa, fob);
        __builtin_amdgcn_sched_barrier(0);
        if (t + 2 < nk) { if (!A_LDS) dmaA<MT>(lds + a_tile_off<false>(t + 2), ap0 + KT(t + 2) * 64, ap1 + KT(t + 2) * 64, wave); }
        __builtin_amdgcn_sched_barrier(0);
        mma_ktile<MT, 1, 2>(acc, lds + (A_LDS ? a_tile_off<true>(KT(t)) : a_tile_off<false>(t)) + wr * (MT * 2048), lds + L_BS0 + wc * 8192, foa, fob);
        __builtin_amdgcn_sched_barrier(0);
        ENDWAIT(t + 3 < nk, t + 2 < nk);
        LGKM_BAR();
        if (t + 1 >= nk) break;
        if (t + 2 < nk) storeB32(r0, lds + L_BS0, n0, wave);
        if (t + 4 < nk) loadB32(r0, bpp + (size_t)KT(t + 4) * tstep, ldb);
        __builtin_amdgcn_sched_barrier(0);
        mma_ktile<MT, 0, 1>(acc, lds + (A_LDS ? a_tile_off<true>(KT(t + 1)) : a_tile_off<false>(t + 1)) + wr * (MT * 2048), lds + L_BS0 + 32768 + wc * 8192, foa, fob);
        __builtin_amdgcn_sched_barrier(0);
        if (t + 3 < nk) { if (!A_LDS) dmaA<MT>(lds + a_tile_off<false>(t + 3), ap0 + KT(t + 3) * 64, ap1 + KT(t + 3) * 64, wave); }
        __builtin_amdgcn_sched_barrier(0);
        mma_ktile<MT, 1, 2>(acc, lds + (A_LDS ? a_tile_off<true>(KT(t + 1)) : a_tile_off<false>(t + 1)) + wr * (MT * 2048), lds + L_BS0 + 32768 + wc * 8192, foa, fob);
        __builtin_amdgcn_sched_barrier(0);
        ENDWAIT(t + 4 < nk, t + 3 < nk);
        LGKM_BAR();
    }
#undef ENDWAIT
#undef WAITV
#undef KT
}
template <int OFF>
__device__ __forceinline__ void gld16(f32x4& d, const float* p) { asm volatile("global_load_dwordx4 %0, %1, off offset:%2" : "=&v"(d) : "v"(p), "n"(OFF) : "memory"); }
template <int LDB>
__device__ __forceinline__ void loadB32a(f32x4 (&r)[8], const float* p) {
    if (LDB == 256) {
        const float* q = p + 4 * LDB;
        gld16<-4096>(r[0], q); gld16<-3072>(r[1], q); gld16<-2048>(r[2], q); gld16<-1024>(r[3], q); gld16<0>(r[4], q); gld16<1024>(r[5], q); gld16<2048>(r[6], q); gld16<3072>(r[7], q);
    } else {
        const float* q0 = p + LDB; const float* q1 = p + 3 * LDB; const float* q2 = p + 5 * LDB; const float* q3 = p + 7 * LDB;
        gld16<-4096>(r[0], q0); gld16<0>(r[1], q0); gld16<-4096>(r[2], q1); gld16<0>(r[3], q1); gld16<-4096>(r[4], q2); gld16<0>(r[5], q2); gld16<-4096>(r[6], q3); gld16<0>(r[7], q3);
    }
}
#define TIE8(r) "+v"(r[0]), "+v"(r[1]), "+v"(r[2]), "+v"(r[3]), "+v"(r[4]), "+v"(r[5]), "+v"(r[6]), "+v"(r[7])
template <int N> __device__ __forceinline__ void wait_vmc() {
    static_assert(N >= 0 && N <= 12 && N % 2 == 0, "vmcnt");
    if (N == 0) asm volatile("s_waitcnt vmcnt(0)" ::: "memory"); else if (N == 2) asm volatile("s_waitcnt vmcnt(2)" ::: "memory"); else if (N == 4) asm volatile("s_waitcnt vmcnt(4)" ::: "memory");
    else if (N == 6) asm volatile("s_waitcnt vmcnt(6)" ::: "memory"); else if (N == 8) asm volatile("s_waitcnt vmcnt(8)" ::: "memory"); else if (N == 10) asm volatile("s_waitcnt vmcnt(10)" ::: "memory");
    else asm volatile("s_waitcnt vmcnt(12)" ::: "memory");
}
template <bool A_LDS, int NK, int LDB, bool LATE = false>
__device__ __forceinline__ void gemm_loopa(f32x4 (&acc)[4][4], const Frame& F, const bf16* ap0, const bf16* ap1, const float* bp, int rot) {
    static_assert(LDB == 256 || LDB == 1024, "row pitch of the f32 B source");
    constexpr int MT = 4;
    LAS unsigned char* lds = F.lds;
    const int lane = F.lane, wave = F.wave, wr = wave >> 2, wc = wave & 3, fr = lane & 15, fq = lane >> 4;
    unsigned foa[2], fob[2][2];
#pragma unroll
    for (int kh = 0; kh < 2; ++kh) {
        foa[kh] = (unsigned)(fr * 128 + ((((4 * kh + fq)) ^ (fr & 7)) << 4));
#pragma unroll
        for (int par = 0; par < 2; ++par) fob[kh][par] = (unsigned)(fr * 128 + (((4 * kh + fq) ^ (fr & 7) ^ ((fr >> 3) << 1) ^ par) << 4));
    }
    const int n0 = 4 * lane;
    const float* bpp = bp + (size_t)(8 * wave) * LDB;
    constexpr size_t tstep = (size_t)64 * LDB;
    f32x4 r0[8], r1[8];
#define KT(t) (((t) ^ rot) & (NK - 1))
#define XWAIT(nb, na, RS) do { if (nb) { if (A_LDS) asm volatile("s_waitcnt vmcnt(8)" : TIE8(RS) :: "memory"); else asm volatile("s_waitcnt vmcnt(10)" : TIE8(RS) :: "memory"); } \
                               else if ((na) && !A_LDS) asm volatile("s_waitcnt vmcnt(2)" : TIE8(RS) :: "memory"); \
                               else asm volatile("s_waitcnt vmcnt(0)" : TIE8(RS) :: "memory"); } while (0)
#define X_ATILE(t) (lds + (A_LDS ? a_tile_off<true>(KT(t)) : a_tile_off<false>(t)) + wr * (MT * 2048))
#define X_EVEN(t, H1, H2, H3) do { \
        if (H1) storeB32(r1, lds + L_BS0 + 32768, n0, wave); \
        if (H3) loadB32a<LDB>(r1, bpp + (size_t)KT((t) + 3) * tstep); \
        __builtin_amdgcn_sched_barrier(0); \
        mma_ktile<MT, 0, 1>(acc, X_ATILE(t), lds + L_BS0 + wc * 8192, foa, fob); \
        __builtin_amdgcn_sched_barrier(0); \
        if ((H2) && !A_LDS) dmaA<MT>(lds + a_tile_off<false>((t) + 2), ap0 + KT((t) + 2) * 64, ap1 + KT((t) + 2) * 64, wave); \
        __builtin_amdgcn_sched_barrier(0); \
        mma_ktile<MT, 1, 2>(acc, X_ATILE(t), lds + L_BS0 + wc * 8192, foa, fob); \
        __builtin_amdgcn_sched_barrier(0); \
        XWAIT(H3, H2, r0); \
        LGKM_BAR(); } while (0)
#define X_ODD(t, H2, H3, H4) do { \
        if (H2) storeB32(r0, lds + L_BS0, n0, wave); \
        if (H4) loadB32a<LDB>(r0, bpp + (size_t)KT((t) + 4) * tstep); \
        __builtin_amdgcn_sched_barrier(0); \
        mma_ktile<MT, 0, 1>(acc, X_ATILE((t) + 1), lds + L_BS0 + 32768 + wc * 8192, foa, fob); \
        __builtin_amdgcn_sched_barrier(0); \
        if ((H3) && !A_LDS) dmaA<MT>(lds + a_tile_off<false>((t) + 3), ap0 + KT((t) + 3) * 64, ap1 + KT((t) + 3) * 64, wave); \
        __builtin_amdgcn_sched_barrier(0); \
        mma_ktile<MT, 1, 2>(acc, X_ATILE((t) + 1), lds + L_BS0 + 32768 + wc * 8192, foa, fob); \
        __builtin_amdgcn_sched_barrier(0); \
        XWAIT(H4, H3, r1); \
        LGKM_BAR(); } while (0)
    loadB32a<LDB>(r0, bpp + (size_t)KT(0) * tstep);
    if (!A_LDS) dmaA<MT>(lds + L_AS0, ap0 + KT(0) * 64, ap1 + KT(0) * 64, wave);
    loadB32a<LDB>(r1, bpp + (size_t)KT(1) * tstep);
    if (!A_LDS) dmaA<MT>(lds + L_AS0 + 16384, ap0 + KT(1) * 64, ap1 + KT(1) * 64, wave);
    __builtin_amdgcn_sched_barrier(0);
    if (A_LDS) asm volatile("s_waitcnt vmcnt(8)" : TIE8(r0) :: "memory"); else asm volatile("s_waitcnt vmcnt(10)" : TIE8(r0) :: "memory");
    storeB32(r0, lds + L_BS0, n0, wave);
    loadB32a<LDB>(r0, bpp + (size_t)KT(2) * tstep);
    __builtin_amdgcn_sched_barrier(0);
    asm volatile("s_waitcnt vmcnt(8)" : TIE8(r1) :: "memory");
    LGKM_BAR();
    constexpr int T0 = (NK > 4) ? ((NK - 3) / 2) * 2 : 0;
    if (!LATE) {
#pragma unroll 1
        for (int t = 0; t < T0; t += 2) { X_EVEN(t, true, true, true); X_ODD(t, true, true, true); }
#pragma unroll
        for (int t = T0; t < NK; t += 2) { X_EVEN(t, t + 1 < NK, t + 2 < NK, t + 3 < NK); X_ODD(t, t + 2 < NK, t + 3 < NK, t + 4 < NK); }
    } else {
#define L_NB(s) ((s) + 3 < NK)
#define L_NA(s) (!A_LDS && (s) + 2 < NK)
#define L_STEP(s, RS, BOFF, WA, WB) do { \
        mma_ktile<MT, 0, 2>(acc, X_ATILE(s), lds + L_BS0 + (BOFF) + wc * 8192, foa, fob); \
        __builtin_amdgcn_sched_barrier(0); \
        if ((s) + 1 < NK) { wait_vmc<WA>(); asm volatile("" : TIE8(RS) :: "memory"); storeB32(RS, lds + L_BS0 + (32768 - (BOFF)), n0, wave); } \
        if (L_NB(s)) loadB32a<LDB>(RS, bpp + (size_t)KT((s) + 3) * tstep); \
        if (L_NA(s)) dmaA<MT>(lds + a_tile_off<false>((s) + 2), ap0 + KT((s) + 2) * 64, ap1 + KT((s) + 2) * 64, wave); \
        __builtin_amdgcn_sched_barrier(0); \
        if (!A_LDS && (s) + 1 < NK) wait_vmc<WB>(); \
        LGKM_BAR(); } while (0)
        constexpr int WAS = A_LDS ? 8 : 10, WBS = 10;
#pragma unroll 1
        for (int t = 0; t < T0; t += 2) { L_STEP(t, r1, 0, WAS, WBS); L_STEP(t + 1, r0, 32768, WAS, WBS); }
#define L_WA(s) ((((s) >= 2 ? L_NA((s) - 2) : ((s) == 0 && !A_LDS)) ? 2 : 0) + (((s) >= 1 ? L_NB((s) - 1) : true) ? 8 : 0) + (((s) >= 1 && L_NA((s) - 1)) ? 2 : 0))
#define L_WB(s) ((L_NB(s) ? 8 : 0) + (L_NA(s) ? 2 : 0))
#define L_TAIL(s, RS, BOFF) L_STEP(s, RS, BOFF, (L_WA(s) > 10 ? 10 : L_WA(s)), L_WB(s))
        static_assert(T0 % 2 == 0 && NK - T0 == 4, "tail of four steps");
        L_TAIL(T0, r1, 0); L_TAIL(T0 + 1, r0, 32768); L_TAIL(T0 + 2, r1, 0); L_TAIL(T0 + 3, r0, 32768);
#undef L_TAIL
#undef L_WA
#undef L_WB
#undef L_STEP
#undef L_NA
#undef L_NB
    }
#undef X_EVEN
#undef X_ODD
#undef X_ATILE
#undef XWAIT
#undef KT
}
__device__ __forceinline__ int swz4(int row) { return (0x78 >> (2 * ((row >> 2) & 3))) & 3; }
template <int MT>
__device__ __forceinline__ void gemm_ring(f32x4 (&acc)[MT][4], const Frame& F, const bf16* abase, const unsigned (&aoff)[2], const bf16* bblk, int nst) {
    LAS unsigned char* lds = F.lds;
    const int tid = F.tid, lane = F.lane, wave = F.wave, wr = wave >> 2, wc = wave & 3, fr = lane & 15, fq = lane >> 4;
    const unsigned fo = (unsigned)(fr * 64 + ((fq ^ swz4(fr)) << 4));
    const unsigned boff = (unsigned)(tid * 16);
    const bool a_wave = (MT != 2) || (wave < 4);
#define RG_STAGE(t) do { const int sl_ = ((t) & 3) * 32768; \
        _Pragma("unroll") for (int i = 0; i < 2; ++i) __builtin_amdgcn_global_load_lds((const unsigned*)((const char*)bblk + (size_t)(t) * 16384 + boff + i * 8192), (LAS unsigned*)(lds + sl_ + 16384 + wave * 1024 + i * 8192), 16, 0, 0); \
        if (MT == 8) { _Pragma("unroll") for (int i = 0; i < 2; ++i) __builtin_amdgcn_global_load_lds((const unsigned*)((const char*)abase + (size_t)(t) * 64 + aoff[i]), (LAS unsigned*)(lds + sl_ + wave * 1024 + i * 8192), 16, 0, 0); } \
        else if (a_wave) __builtin_amdgcn_global_load_lds((const unsigned*)((const char*)abase + (size_t)(t) * 64 + aoff[0]), (LAS unsigned*)(lds + sl_ + wave * 1024), 16, 0, 0); } while (0)
#define RG_WAIT(k) do { if (MT == 8) { if ((k) == 2) asm volatile("s_waitcnt vmcnt(8)" ::: "memory"); else if ((k) == 1) asm volatile("s_waitcnt vmcnt(4)" ::: "memory"); else asm volatile("s_waitcnt vmcnt(0)" ::: "memory"); } \
        else if (a_wave) { if ((k) == 2) asm volatile("s_waitcnt vmcnt(6)" ::: "memory"); else if ((k) == 1) asm volatile("s_waitcnt vmcnt(3)" ::: "memory"); else asm volatile("s_waitcnt vmcnt(0)" ::: "memory"); } \
        else { if ((k) == 2) asm volatile("s_waitcnt vmcnt(4)" ::: "memory"); else if ((k) == 1) asm volatile("s_waitcnt vmcnt(2)" ::: "memory"); else asm volatile("s_waitcnt vmcnt(0)" ::: "memory"); } } while (0)
    RG_STAGE(0);
    if (nst > 1) RG_STAGE(1);
    if (nst > 2) RG_STAGE(2);
#pragma unroll 1
    for (int t = 0; t < nst; ++t) {
        const int ahead = (nst - 1 - t) < 2 ? (nst - 1 - t) : 2;
        if (ahead == 2) RG_WAIT(2); else if (ahead == 1) RG_WAIT(1); else RG_WAIT(0);
        LGKM_BAR();
        __builtin_amdgcn_sched_barrier(0);
        {
            LAS const unsigned char* As = lds + (t & 3) * 32768 + wr * (MT * 1024);
            LAS const unsigned char* Bs = lds + (t & 3) * 32768 + 16384 + wc * 4096;
            bf16x8 bfr[4];
#pragma unroll
            for (int n = 0; n < 4; ++n) bfr[n] = *(LAS const bf16x8*)(Bs + n * 1024 + fo);
            constexpr int MH = MT > 4 ? 4 : MT;
#pragma unroll
            for (int m0 = 0; m0 < MT; m0 += MH) {
                bf16x8 af[MH];
#pragma unroll
                for (int m = 0; m < MH; ++m) af[m] = *(LAS const bf16x8*)(As + (m0 + m) * 1024 + fo);
#pragma unroll
                for (int m = 0; m < MH; ++m)
#pragma unroll
                    for (int n = 0; n < 4; ++n)
                        acc[m0 + m][n] = __builtin_amdgcn_mfma_f32_16x16x32_bf16(bfr[n], af[m], acc[m0 + m][n], 0, 0, 0);
                if (m0 == 0) {
                    __builtin_amdgcn_sched_barrier(0);
                    if (t + 3 < nst) RG_STAGE(t + 3);
                    __builtin_amdgcn_sched_barrier(0);
                }
            }
        }
        __builtin_amdgcn_sched_barrier(0);
    }
    LGKM_BAR();
#undef RG_STAGE
#undef RG_WAIT
}
__device__ __forceinline__ void ring_aoff(unsigned (&aoff)[2], int tid, int ld_elems) {
#pragma unroll
    for (int i = 0; i < 2; ++i) { const int p = tid + 512 * i, row = p >> 2, lc = (p & 3) ^ swz4(row); aoff[i] = (unsigned)(row * ld_elems + lc * 8) * 2u; }
}
template <int MT>
__device__ __forceinline__ void zero_accT(f32x4 (&acc)[MT][4]) {
#pragma unroll
    for (int m = 0; m < MT; ++m)
#pragma unroll
        for (int n = 0; n < 4; ++n) acc[m][n] = (f32x4){0.f, 0.f, 0.f, 0.f};
}
__device__ __forceinline__ void convert_block(const Frame& F, const float* colp, size_t ldb, int kt, bf16* blk) {
    f32x4 r[8];
    loadB32(r, colp + (size_t)(kt * 64 + 8 * F.wave) * ldb, ldb);
#pragma unroll
    for (int j = 0; j < 4; ++j) {
        u32x4 w; w.x = pk2(r[0][j], r[1][j]); w.y = pk2(r[2][j], r[3][j]); w.z = pk2(r[4][j], r[5][j]); w.w = pk2(r[6][j], r[7][j]);
        const int n = 4 * F.lane + j;
        *(u32x4*)((char*)blk + (F.wave >> 2) * 16384 + n * 64 + (((F.wave & 3) ^ swz4(n)) << 4)) = w;
    }
}
__device__ __forceinline__ void zero_acc(f32x4 (&acc)[4][4]) {
#pragma unroll
    for (int m = 0; m < 4; ++m)
#pragma unroll
        for (int n = 0; n < 4; ++n) acc[m][n] = (f32x4){0.f, 0.f, 0.f, 0.f};
}

__device__ __forceinline__ void phase0(const Frame& F, const float* x, const float* g, const float* b, const float* w_in, const float* w_out, const float* w_router) {
    const int gw = F.vcu * 8 + F.wave, NGW = F.G * 8;
    bf16* H0B = (bf16*)(F.ws + WS_H0B);
    f32x4 gv[4], bv[4];
#pragma unroll
    for (int c = 0; c < 4; ++c) { gv[c] = *(const f32x4*)(g + 4 * F.lane + 256 * c); bv[c] = *(const f32x4*)(b + 4 * F.lane + 256 * c); }
    for (int row = gw; row < T_TOK; row += NGW) {
        const float* xr = x + (size_t)row * DM + 4 * F.lane;
        f32x4 v[4]; float s = 0.f;
#pragma unroll
        for (int c = 0; c < 4; ++c) { v[c] = *(const f32x4*)(xr + 256 * c); s += (v[c].x + v[c].y) + (v[c].z + v[c].w); }
        const float mean = wave_sum(s) * (1.f / DM); float s2 = 0.f;
#pragma unroll
        for (int c = 0; c < 4; ++c) { v[c] = v[c] - mean; s2 += (v[c].x * v[c].x + v[c].y * v[c].y) + (v[c].z * v[c].z + v[c].w * v[c].w); }
        const float rstd = 1.f / sqrtf(wave_sum(s2) * (1.f / DM) + 1e-5f);
        bf16* orow = H0B + (size_t)row * DM + 4 * F.lane;
#pragma unroll
        for (int c = 0; c < 4; ++c) {
            const f32x4 y = v[c] * rstd * gv[c] + bv[c];
            u32x2 w; w.x = pk2(y.x, y.y); w.y = pk2(y.z, y.w);
            *(u32x2*)(orow + 256 * c) = w;
        }
    }
    {
        bf16* WIMG = (bf16*)(F.ws + WS_WIMG);
        for (int blk = F.vcu; blk < WIMG_N; blk += F.G) {
            const int s = 4 * F.lane;
            if (blk >= 128 && blk < WIMG_OUT) convert_block(F, w_in + (blk / 16) * 256 + s, INW, blk % 16, WIMG + (size_t)blk * 16384);
            else if (blk >= WIMG_RT) convert_block(F, w_router + s, NEXP, blk - WIMG_RT, WIMG + (size_t)blk * 16384);
        }
    }
    {
        bf16* WTI = (bf16*)(F.ws + WS_WT_IN); bf16* WTO = (bf16*)(F.ws + WS_WT_OUT);
        LAS float* scr = (LAS float*)(F.lds + F.wave * 8448);
        for (int it = gw; it < 1024 + 512; it += NGW) {
            const bool isin = it < 1024; const int r = isin ? it : it - 1024;
            const int nblk = isin ? 64 : 32, kb = r / nblk, nb = r % nblk, k0 = 64 * kb, n0 = 32 * nb, N = isin ? INW : DM;
            const float* W = isin ? w_in : w_out; bf16* WT = isin ? WTI : WTO;
#pragma unroll 8
            for (int i = 0; i < 32; ++i) { const int kk = 2 * i + (F.lane >> 5); scr[kk * 33 + (F.lane & 31)] = W[(size_t)(k0 + kk) * N + n0 + (F.lane & 31)]; }
            asm volatile("s_waitcnt lgkmcnt(0)" ::: "memory");
            const int c = F.lane & 7;
#pragma unroll
            for (int j = 0; j < 4; ++j) {
                const int n = (F.lane >> 3) + 8 * j; const LAS float* sp = scr + (8 * c) * 33 + n;
                u32x4 o; o.x = pk2(sp[0 * 33], sp[1 * 33]); o.y = pk2(sp[2 * 33], sp[3 * 33]); o.z = pk2(sp[4 * 33], sp[5 * 33]); o.w = pk2(sp[6 * 33], sp[7 * 33]);
                const int col = n0 + n;
                const int row = (isin && col < 512) ? ((col & ~48) | ((col & 16) << 1) | ((col & 32) >> 1)) : col;
                *(u32x4*)(WT + (size_t)row * DM + k0 + 8 * c) = o;
            }
            asm volatile("s_waitcnt lgkmcnt(0)" ::: "memory");
        }
    }
    float* COS = (float*)(F.ws + WS_COS); float* SIN = (float*)(F.ws + WS_SIN);
    for (int i = F.vcu * 512 + F.tid; i < SEQ * 32; i += F.G * 512) {
        const int pos = i >> 5, j = i & 31;
        const float inv = exp2f(-(float)j * (13.287712379549449f / 32.0f));
        const float ang = (float)pos * inv;
        double rev = (double)ang * 0.15915494309189535;
        rev -= __builtin_rint(rev);
        const float rv = (float)rev;
        COS[i] = __builtin_amdgcn_cosf(rv); SIN[i] = __builtin_amdgcn_sinf(rv);
    }
}

template <int MT>
__device__ __forceinline__ void p1_epilogue(f32x4 (&acc)[MT][4], const Frame& F, int row_base, int nt) {
    bf16* PROJ = (bf16*)(F.ws + WS_PROJ);
    const float* COS = (const float*)(F.ws + WS_COS); const float* SIN = (const float*)(F.ws + WS_SIN);
    const int lane = F.lane, wr = F.wave >> 2, wc = F.wave & 3, fr = lane & 15, fq = lane >> 4;
    const float scale = (nt == 1 || nt == 6 || nt == 7) ? 0.125f : 1.0f;
#pragma unroll
    for (int m = 0; m < MT; ++m) {
        const int row = row_base + wr * (16 * MT) + m * 16 + fr;
        if (nt < 2) {
            const int pos = row & (SEQ - 1);
#pragma unroll
            for (int n = 0; n < 2; ++n) {
                const f32x4 c = *(const f32x4*)(COS + pos * 32 + 16 * n + 4 * fq), s = *(const f32x4*)(SIN + pos * 32 + 16 * n + 4 * fq);
                const f32x4 x1 = acc[m][n], x2 = acc[m][n + 2];
                acc[m][n] = x1 * c - x2 * s; acc[m][n + 2] = x1 * s + x2 * c;
            }
        }
        bf16* orow = PROJ + (size_t)row * INW + nt * 256 + wc * 64 + 4 * fq;
#pragma unroll
        for (int n = 0; n < 4; ++n) {
            const f32x4 v = acc[m][n] * scale;
            u32x2 w; w.x = pk2(v.x, v.y); w.y = pk2(v.z, v.w);
            *(u32x2*)(orow + 16 * n) = w;
        }
        asm volatile("" ::: "memory");
    }
}
struct SchedP1 { int vcu, G; __device__ __forceinline__ bool next(int i, pg8::Unit& u) const { const int L = vcu + i * G; if (L >= 512) return false; u.pm = L >> 3; u.pn = L & 7; return true; } };
struct EpiP1 {
    bf16* PROJ; const float* COS; const float* SIN;
    __device__ __forceinline__ void operator()(const f32x4 (&acc)[2][2][4][2], const pg8::Unit& u, int wr, int wc, int fr, int fq) const {
        const float scale = (u.pn == 1 || u.pn == 6 || u.pn == 7) ? 0.125f : 1.0f;
#pragma unroll
        for (int ai = 0; ai < 2; ++ai)
#pragma unroll
            for (int m = 0; m < 4; ++m) {
                const int row = u.pm * 256 + ai * 128 + wr * 64 + m * 16 + fr;
                if (u.pn < 2) {
                    const int pos = row & (SEQ - 1), d0 = 16 * (wc & 1) + 4 * fq;
                    const f32x4 c = *(const f32x4*)(COS + pos * 32 + d0), s = *(const f32x4*)(SIN + pos * 32 + d0);
#pragma unroll
                    for (int bj = 0; bj < 2; ++bj) {
                        const f32x4 x1 = acc[ai][bj][m][0], x2 = acc[ai][bj][m][1];
                        const f32x4 o1 = (x1 * c - x2 * s) * scale, o2 = (x1 * s + x2 * c) * scale;
                        bf16* dst = PROJ + (size_t)row * INW + u.pn * 256 + bj * 128 + (wc >> 1) * 64 + d0;
                        u32x2 w1, w2; w1.x = pk2(o1.x, o1.y); w1.y = pk2(o1.z, o1.w); w2.x = pk2(o2.x, o2.y); w2.y = pk2(o2.z, o2.w);
                        *(u32x2*)dst = w1; *(u32x2*)(dst + 32) = w2;
                    }
                } else {
#pragma unroll
                    for (int bj = 0; bj < 2; ++bj)
#pragma unroll
                        for (int n = 0; n < 2; ++n) {
                            const f32x4 v = acc[ai][bj][m][n] * scale;
                            u32x2 w; w.x = pk2(v.x, v.y); w.y = pk2(v.z, v.w);
                            *(u32x2*)(PROJ + (size_t)row * INW + u.pn * 256 + bj * 128 + wc * 32 + 16 * n + 4 * fq) = w;
                        }
                }
                asm volatile("" ::: "memory");
            }
    }
};
__device__ __forceinline__ void phase1(const Frame& F) {
    const bf16* H0B = (const bf16*)(F.ws + WS_H0B);
    const bf16* WIMG = (const bf16*)(F.ws + WS_WIMG);
    {
        const pg8::Gemm g{H0B, (const bf16*)(F.ws + WS_WT_IN), DM};
        const SchedP1 S{F.vcu, F.G};
        const EpiP1 E{(bf16*)(F.ws + WS_PROJ), (const float*)(F.ws + WS_COS), (const float*)(F.ws + WS_SIN)};
        pg8::gemm_phase<EpiP1, SchedP1>(F.lds, g, S, E);
    }
    unsigned aoff[2]; ring_aoff(aoff, F.tid, DM);
    for (int mt = F.vcu; mt < 256; mt += F.G) {
        f32x4 acc[2][4]; zero_accT<2>(acc);
        gemm_ring<2>(acc, F, H0B + (size_t)mt * 64 * DM, aoff, WIMG + (size_t)(WIMG_IN + 8 * 16) * 16384, DM / 32);
        p1_epilogue<2>(acc, F, mt * 64, 8);
    }
}

__device__ __forceinline__ bf16x8 tr_frag(LAS const unsigned char* a0, LAS const unsigned char* a1) {
    const s16x4 lo = __builtin_amdgcn_ds_read_tr16_b64_v4i16((LAS s16x4*)a0);
    const s16x4 hi = __builtin_amdgcn_ds_read_tr16_b64_v4i16((LAS s16x4*)a1);
    bf16x8 r; r[0] = lo[0]; r[1] = lo[1]; r[2] = lo[2]; r[3] = lo[3]; r[4] = hi[0]; r[5] = hi[1]; r[6] = hi[2]; r[7] = hi[3];
    return r;
}
__device__ __forceinline__ int tr128_off(int row, int col) { return row * 128 + 32 * ((col >> 4) ^ ((row >> 1) & 3)) + 2 * (col & 15); }
__device__ __forceinline__ int tr256_off(int row, int col) { return row * 256 + 32 * ((col >> 4) ^ (row & 7)) + 2 * (col & 15); }
__device__ __forceinline__ bf16x8 pack_p(const f32x4& a, const f32x4& b) {
    u32x4 w; w.x = pk2(a.x, a.y); w.y = pk2(a.z, a.w); w.z = pk2(b.x, b.y); w.w = pk2(b.z, b.w);
    return __builtin_bit_cast(bf16x8, w);
}

__device__ __forceinline__ int t5_bucket(int n) {
    if (n < 16) return n;
    const float ratio = logf((float)n / 16.0f) / 2.0794415416798357f;
    int large = 16 + (int)(ratio * 16.0f);
    return large < 31 ? large : 31;
}
__device__ __forceinline__ void swa_unit(const Frame& F, int su, const float* rel_bias, const float* sinks) {
    LAS unsigned char* lds = F.lds;
    const bf16* PROJ = (const bf16*)(F.ws + WS_PROJ);
    bf16* MIXIN = (bf16*)(F.ws + WS_MIXIN);
    const int tid = F.tid, lane = F.lane, wave = F.wave, fr = lane & 15, fq = lane >> 4;
    const int b = su >> 7, nb = (su >> 1) & 63, kvh = su & 1;
    const int tok_prev = b * SEQ + (nb > 0 ? nb - 1 : 0) * 128, tok_cur = b * SEQ + nb * 128;
    constexpr int L_K = 0, L_V = 32768, L_BT = 65536;
#pragma unroll
    for (int i = 0; i < 4; ++i) {
        const int p = tid + 512 * i, row = p >> 3, pc = p & 7;
        const int tok = (row < 128 ? tok_prev + row : tok_cur + row - 128);
        const bf16* src = PROJ + (size_t)tok * INW;
        const int lck = pc ^ (row & 7);
        __builtin_amdgcn_global_load_lds((const unsigned*)(src + 2048 + kvh * 64 + lck * 8), (LAS unsigned*)(lds + L_K + wave * 1024 + i * 8192), 16, 0, 0);
        const int vcol = 16 * ((pc >> 1) ^ ((row >> 1) & 3)) + 8 * (pc & 1);
        __builtin_amdgcn_global_load_lds((const unsigned*)(src + 2176 + kvh * 64 + vcol), (LAS unsigned*)(lds + L_V + wave * 1024 + i * 8192), 16, 0, 0);
    }
    {
        const int g = tid >> 7, dist = tid & 127;
        ((LAS float*)(lds + L_BT))[tid] = rel_bias[t5_bucket(dist) * 8 + kvh * 4 + g];
    }
    BLOCK_SYNC();
#pragma unroll 1
    for (int task = wave; task < 32; task += 8) {
        const int g = task >> 3, a = task & 7, nj0 = a & ~1, head = kvh * 4 + g;
        const float sink = sinks[head];
        LAS const float* bt = (LAS const float*)(lds + L_BT) + g * 128;
        const int i = a * 16 + fr;
        bf16x8 qf[2];
#pragma unroll
        for (int kk = 0; kk < 2; ++kk)
            qf[kk] = *(const bf16x8*)(PROJ + (size_t)(tok_cur + i) * INW + 1536 + head * 64 + kk * 32 + fq * 8);
        f32x4 s[10];
#pragma unroll
        for (int nl = 0; nl < 10; ++nl) {
            s[nl] = (f32x4){0.f, 0.f, 0.f, 0.f};
            const int krow = 16 * (nj0 + nl) + fr;
#pragma unroll
            for (int kk = 0; kk < 2; ++kk) {
                const bf16x8 kf = *(LAS const bf16x8*)(lds + L_K + krow * 128 + (((kk * 4 + fq) ^ (fr & 7)) << 4));
                s[nl] = __builtin_amdgcn_mfma_f32_16x16x32_bf16(kf, qf[kk], s[nl], 0, 0, 0);
            }
        }
        float m = sink;
#pragma unroll
        for (int nl = 0; nl < 10; ++nl)
#pragma unroll
            for (int j = 0; j < 4; ++j) {
                const int jp = 16 * (nj0 + nl) + 4 * fq + j;
                const int dist = i + 128 - jp;
                const bool ok = (dist >= 0) && (dist < 128) && (nb > 0 || jp >= 128);
                const float v = ok ? s[nl][j] + bt[dist & 127] : -INFINITY;
                s[nl][j] = v; m = fmaxf(m, v);
            }
        m = fmaxf(m, __shfl_xor(m, 16)); m = fmaxf(m, __shfl_xor(m, 32));
        float d = 0.f;
#pragma unroll
        for (int nl = 0; nl < 10; ++nl)
#pragma unroll
            for (int j = 0; j < 4; ++j) { const float p = __expf(s[nl][j] - m); s[nl][j] = p; d += p; }
        d += __shfl_xor(d, 16); d += __shfl_xor(d, 32);
        const float inv = 1.0f / (d + __expf(sink - m));
        f32x4 o[4];
#pragma unroll
        for (int ne = 0; ne < 4; ++ne) o[ne] = (f32x4){0.f, 0.f, 0.f, 0.f};
#pragma unroll
        for (int ks = 0; ks < 5; ++ks) {
            const bf16x8 pf = pack_p(s[2 * ks], s[2 * ks + 1]);
            const int r0 = 16 * (nj0 + 2 * ks) + 4 * fq + (fr >> 2);
#pragma unroll
            for (int ne = 0; ne < 4; ++ne) {
                const bf16x8 vf = tr_frag(lds + L_V + tr128_off(r0, 16 * ne) + 8 * (fr & 3), lds + L_V + tr128_off(r0 + 16, 16 * ne) + 8 * (fr & 3));
                o[ne] = __builtin_amdgcn_mfma_f32_16x16x32_bf16(vf, pf, o[ne], 0, 0, 0);
            }
        }
        bf16* orow = MIXIN + (size_t)(tok_cur + i) * DM + 512 + head * 64 + 4 * fq;
#pragma unroll
        for (int ne = 0; ne < 4; ++ne) {
            const f32x4 v = o[ne] * inv;
            u32x2 w; w.x = pk2(v.x, v.y); w.y = pk2(v.z, v.w);
            *(u32x2*)(orow + 16 * ne) = w;
        }
    }
    BLOCK_SYNC();
}

__device__ __forceinline__ float ret_log2gamma(int h) { return log2f(1.0f - exp2f(-5.0f - (float)h)); }
__device__ __forceinline__ void stage_v256(const Frame& F, const bf16* PROJ, int tok0, int h, int L_V) {
#pragma unroll
    for (int i = 0; i < 4; ++i) {
        const int p = F.tid + 512 * i, row = p >> 4, pc = p & 15;
        const int col = 16 * ((pc >> 1) ^ (row & 7)) + 8 * (pc & 1);
        __builtin_amdgcn_global_load_lds((const unsigned*)(PROJ + (size_t)(tok0 + row) * INW + 512 + h * 128 + col), (LAS unsigned*)(F.lds + L_V + F.wave * 1024 + i * 8192), 16, 0, 0);
    }
}
__device__ __forceinline__ void kv_unit(const Frame& F, int ku) {
    LAS unsigned char* lds = F.lds;
    const bf16* PROJ = (const bf16*)(F.ws + WS_PROJ);
    float* KVT = (float*)(F.ws + WS_KVT);
    const int tid = F.tid, lane = F.lane, wave = F.wave, fr = lane & 15, fq = lane >> 4;
    const int b = ku >> 8, n = (ku >> 2) & 63, h = ku & 3;
    const int tok0 = b * SEQ + n * 128;
    constexpr int L_K = 0, L_V = 16384;
    const float l2g = ret_log2gamma(h);
    stage_v256(F, PROJ, tok0, h, L_V);
#pragma unroll
    for (int i = 0; i < 2; ++i) {
        const int p = tid + 512 * i, row = p >> 3, pc = p & 7;
        const int col = 16 * ((pc >> 1) ^ ((row >> 1) & 3)) + 8 * (pc & 1);
        const u32x4 kv = *(const u32x4*)(PROJ + (size_t)(tok0 + row) * INW + 256 + h * 64 + col);
        const float z = exp2f((float)(127 - row) * l2g);
        u32x4 w;
        w.x = pk2(bflo(kv.x) * z, bfhi(kv.x) * z); w.y = pk2(bflo(kv.y) * z, bfhi(kv.y) * z);
        w.z = pk2(bflo(kv.z) * z, bfhi(kv.z) * z); w.w = pk2(bflo(kv.w) * z, bfhi(kv.w) * z);
        *(LAS u32x4*)(lds + L_K + p * 16) = w;
    }
    BLOCK_SYNC();
    const int ne = wave;
    f32x4 acc[4];
#pragma unroll
    for (int nd = 0; nd < 4; ++nd) acc[nd] = (f32x4){0.f, 0.f, 0.f, 0.f};
#pragma unroll
    for (int ks = 0; ks < 4; ++ks) {
        const int r0 = 32 * ks + 4 * fq + (fr >> 2);
        const bf16x8 vf = tr_frag(lds + L_V + tr256_off(r0, 16 * ne) + 8 * (fr & 3), lds + L_V + tr256_off(r0 + 16, 16 * ne) + 8 * (fr & 3));
#pragma unroll
        for (int nd = 0; nd < 4; ++nd) {
            const bf16x8 kf = tr_frag(lds + L_K + tr128_off(r0, 16 * nd) + 8 * (fr & 3), lds + L_K + tr128_off(r0 + 16, 16 * nd) + 8 * (fr & 3));
            acc[nd] = __builtin_amdgcn_mfma_f32_16x16x32_bf16(kf, vf, acc[nd], 0, 0, 0);
        }
    }
    float* dst = KVT + (size_t)ku * 8192 + (16 * ne + fr) * 64 + 4 * fq;
#pragma unroll
    for (int nd = 0; nd < 4; ++nd) *(f32x4*)(dst + 16 * nd) = acc[nd];
    BLOCK_SYNC();
}

__device__ __forceinline__ void phase_scan(const Frame& F) {
    const float* KVT = (const float*)(F.ws + WS_KVT);
    bf16* ST = (bf16*)(F.ws + WS_STATE);
    for (int gid = F.vcu * 512 + F.tid; gid < 65536; gid += F.G * 512) {
        const int b = gid >> 15, h = (gid >> 13) & 3, ed = gid & 8191;
        const float cd = exp2f(128.0f * ret_log2gamma(h));
        float s = 0.f;
        const size_t base = (size_t)b * 64 * 4 * 8192 + (size_t)h * 8192 + ed;
#pragma unroll 8
        for (int n = 0; n < 64; ++n) {
            const size_t idx = base + (size_t)n * 4 * 8192;
            const float kv = KVT[idx];
            ST[idx] = (bf16)(pk2(s, 0.f) & 0xffffu);
            s = s * cd + kv;
        }
    }
}

__device__ __forceinline__ void ret_unit(const Frame& F, int ku) {
    LAS unsigned char* lds = F.lds;
    const bf16* PROJ = (const bf16*)(F.ws + WS_PROJ);
    const bf16* ST = (const bf16*)(F.ws + WS_STATE);
    bf16* MIXIN = (bf16*)(F.ws + WS_MIXIN);
    const int tid = F.tid, lane = F.lane, w = F.wave, fr = lane & 15, fq = lane >> 4;
    const int b = ku >> 8, n = (ku >> 2) & 63, h = ku & 3;
    const int tok0 = b * SEQ + n * 128;
    constexpr int L_K = 0, L_V = 16384;
    const float l2g = ret_log2gamma(h);
    stage_v256(F, PROJ, tok0, h, L_V);
#pragma unroll
    for (int i = 0; i < 2; ++i) {
        const int p = tid + 512 * i, row = p >> 3, pc = p & 7;
        const int lck = pc ^ (row & 7);
        __builtin_amdgcn_global_load_lds((const unsigned*)(PROJ + (size_t)(tok0 + row) * INW + 256 + h * 64 + lck * 8), (LAS unsigned*)(lds + L_K + w * 1024 + i * 8192), 16, 0, 0);
    }
    const int i_row = 16 * w + fr;
    const size_t tok = (size_t)tok0 + i_row;
    bf16x8 qf[2];
#pragma unroll
    for (int kk = 0; kk < 2; ++kk) qf[kk] = *(const bf16x8*)(PROJ + tok * INW + h * 64 + kk * 32 + fq * 8);
    f32x4 o[8];
#pragma unroll
    for (int ne = 0; ne < 8; ++ne) o[ne] = (f32x4){0.f, 0.f, 0.f, 0.f};
    const bf16* stb = ST + (size_t)ku * 8192;
#pragma unroll
    for (int ne = 0; ne < 8; ++ne)
#pragma unroll
        for (int kk = 0; kk < 2; ++kk) {
            const bf16x8 sf = *(const bf16x8*)(stb + (16 * ne + fr) * 64 + kk * 32 + fq * 8);
            o[ne] = __builtin_amdgcn_mfma_f32_16x16x32_bf16(sf, qf[kk], o[ne], 0, 0, 0);
        }
    const float xi = exp2f((float)(i_row + 1) * l2g);
#pragma unroll
    for (int ne = 0; ne < 8; ++ne) o[ne] = o[ne] * xi;
    BLOCK_SYNC();
    f32x4 s[8];
#pragma unroll
    for (int nj = 0; nj < 8; ++nj) {
        s[nj] = (f32x4){0.f, 0.f, 0.f, 0.f};
        if (nj <= w) {
#pragma unroll
            for (int kk = 0; kk < 2; ++kk) {
                const bf16x8 kf = *(LAS const bf16x8*)(lds + L_K + (16 * nj + fr) * 128 + (((kk * 4 + fq) ^ (fr & 7)) << 4));
                s[nj] = __builtin_amdgcn_mfma_f32_16x16x32_bf16(kf, qf[kk], s[nj], 0, 0, 0);
            }
#pragma unroll
            for (int j = 0; j < 4; ++j) {
                const int jj = 16 * nj + 4 * fq + j;
                const int diff = i_row - jj;
                s[nj][j] = diff >= 0 ? s[nj][j] * exp2f((float)diff * l2g) : 0.f;
            }
        }
    }
#pragma unroll
    for (int ks = 0; ks < 4; ++ks) {
        if (2 * ks <= w) {
            const bf16x8 pf = pack_p(s[2 * ks], s[2 * ks + 1]);
            const int r0 = 32 * ks + 4 * fq + (fr >> 2);
#pragma unroll
            for (int ne = 0; ne < 8; ++ne) {
                const bf16x8 vf = tr_frag(lds + L_V + tr256_off(r0, 16 * ne) + 8 * (fr & 3), lds + L_V + tr256_off(r0 + 16, 16 * ne) + 8 * (fr & 3));
                o[ne] = __builtin_amdgcn_mfma_f32_16x16x32_bf16(vf, pf, o[ne], 0, 0, 0);
            }
        }
    }
    float sm = 0.f;
#pragma unroll
    for (int ne = 0; ne < 8; ++ne) sm += (o[ne].x + o[ne].y) + (o[ne].z + o[ne].w);
    sm += __shfl_xor(sm, 16); sm += __shfl_xor(sm, 32);
    const float mean = sm * (1.f / 128.f);
    float sq = 0.f;
#pragma unroll
    for (int ne = 0; ne < 8; ++ne) { o[ne] = o[ne] - mean; sq += (o[ne].x * o[ne].x + o[ne].y * o[ne].y) + (o[ne].z * o[ne].z + o[ne].w * o[ne].w); }
    sq += __shfl_xor(sq, 16); sq += __shfl_xor(sq, 32);
    const float rstd = 1.0f / sqrtf(sq * (1.f / 128.f) + 1e-6f);
    const bf16* grow = PROJ + tok * INW + 1024 + h * 128 + 4 * fq;
    bf16* orow = MIXIN + tok * DM + h * 128 + 4 * fq;
#pragma unroll
    for (int ne = 0; ne < 8; ++ne) {
        const u32x2 gg = *(const u32x2*)(grow + 16 * ne);
        const float g0 = bflo(gg.x), g1 = bfhi(gg.x), g2 = bflo(gg.y), g3 = bfhi(gg.y);
        const f32x4 v = o[ne] * rstd;
        const float y0 = v.x * g0 / (1.f + __expf(-g0)), y1 = v.y * g1 / (1.f + __expf(-g1)), y2 = v.z * g2 / (1.f + __expf(-g2)), y3 = v.w * g3 / (1.f + __expf(-g3));
        u32x2 wv; wv.x = pk2(y0, y1); wv.y = pk2(y2, y3);
        *(u32x2*)(orow + 16 * ne) = wv;
    }
    BLOCK_SYNC();
}

struct SchedP5 { int vcu, G; __device__ __forceinline__ bool next(int i, pg8::Unit& u) const { const int L = vcu + i * G; if (L >= 256) return false; u.pm = L >> 2; u.pn = L & 3; return true; } };
struct EpiP5 {
    const bf16* H0B; bf16* PRE1;
    __device__ __forceinline__ void operator()(const f32x4 (&acc)[2][2][4][2], const pg8::Unit& u, int wr, int wc, int fr, int fq) const {
#pragma unroll
        for (int ai = 0; ai < 2; ++ai)
#pragma unroll
            for (int m = 0; m < 4; ++m) {
                const size_t row = (size_t)(u.pm * 256 + ai * 128 + wr * 64 + m * 16 + fr);
#pragma unroll
                for (int bj = 0; bj < 2; ++bj)
#pragma unroll
                    for (int n = 0; n < 2; ++n) {
                        const size_t off = row * DM + u.pn * 256 + bj * 128 + wc * 32 + 16 * n + 4 * fq;
                        const u32x2 hh = *(const u32x2*)(H0B + off);
                        f32x4 v = acc[ai][bj][m][n];
                        v.x += ALPHA * bflo(hh.x); v.y += ALPHA * bfhi(hh.x); v.z += ALPHA * bflo(hh.y); v.w += ALPHA * bfhi(hh.y);
                        u32x2 pw; pw.x = pk2(v.x, v.y); pw.y = pk2(v.z, v.w);
                        *(u32x2*)(PRE1 + off) = pw;
                    }
                asm volatile("" ::: "memory");
            }
    }
};
__device__ __forceinline__ void phase_outproj(const Frame& F) {
    const pg8::Gemm g{(const bf16*)(F.ws + WS_MIXIN), (const bf16*)(F.ws + WS_WT_OUT), DM};
    const SchedP5 S{F.vcu, F.G};
    const EpiP5 E{(const bf16*)(F.ws + WS_H0B), (bf16*)(F.ws + WS_PRE1)};
    pg8::gemm_phase<EpiP5, SchedP5>(F.lds, g, S, E);
}

__device__ __forceinline__ unsigned fkey(float f) { const unsigned u = __float_as_uint(f); return u ^ ((u >> 31) ? 0xffffffffu : 0x80000000u); }
__device__ __forceinline__ int lanes_below(unsigned long long m) { return (int)__builtin_amdgcn_mbcnt_hi((unsigned)(m >> 32), __builtin_amdgcn_mbcnt_lo((unsigned)m, 0u)); }
__device__ __forceinline__ void phase_router(const Frame& F, const float* g, const float* bb, const float* w_router, const float* rbias) {
    LAS unsigned char* lds = F.lds;
    const bf16* PRE1 = (const bf16*)(F.ws + WS_PRE1);
    bf16* H1B = (bf16*)(F.ws + WS_H1B);
    unsigned* gcnt = (unsigned*)(F.ws + WS_CTL) + CW_CNT;
    u32x2* LIST2 = (u32x2*)(F.ws + WS_LIST2);
    const int tid = F.tid, lane = F.lane, wave = F.wave, wr = wave >> 2, wc = wave & 3, fr = lane & 15, fq = lane >> 4;
    LAS float* selw = (LAS float*)(lds + L_TAB + TB_SELW);
    LAS int* hist = (LAS int*)(lds + L_TAB + TB_HIST);
    LAS int* basee = (LAS int*)(lds + L_TAB + TB_BASE);
    LAS int* sel = (LAS int*)(lds + L_TAB + TB_SEL);
    for (int mt = F.vcu; mt < 256; mt += F.G) {
        const int row0 = mt * 64;
        asm volatile("" ::: "memory");
        {
            f32x4 gv[4], bv[4];
#pragma unroll
            for (int c = 0; c < 4; ++c) { gv[c] = *(const f32x4*)(g + 4 * lane + 256 * c); bv[c] = *(const f32x4*)(bb + 4 * lane + 256 * c); }
#pragma unroll 1
            for (int batch = 0; batch < 2; ++batch) {
                f32x4 v[4][4];
#pragma unroll
                for (int r = 0; r < 4; ++r)
#pragma unroll
                    for (int c = 0; c < 4; ++c) { const u32x2 pw = *(const u32x2*)(PRE1 + (size_t)(row0 + wave * 8 + batch * 4 + r) * DM + 4 * lane + 256 * c); v[r][c] = (f32x4){bflo(pw.x), bfhi(pw.x), bflo(pw.y), bfhi(pw.y)}; }
#pragma unroll
                for (int r = 0; r < 4; ++r) {
                    float s = 0.f;
#pragma unroll
                    for (int c = 0; c < 4; ++c) s += (v[r][c].x + v[r][c].y) + (v[r][c].z + v[r][c].w);
                    const float mean = wave_sum(s) * (1.f / DM); float s2 = 0.f;
#pragma unroll
                    for (int c = 0; c < 4; ++c) { v[r][c] = v[r][c] - mean; s2 += (v[r][c].x * v[r][c].x + v[r][c].y * v[r][c].y) + (v[r][c].z * v[r][c].z + v[r][c].w * v[r][c].w); }
                    const float rstd = 1.f / sqrtf(wave_sum(s2) * (1.f / DM) + 1e-5f);
                    bf16* orow = H1B + (size_t)(row0 + wave * 8 + batch * 4 + r) * DM + 4 * lane;
#pragma unroll
                    for (int c = 0; c < 4; ++c) {
                        const f32x4 y = v[r][c] * rstd * gv[c] + bv[c];
                        u32x2 wv; wv.x = pk2(y.x, y.y); wv.y = pk2(y.z, y.w);
                        *(u32x2*)(orow + 256 * c) = wv;
                    }
                }
            }
        }
        if (tid < 256) hist[tid] = 0;
        BLOCK_SYNC();
        asm volatile("" ::: "memory");
        unsigned aoff[2]; ring_aoff(aoff, tid, DM);
        f32x4 acc[2][4]; zero_accT<2>(acc);
        gemm_ring<2>(acc, F, H1B + (size_t)row0 * DM, aoff, (const bf16*)(F.ws + WS_WIMG) + (size_t)WIMG_RT * 16384, DM / 32);
        LAS float* sc = (LAS float*)lds;
#pragma unroll
        for (int m = 0; m < 2; ++m) {
            const int row = wr * 32 + m * 16 + fr;
#pragma unroll
            for (int n = 0; n < 4; ++n) {
                f32x4 v = acc[m][n];
                v.x = 1.f / (1.f + __expf(-v.x)); v.y = 1.f / (1.f + __expf(-v.y)); v.z = 1.f / (1.f + __expf(-v.z)); v.w = 1.f / (1.f + __expf(-v.w));
                *(LAS f32x4*)(sc + row * 260 + wc * 64 + n * 16 + 4 * fq) = v;
            }
        }
        BLOCK_SYNC();
        asm volatile("" ::: "memory");
        const f32x4 rb = *(const f32x4*)(rbias + 4 * lane);
        const int grp = lane >> 3;
#pragma unroll 1
        for (int r = 0; r < 8; ++r) {
            const int rl = wave * 8 + r;
            const f32x4 v = *(LAS const f32x4*)(sc + rl * 260 + 4 * lane);
            const f32x4 ch = v + rb;
            float a1 = fmaxf(ch.x, ch.y), a2 = fminf(ch.x, ch.y);
            { const float b1 = fmaxf(ch.z, ch.w), b2 = fminf(ch.z, ch.w); const float n1 = fmaxf(a1, b1), n2 = fmaxf(fminf(a1, b1), fmaxf(a2, b2)); a1 = n1; a2 = n2; }
#pragma unroll
            for (int o = 1; o < 8; o <<= 1) {
                const float b1 = __shfl_xor(a1, o), b2 = __shfl_xor(a2, o);
                const float n1 = fmaxf(a1, b1), n2 = fmaxf(fminf(a1, b1), fmaxf(a2, b2));
                a1 = n1; a2 = n2;
            }
            const float gsum = a1 + a2;
            int rank = 0;
#pragma unroll
            for (int j = 0; j < 8; ++j) { const float sj = __shfl(gsum, 8 * j); rank += (sj > gsum || (sj == gsum && j < grp)) ? 1 : 0; }
            const bool gsel = rank < 4;
            unsigned key[4];
            key[0] = gsel ? fkey(ch.x) : 0u; key[1] = gsel ? fkey(ch.y) : 0u; key[2] = gsel ? fkey(ch.z) : 0u; key[3] = gsel ? fkey(ch.w) : 0u;
            unsigned tau = 0u;
#pragma unroll 1
            for (int bit = 31; bit >= 0; --bit) {
                const unsigned cand = tau | (1u << bit);
                const int cnt = __popcll(__ballot(key[0] >= cand)) + __popcll(__ballot(key[1] >= cand)) + __popcll(__ballot(key[2] >= cand)) + __popcll(__ballot(key[3] >= cand));
                if (cnt >= 8) tau = cand;
            }
            unsigned long long gm[4], em[4];
            int ngt = 0;
#pragma unroll
            for (int j = 0; j < 4; ++j) { gm[j] = __ballot(key[j] > tau); em[j] = __ballot(key[j] == tau); ngt += __popcll(gm[j]); }
            const int need = 8 - ngt;
            int eqb = lanes_below(em[0]) + lanes_below(em[1]) + lanes_below(em[2]) + lanes_below(em[3]);
            bool s[4];
#pragma unroll
            for (int j = 0; j < 4; ++j) { const bool eq = key[j] == tau; s[j] = (key[j] > tau) || (eq && eqb < need); eqb += eq ? 1 : 0; }
            unsigned long long sm[4];
#pragma unroll
            for (int j = 0; j < 4; ++j) sm[j] = __ballot(s[j]);
            int kpos = lanes_below(sm[0]) + lanes_below(sm[1]) + lanes_below(sm[2]) + lanes_below(sm[3]);
            const float wl = (s[0] ? v.x : 0.f) + (s[1] ? v.y : 0.f) + (s[2] ? v.z : 0.f) + (s[3] ? v.w : 0.f);
            const float wscale = 2.5f / wave_sum(wl);
#pragma unroll
            for (int j = 0; j < 4; ++j) {
                if (s[j]) {
                    selw[rl * 8 + kpos] = v[j] * wscale;
                    const int e = 4 * lane + j;
                    const int lpos = __hip_atomic_fetch_add(hist + e, 1, __ATOMIC_RELAXED, __HIP_MEMORY_SCOPE_WORKGROUP);
                    sel[rl * 8 + kpos] = (e << 16) | lpos;
                    ++kpos;
                }
            }
        }
        BLOCK_SYNC();
        if (tid < 256) { const int c = hist[tid]; basee[tid] = c > 0 ? (int)__hip_atomic_fetch_add(gcnt + tid, (unsigned)c, __ATOMIC_RELAXED, __HIP_MEMORY_SCOPE_AGENT) : 0; }
        BLOCK_SYNC();
        {
            const int sv = sel[tid], e = sv >> 16, lpos = sv & 0xffff;
            u32x2 ent; ent.x = (unsigned)(mt * 512 + tid); ent.y = __float_as_uint(selw[tid]);
            LIST2[(size_t)e * LCAP + basee[e] + lpos] = ent;
        }
        BLOCK_SYNC();
    }
}

__device__ __forceinline__ void phase_moe(const Frame& F, const float* w_gate, const float* w_up, const float* w_down, const float* ws_gate, const float* ws_up, const float* ws_down) {
    LAS unsigned char* lds = F.lds;
    const bf16* H1B = (const bf16*)(F.ws + WS_H1B);
    const unsigned* gcnt = (const unsigned*)(F.ws + WS_CTL) + CW_CNT;
    const u32x2* LIST2 = (const u32x2*)(F.ws + WS_LIST2);
    bf16* YROWS = (bf16*)(F.ws + WS_YROWS);
    const int tid = F.tid, lane = F.lane, wave = F.wave, wr = wave >> 2, wc = wave & 3, fr = lane & 15, fq = lane >> 4;
    const int lchunk = (tid & 7) ^ ((tid >> 3) & 7);
    LAS int* prefix = (LAS int*)(lds + L_TAB + TB_PREFIX);
    LAS int* rtok = (LAS int*)(lds + L_TAB + TB_RTOK);
    LAS int* ryrow = (LAS int*)(lds + L_TAB + TB_RYROW);
    LAS float* rw = (LAS float*)(lds + L_TAB + TB_RW);
    LAS int* cntl = (LAS int*)(lds + L_TAB + TB_CNT);
    if (tid < 256) cntl[tid] = (int)gcnt[tid];
    if (wave == 0) {
        int c4[4], loc = 0;
#pragma unroll
        for (int j = 0; j < 4; ++j) { c4[j] = ((int)gcnt[lane * 4 + j] + 127) >> 7; loc += c4[j]; }
        int incl = loc;
#pragma unroll
        for (int o = 1; o < 64; o <<= 1) { const int t = __shfl_up(incl, o); if (lane >= o) incl += t; }
        int run = incl - loc;
#pragma unroll
        for (int j = 0; j < 4; ++j) { prefix[lane * 4 + j] = run; run += c4[j]; }
        if (lane == 63) prefix[256] = run;
    }
    BLOCK_SYNC();
    const int R = prefix[256];
    const int nr = (R > F.vcu) ? (R - F.vcu + F.G - 1) / F.G : 0;
    const int base = R % F.G, L = F.G - base;
    const bool lightonly = L >= 64;
    const int sd = (F.vcu - base + F.G) % F.G;
    const int ns = lightonly ? ((sd < L && sd < 128) ? (128 - sd + L - 1) / L : 0) : ((sd < 128) ? 1 : 0);
    const int sstep = lightonly ? L : F.G;
#define MOE_ITEM(it_, e_, tile_) do { if ((it_) >= nr) { e_ = 256; tile_ = sd + ((it_) - nr) * sstep; } else { const int u_ = F.vcu + (it_) * F.G; int lo_ = 0, hi_ = 255; \
        while (lo_ < hi_) { const int mid_ = (lo_ + hi_ + 1) >> 1; if (prefix[mid_] <= u_) lo_ = mid_; else hi_ = mid_ - 1; } e_ = lo_; tile_ = u_ - prefix[lo_]; } } while (0)
#define MOE_FETCH(e_, tile_, tok_, yr_, wv_) do { tok_ = 0; yr_ = -1; wv_ = 0.f; if (tid < 128) { const int idx_ = (tile_) * 128 + tid; \
        if ((e_) == 256) { tok_ = idx_; yr_ = idx_ * 9 + 8; wv_ = 1.0f; } \
        else if (idx_ < cntl[e_]) { const u32x2 en_ = LIST2[(size_t)(e_) * LCAP + idx_]; tok_ = (int)(en_.x >> 3); yr_ = tok_ * 9 + (int)(en_.x & 7u); wv_ = __uint_as_float(en_.y); } } } while (0)
    int ptok = 0, pyr = -1; float pwv = 0.f;
    if (nr + ns > 0) { int e0, t0; MOE_ITEM(0, e0, t0); MOE_FETCH(e0, t0, ptok, pyr, pwv); }
    for (int it = 0; it < nr + ns; ++it) {
        int e, tile;
        MOE_ITEM(it, e, tile);
        if (tid < 128) { rtok[tid] = ptok; ryrow[tid] = pyr; rw[tid] = pwv; }
        BLOCK_SYNC();
        const float* Wg = (e == 256) ? ws_gate : w_gate + (size_t)e * 262144;
        const float* Wu = (e == 256) ? ws_up : w_up + (size_t)e * 262144;
        const float* Wd = (e == 256) ? ws_down : w_down + (size_t)e * 262144;
        const bf16* ap0 = H1B + (size_t)rtok[tid >> 3] * DM + lchunk * 8;
        const bf16* ap1 = H1B + (size_t)rtok[(tid >> 3) + 64] * DM + lchunk * 8;
#pragma unroll 1
        for (int c0 = 0; c0 < 256; c0 += 128) {
            const int s = 4 * lane;
            const float* bp = ((s & 32) ? Wu : Wg) + c0 + 32 * (s >> 6) + (s & 31);
            f32x4 acc[4][4]; zero_acc(acc);
            if (wave >= 4) gemm_loopa<false, DM / 64, 256, true>(acc, F, ap0, ap1, bp, tile & 3); else gemm_loopa<false, DM / 64, 256>(acc, F, ap0, ap1, bp, tile & 3);
#pragma unroll
            for (int m = 0; m < 4; ++m) {
                const int row = wr * 64 + m * 16 + fr;
#pragma unroll
                for (int n = 0; n < 2; ++n) {
                    const f32x4 gt = acc[m][n], up = acc[m][n + 2];
                    const float a0 = gt.x / (1.f + __expf(-gt.x)) * up.x, a1 = gt.y / (1.f + __expf(-gt.y)) * up.y, a2 = gt.z / (1.f + __expf(-gt.z)) * up.z, a3 = gt.w / (1.f + __expf(-gt.w)) * up.w;
                    const int col = c0 + 32 * wc + 16 * n + 4 * fq, kt = col >> 6, c64 = col & 63;
                    u32x2 wv; wv.x = pk2(a0, a1); wv.y = pk2(a2, a3);
                    *(LAS u32x2*)(lds + a_tile_off<true>(kt) + row * 128 + (((c64 >> 3) ^ (row & 7)) << 4) + (c64 & 7) * 2) = wv;
                }
            }
        }
        BLOCK_SYNC();
        if (it + 1 < nr + ns) { int e1, t1; MOE_ITEM(it + 1, e1, t1); MOE_FETCH(e1, t1, ptok, pyr, pwv); }
#pragma unroll 1
        for (int nc = 0; nc < 4; ++nc) {
            const int s = 4 * lane, sl = s & 63;
            const float* bp = Wd + nc * 256 + (s & 192) + 16 * ((sl >> 2) & 3) + 4 * (sl >> 4) + (sl & 3);
            f32x4 acc[4][4]; zero_acc(acc);
            if (wave >= 4) gemm_loopa<true, 4, DM, true>(acc, F, nullptr, nullptr, bp, tile & 3); else gemm_loopa<true, 4, DM>(acc, F, nullptr, nullptr, bp, tile & 3);
#pragma unroll
            for (int m = 0; m < 4; ++m) {
                const int row = wr * 64 + m * 16 + fr;
                const int yr = ryrow[row]; const float wv = rw[row];
                if (yr >= 0) {
                    bf16* dst = YROWS + (size_t)yr * DM + nc * 256 + wc * 64 + 16 * fq;
                    u32x4 w0, w1;
                    w0.x = pk2(acc[m][0].x * wv, acc[m][0].y * wv); w0.y = pk2(acc[m][0].z * wv, acc[m][0].w * wv);
                    w0.z = pk2(acc[m][1].x * wv, acc[m][1].y * wv); w0.w = pk2(acc[m][1].z * wv, acc[m][1].w * wv);
                    w1.x = pk2(acc[m][2].x * wv, acc[m][2].y * wv); w1.y = pk2(acc[m][2].z * wv, acc[m][2].w * wv);
                    w1.z = pk2(acc[m][3].x * wv, acc[m][3].y * wv); w1.w = pk2(acc[m][3].z * wv, acc[m][3].w * wv);
                    *(u32x4*)dst = w0; *(u32x4*)(dst + 8) = w1;
                }
            }
        }
        BLOCK_SYNC();
    }
}

__device__ __forceinline__ void phase_final(const Frame& F, const float* g, const float* b, float* out) {
    const bf16* H1B = (const bf16*)(F.ws + WS_H1B);
    const bf16* YROWS = (const bf16*)(F.ws + WS_YROWS);
    const int gw = F.vcu * 8 + F.wave, NGW = F.G * 8, lane = F.lane;
    f32x4 gv[4], bv[4];
#pragma unroll
    for (int c = 0; c < 2; ++c)
#pragma unroll
        for (int hh = 0; hh < 2; ++hh) { gv[2 * c + hh] = *(const f32x4*)(g + 8 * lane + 512 * c + 4 * hh); bv[2 * c + hh] = *(const f32x4*)(b + 8 * lane + 512 * c + 4 * hh); }
    for (int row = gw; row < T_TOK; row += NGW) {
        float v[16];
#pragma unroll
        for (int c = 0; c < 2; ++c) {
            const u32x4 hv = *(const u32x4*)(H1B + (size_t)row * DM + 8 * lane + 512 * c);
            v[8 * c + 0] = ALPHA * bflo(hv.x); v[8 * c + 1] = ALPHA * bfhi(hv.x); v[8 * c + 2] = ALPHA * bflo(hv.y); v[8 * c + 3] = ALPHA * bfhi(hv.y);
            v[8 * c + 4] = ALPHA * bflo(hv.z); v[8 * c + 5] = ALPHA * bfhi(hv.z); v[8 * c + 6] = ALPHA * bflo(hv.w); v[8 * c + 7] = ALPHA * bfhi(hv.w);
#pragma unroll
            for (int sidx = 0; sidx < 9; ++sidx) {
                const u32x4 yv = *(const u32x4*)(YROWS + ((size_t)row * 9 + sidx) * DM + 8 * lane + 512 * c);
                v[8 * c + 0] += bflo(yv.x); v[8 * c + 1] += bfhi(yv.x); v[8 * c + 2] += bflo(yv.y); v[8 * c + 3] += bfhi(yv.y);
                v[8 * c + 4] += bflo(yv.z); v[8 * c + 5] += bfhi(yv.z); v[8 * c + 6] += bflo(yv.w); v[8 * c + 7] += bfhi(yv.w);
            }
        }
        float s = 0.f;
#pragma unroll
        for (int i = 0; i < 16; ++i) s += v[i];
        const float mean = wave_sum(s) * (1.f / DM); float s2 = 0.f;
#pragma unroll
        for (int i = 0; i < 16; ++i) { v[i] -= mean; s2 += v[i] * v[i]; }
        const float rstd = 1.f / sqrtf(wave_sum(s2) * (1.f / DM) + 1e-5f);
        float* orow = out + (size_t)row * DM + 8 * lane;
#pragma unroll
        for (int c = 0; c < 2; ++c)
#pragma unroll
            for (int hh = 0; hh < 2; ++hh) {
                f32x4 y;
                y.x = v[8 * c + 4 * hh + 0] * rstd; y.y = v[8 * c + 4 * hh + 1] * rstd; y.z = v[8 * c + 4 * hh + 2] * rstd; y.w = v[8 * c + 4 * hh + 3] * rstd;
                y = y * gv[2 * c + hh] + bv[2 * c + hh];
                *(f32x4*)(orow + 512 * c + 4 * hh) = y;
            }
    }
}

__global__ void __launch_bounds__(512, 2) fwd_kernel(Args a) {
    extern __shared__ __attribute__((aligned(16))) unsigned char lds_raw[];
    Frame F;
    F.lds = (LAS unsigned char*)lds_raw;
    F.tid = threadIdx.x; F.lane = F.tid & 63; F.wave = __builtin_amdgcn_readfirstlane(F.tid >> 6);
    F.G = gridDim.x; { const int bx = blockIdx.x; F.vcu = (F.G % 8 == 0) ? (bx % 8) * (F.G / 8) + bx / 8 : bx; }
    F.ws = a.ws;
    volatile LAS unsigned* MISC = (volatile LAS unsigned*)(F.lds + L_TAB + TB_MISC);
    if (F.tid < 16) MISC[F.tid] = 0u;
    __syncthreads();
    unsigned* ctl = (unsigned*)(a.ws + WS_CTL);
    const int lo = a.ph_lo, hi = a.ph_hi;
    XcdBarrier bar; bar.bar = ctl + CW_BAR; bar.x = 0; bar.st = MISC + 8;
    if (hi - lo > 1) bar = xcd_barrier_post(ctl + CW_BAR, MISC + 8);
#define IN(k) (lo <= (k) && (k) < hi)
#define SEAM(k) do { if (IN(k) && IN((k) + 1)) xcd_barrier(bar); } while (0)
    if (IN(0)) { phase0(F, a.in[0], a.in[1], a.in[2], a.in[3], a.in[4], a.in[9]); }
    SEAM(0);
    if (IN(1)) { phase1(F); }
    SEAM(1);
    if (IN(2)) {
        for (int su = F.vcu; su < 256; su += F.G) swa_unit(F, su, a.in[5], a.in[6]);
        for (int ku = F.vcu; ku < 512; ku += F.G) kv_unit(F, ku);
    }
    SEAM(2);
    if (IN(3)) { phase_scan(F); }
    SEAM(3);
    if (IN(4)) { for (int ku = F.vcu; ku < 512; ku += F.G) ret_unit(F, ku); }
    SEAM(4);
    if (IN(5)) { phase_outproj(F); }
    SEAM(5);
    if (IN(6)) { phase_router(F, a.in[7], a.in[8], a.in[9], a.in[10]); }
    SEAM(6);
    if (IN(7)) { phase_moe(F, a.in[11], a.in[12], a.in[13], a.in[14], a.in[15], a.in[16]); }
    SEAM(7);
    if (IN(8)) { phase_final(F, a.in[17], a.in[18], a.out); }
#undef IN
#undef SEAM
}

extern "C" void kernel_launch(void* const* d_in, const int* in_sizes, int n_in, void* d_out, int out_size, void* d_ws, size_t ws_size, hipStream_t stream) {
    static int grid = 0;
    if (grid == 0) {
        if (n_in != 19 || out_size != T_TOK * DM || ws_size < WS_END) { fprintf(stderr, "kernel_launch: unexpected problem shape (n_in %d out %d ws %zu)\n", n_in, out_size, ws_size); grid = -1; return; }
        int dev = 0, cus = 0, per_cu = 0;
        if (hipGetDevice(&dev) != hipSuccess || hipDeviceGetAttribute(&cus, hipDeviceAttributeMultiprocessorCount, dev) != hipSuccess) { grid = -1; return; }
        if (hipFuncSetAttribute((const void*)fwd_kernel, hipFuncAttributeMaxDynamicSharedMemorySize, LDS_BYTES) != hipSuccess) { fprintf(stderr, "kernel_launch: hipFuncSetAttribute failed\n"); grid = -1; return; }
        if (hipOccupancyMaxActiveBlocksPerMultiprocessor(&per_cu, (const void*)fwd_kernel, 512, LDS_BYTES) != hipSuccess || per_cu < 1)
            fprintf(stderr, "kernel_launch: occupancy query reports %d\n", per_cu);
        (void)hipGetLastError();
        grid = cus;
    }
    if (grid < 0) return;
    (void)hipMemsetAsync((char*)d_ws + WS_CTL, 0, CTL_BYTES, stream);
    Args a{};
    for (int i = 0; i < 19; ++i) a.in[i] = (const float*)d_in[i];
    a.out = (float*)d_out; a.ws = (unsigned char*)d_ws;
    if (MK_N_LAUNCHES == 1) {
        a.ph_lo = 0; a.ph_hi = NPHASE;
        hipLaunchKernelGGL(fwd_kernel, dim3(grid), dim3(512), LDS_BYTES, stream, a);
    } else {
        for (int p = 0; p < NPHASE; ++p) {
            a.ph_lo = p; a.ph_hi = p + 1;
            hipLaunchKernelGGL(fwd_kernel, dim3(grid), dim3(512), LDS_BYTES, stream, a);
        }
    }
}
```

```cpp
#include <hip/hip_runtime.h>
#include <cstdio>
#include <cstdint>

#ifndef MK_N_LAUNCHES
#define MK_N_LAUNCHES 1
#endif

#define LAS __attribute__((address_space(3)))
typedef unsigned short bf16;
typedef short bf16x8 __attribute__((ext_vector_type(8)));
typedef short s16x4 __attribute__((ext_vector_type(4)));
typedef float f32x4 __attribute__((ext_vector_type(4)));
typedef float f32x2 __attribute__((ext_vector_type(2)));
typedef unsigned u32x4 __attribute__((ext_vector_type(4)));
typedef unsigned u32x2 __attribute__((ext_vector_type(2)));
typedef __bf16 bf2_t __attribute__((ext_vector_type(2)));

constexpr int T_TOK = 16384, SEQ = 8192, DM = 1024, INW = 2304, NEXP = 256;
constexpr int NPHASE = 9;
constexpr float ALPHA = 1.189207115002721f;
constexpr int LCAP = 16384;

constexpr size_t MiB = 1u << 20;
constexpr size_t WS_CTL = 0, CTL_BYTES = 1 * MiB;
constexpr size_t WS_COS = 1 * MiB, WS_SIN = 2 * MiB;
constexpr size_t WS_H0B = 4 * MiB;
constexpr size_t WS_PROJ = 36 * MiB;
constexpr size_t WS_MIXIN = 108 * MiB;
constexpr size_t WS_PRE1 = 140 * MiB;
constexpr size_t WS_H1B = 204 * MiB;
constexpr size_t WS_KVT = 236 * MiB;
constexpr size_t WS_STATE = 252 * MiB;
constexpr size_t WS_LISTS = 260 * MiB;
constexpr size_t WS_ROWW = 276 * MiB;
constexpr size_t WS_YROWS = 280 * MiB;
constexpr size_t WS_WIMG = 576 * MiB;
constexpr int WIMG_IN = 0, WIMG_OUT = 144, WIMG_RT = 208, WIMG_N = 224;
constexpr size_t WS_WT_IN = 620 * MiB;
constexpr size_t WS_WT_OUT = 624 * MiB;
constexpr size_t WS_LIST2 = 584 * MiB;
constexpr size_t WS_END = 626 * MiB;
constexpr int CW_BAR = 4096;
constexpr int CW_CNT = 16384;

constexpr int L_BS0 = 0, L_AS0 = 65536, L_ACTLO = 114688, L_TAB = 147456, LDS_BYTES = 163840;
constexpr int TB_MISC = 0;
constexpr int TB_RTOK = 256;
constexpr int TB_RYROW = 768;
constexpr int TB_RW = 1280;
constexpr int TB_PREFIX = 2048;
constexpr int TB_HIST = 4096;
constexpr int TB_BASE = 5120;
constexpr int TB_SEL = 6144;
constexpr int TB_SELW = 10496;
constexpr int TB_CNT = 12544;
constexpr int TB_UNIT = 10240;

__device__ __forceinline__ unsigned pk2(float lo, float hi) { f32x2 v = {lo, hi}; bf2_t r = __builtin_convertvector(v, bf2_t); return __builtin_bit_cast(unsigned, r); }
__device__ __forceinline__ float bflo(unsigned u) { return __uint_as_float(u << 16); }
__device__ __forceinline__ float bfhi(unsigned u) { return __uint_as_float(u & 0xffff0000u); }
__device__ __forceinline__ float wave_sum(float v) {
#pragma unroll
    for (int o = 1; o < 64; o <<= 1) v += __shfl_xor(v, o);
    return v;
}
#define VM_WAIT() asm volatile("s_waitcnt vmcnt(0)" ::: "memory")
#define ALL_WAIT() asm volatile("s_waitcnt vmcnt(0) lgkmcnt(0)" ::: "memory")
#define BLOCK_SYNC() do { ALL_WAIT(); __syncthreads(); } while (0)

__device__ __forceinline__ int fresh_lane() { int l; asm volatile("v_mbcnt_lo_u32_b32 %0, -1, 0\n\tv_mbcnt_hi_u32_b32 %0, -1, %0" : "=v"(l)); return l; }
#define XB_TMO      128
#define XB_XCNT(j)  (256  + 64 * (j))
#define XB_XSUB(j)  (1280 + 64 * (j))
#define XB_XGEN(j)  (2304 + 64 * (j))
#define XB_TOP      3328
#define XB_TOPGEN   3392
#define XCD_BAR_WORDS 3456
#define XB_SPIN_CAP (1u << 18)
__device__ __forceinline__ unsigned xb_ld(unsigned* p)              { return __hip_atomic_load(p, __ATOMIC_RELAXED, __HIP_MEMORY_SCOPE_AGENT); }
__device__ __forceinline__ unsigned xb_add(unsigned* p, unsigned v) { return __hip_atomic_fetch_add(p, v, __ATOMIC_RELAXED, __HIP_MEMORY_SCOPE_AGENT); }
__device__ __forceinline__ unsigned xb_xcc_id() { return (unsigned)__builtin_amdgcn_s_getreg((3 << 11) | 20) & 0xFu; }
#define XB_SPIN(cond, bar) do { unsigned _sp = 0; while (cond) { __builtin_amdgcn_s_sleep(1); \
    if ((++_sp & 255u) == 0u) { if (xb_ld(&(bar)[XB_TMO])) break; if (_sp > XB_SPIN_CAP) { atomicAdd(&(bar)[XB_TMO], 1u); break; } } } } while (0)
struct XcdBarrier { unsigned* bar; unsigned x; volatile LAS unsigned* st; int w0; };
__device__ __forceinline__ XcdBarrier xcd_barrier_post(unsigned* bar, volatile LAS unsigned* st) {
    XcdBarrier b; b.bar = bar; b.x = xb_xcc_id(); b.st = st; b.w0 = 0;
    if (threadIdx.x == 0) (void)xb_add(&bar[XB_XCNT(b.x)], 1u);
    return b;
}
__device__ __forceinline__ void xcd_barrier_complete(unsigned* bar, unsigned x, unsigned& nloc, unsigned& nx) {
    const unsigned G = gridDim.x * gridDim.y * gridDim.z;
    unsigned sum, cnt, mine, sp = 0u;
    for (;;) {
        sum = 0u; cnt = 0u; mine = 0u;
#pragma unroll
        for (unsigned j = 0; j < 16; ++j) { const unsigned c = xb_ld(&bar[XB_XCNT(j)]); sum += c; cnt += (c > 0u) ? 1u : 0u; mine = (j == x) ? c : mine; }
        if (sum == G) break;
        __builtin_amdgcn_s_sleep(1);
        if ((++sp & 255u) == 0u) { if (xb_ld(&bar[XB_TMO])) break; if (sp > XB_SPIN_CAP) { atomicAdd(&bar[XB_TMO], 1u); break; } }
    }
    nloc = mine > 0u ? mine : 1u; nx = cnt > 0u ? cnt : 1u;
}
__device__ __forceinline__ void xcd_barrier(const XcdBarrier& b) {
    asm volatile("s_waitcnt vmcnt(0)" ::: "memory");
    __syncthreads();
    if (b.w0 && fresh_lane() == 0) {
        unsigned* bar = b.bar;
        __builtin_amdgcn_s_waitcnt(0);
        unsigned nloc = b.st[0], nx = b.st[1];
        if (nloc == 0u) { xcd_barrier_complete(bar, b.x, nloc, nx); b.st[0] = nloc; b.st[1] = nx; }
        const unsigned old = xb_add(&bar[XB_XSUB(b.x)], 1u);
        const unsigned gen = old / nloc;
        if (old + 1u == (gen + 1u) * nloc) {
            __builtin_amdgcn_fence(__ATOMIC_RELEASE, "agent");
            asm volatile("s_waitcnt vmcnt(0)" ::: "memory");
            const unsigned og = xb_add(&bar[XB_TOP], 1u);
            const unsigned tg = og / nx;
            if (og + 1u == (tg + 1u) * nx) xb_add(&bar[XB_TOPGEN], 1u);
            else XB_SPIN(xb_ld(&bar[XB_TOPGEN]) == tg, bar);
            __builtin_amdgcn_fence(__ATOMIC_ACQUIRE, "agent");
            xb_add(&bar[XB_XGEN(b.x)], 1u);
            asm volatile("s_waitcnt vmcnt(0)" ::: "memory");
        } else {
            XB_SPIN(xb_ld(&bar[XB_XGEN(b.x)]) == gen, bar);
            __builtin_amdgcn_fence(__ATOMIC_ACQUIRE, "agent");
            asm volatile("s_waitcnt vmcnt(0)" ::: "memory");
        }
    }
    __syncthreads();
}


namespace pg8 {
#define PG8_LAS __attribute__((address_space(3)))
typedef unsigned short bf16_t;
constexpr int BM = 256, BK = 64, HALF = 128, HTB = HALF * BK * 2;
__host__ __device__ __forceinline__ int lds_byte(int r, int c) { const int st = (r >> 4) * 2 + (c >> 5), rr = r & 15, cc = c & 31, ob = rr * 64 + cc * 2; return st * 1024 + (ob ^ (((ob >> 9) & 1) << 5)); }
__host__ __device__ __forceinline__ void stage_rc(int b, int& R, int& C) { const int st = b / 1024, sb = b % 1024, swz = sb ^ (((sb >> 9) & 1) << 5); R = (st >> 1) * 16 + swz / 64; C = (st & 1) * 32 + (swz % 64) / 2; }
struct Unit { int pm, pn; };
struct Gemm { const bf16_t* A; const bf16_t* Bt; int K; };
template <class Epi, class Sched>
__device__ __forceinline__ void gemm_phase(PG8_LAS unsigned char* lds, const Gemm g, const Sched& S, const Epi& E) {
    const int tid = threadIdx.x, wid = __builtin_amdgcn_readfirstlane(tid >> 6), lane = tid & 63, wr = wid >> 2, wc = wid & 3, fr = lane & 15, fq = lane >> 4;
    const int K = g.K, nt = K / BK;
    unsigned voffA[2], voffB[2];
#pragma unroll
    for (int i = 0; i < 2; ++i) { int R, C; stage_rc(tid * 16 + i * 8192, R, C); voffA[i] = (unsigned)(R * K + C) * 2u; voffB[i] = (unsigned)(R * K + C) * 2u; }
    const size_t kstep = (size_t)(BK * 2);
    const size_t hstep = (size_t)HALF * K * 2;
    const size_t tstep = 2 * hstep;
    const unsigned ldsw = (unsigned)wid * 1024u;
    const int aoff = lds_byte(wr * 64 + fr, fq * 8), boff = lds_byte(wc * 32 + fr, fq * 8);
#define PG8_SA(b, h) (((b) * 2 + (h)) * HTB)
#define PG8_SB(b, h) ((4 + (b) * 2 + (h)) * HTB)
#define PG8_STAGE(bufoff, gbase, voff) do { _Pragma("unroll") for (int _i = 0; _i < 2; ++_i) \
        __builtin_amdgcn_global_load_lds((const unsigned*)((const char*)(gbase) + (voff)[_i]), (PG8_LAS unsigned*)(lds + (bufoff) + ldsw + _i * 8192), 16, 0, 0); } while (0)
#define PG8_LDA(dst, b, h) do { _Pragma("unroll") for (int m = 0; m < 4; ++m) _Pragma("unroll") for (int k = 0; k < 2; ++k) dst[m][k] = *(const PG8_LAS bf16x8*)(lds + PG8_SA(b, h) + aoff + m * 2048 + k * 1024); } while (0)
#define PG8_LDB(dst, b, h) do { _Pragma("unroll") for (int n = 0; n < 2; ++n) _Pragma("unroll") for (int k = 0; k < 2; ++k) dst[n][k] = *(const PG8_LAS bf16x8*)(lds + PG8_SB(b, h) + boff + n * 2048 + k * 1024); } while (0)
#define PG8_MMA(ai, bj, At, Bt) do { __builtin_amdgcn_s_setprio(1); _Pragma("unroll") for (int m = 0; m < 4; ++m) _Pragma("unroll") for (int n = 0; n < 2; ++n) _Pragma("unroll") for (int k = 0; k < 2; ++k) \
        acc[ai][bj][m][n] = __builtin_amdgcn_mfma_f32_16x16x32_bf16(Bt[n][k], At[m][k], acc[ai][bj][m][n], 0, 0, 0); __builtin_amdgcn_s_setprio(0); } while (0)
#define PG8_WAIT_V(n) asm volatile("s_waitcnt vmcnt(" #n ")" ::: "memory")
#define PG8_WAIT_L(n) asm volatile("s_waitcnt lgkmcnt(" #n ")" ::: "memory")
#define PG8_BAR __builtin_amdgcn_s_barrier()
#define PG8_SCHED __builtin_amdgcn_sched_barrier(0)
    Unit cur, nxt; int ui = 0;
    if (!S.next(0, cur)) return;
    f32x4 acc[2][2][4][2];
#pragma unroll
    for (int a = 0; a < 2; ++a)
#pragma unroll
        for (int b = 0; b < 2; ++b)
#pragma unroll
            for (int m = 0; m < 4; ++m)
#pragma unroll
                for (int n = 0; n < 2; ++n) acc[a][b][m][n] = (f32x4){0.f, 0.f, 0.f, 0.f};
    bf16x8 At[4][2], B0[2][2], B1[2][2];
    const char* cA = (const char*)g.A + (size_t)cur.pm * tstep; const char* cB = (const char*)g.Bt + (size_t)cur.pn * tstep;
    PG8_STAGE(PG8_SB(0, 0), cB, voffB); PG8_STAGE(PG8_SA(0, 0), cA, voffA); PG8_STAGE(PG8_SB(0, 1), cB + hstep, voffB); PG8_STAGE(PG8_SA(0, 1), cA + hstep, voffA);
    if (wr == 1) PG8_BAR;
    PG8_WAIT_V(4); PG8_BAR;
    PG8_STAGE(PG8_SB(1, 0), cB + kstep, voffB); PG8_STAGE(PG8_SA(1, 0), cA + kstep, voffA); PG8_STAGE(PG8_SB(1, 1), cB + hstep + kstep, voffB);
    PG8_WAIT_V(6); PG8_BAR;
    for (;;) {
        const bool has_next = S.next(ui + 1, nxt);
        const char* nA = has_next ? (const char*)g.A + (size_t)nxt.pm * tstep : cA; const char* nB = has_next ? (const char*)g.Bt + (size_t)nxt.pn * tstep : cB;
        for (int t = 0; t < nt; t += 2) {
            const bool last = (t == nt - 2);
            const char* a1 = cA + (size_t)(t + 1) * kstep;
            const char* a2 = last ? nA : cA + (size_t)(t + 2) * kstep; const char* b2 = last ? nB : cB + (size_t)(t + 2) * kstep;
            const char* a3 = a2 + kstep; const char* b3 = b2 + kstep;
            PG8_LDB(B0, 0, 0); PG8_SCHED; PG8_LDA(At, 0, 0); PG8_STAGE(PG8_SA(1, 1), a1 + hstep, voffA);
            PG8_WAIT_L(8); PG8_BAR; PG8_WAIT_L(0); PG8_MMA(0, 0, At, B0); PG8_BAR; PG8_SCHED;
            PG8_LDB(B1, 0, 1); PG8_STAGE(PG8_SB(0, 0), b2, voffB);
            PG8_BAR; PG8_WAIT_L(0); PG8_MMA(0, 1, At, B1); PG8_BAR;
            PG8_LDA(At, 0, 1); PG8_STAGE(PG8_SA(0, 0), a2, voffA);
            PG8_BAR; PG8_WAIT_L(0); PG8_MMA(1, 0, At, B0); PG8_BAR; PG8_SCHED;
            PG8_STAGE(PG8_SB(0, 1), b2 + hstep, voffB);
            PG8_WAIT_V(6); PG8_BAR; PG8_MMA(1, 1, At, B1); PG8_BAR;
            PG8_LDB(B0, 1, 0); PG8_SCHED; PG8_LDA(At, 1, 0); PG8_STAGE(PG8_SA(0, 1), a2 + hstep, voffA);
            PG8_WAIT_L(8); PG8_BAR; PG8_WAIT_L(0); PG8_MMA(0, 0, At, B0); PG8_BAR; PG8_SCHED;
            PG8_LDB(B1, 1, 1); PG8_STAGE(PG8_SB(1, 0), b3, voffB);
            PG8_BAR; PG8_WAIT_L(0); PG8_MMA(0, 1, At, B1); PG8_BAR;
            PG8_LDA(At, 1, 1); PG8_STAGE(PG8_SA(1, 0), a3, voffA);
            PG8_BAR; PG8_WAIT_L(0); PG8_MMA(1, 0, At, B0); PG8_BAR; PG8_SCHED;
            PG8_STAGE(PG8_SB(1, 1), b3 + hstep, voffB);
            PG8_WAIT_V(6); PG8_BAR; PG8_MMA(1, 1, At, B1); PG8_BAR;
        }
            E(acc, cur, wr, wc, fr, fq);
            if (!has_next) break;
#pragma unroll
        for (int a = 0; a < 2; ++a)
#pragma unroll
            for (int b = 0; b < 2; ++b)
#pragma unroll
                for (int m = 0; m < 4; ++m)
#pragma unroll
                    for (int n = 0; n < 2; ++n) acc[a][b][m][n] = (f32x4){0.f, 0.f, 0.f, 0.f};
        cur = nxt; cA = nA; cB = nB; ++ui;
    }
    PG8_WAIT_V(0);
    if (wr == 0) PG8_BAR;
    PG8_BAR;
#undef PG8_SA
#undef PG8_SB
#undef PG8_STAGE
#undef PG8_LDA
#undef PG8_LDB
#undef PG8_MMA
#undef PG8_WAIT_V
#undef PG8_WAIT_L
#undef PG8_BAR
#undef PG8_SCHED
}
}

struct Args {
    const float* in[19];
    float* out;
    unsigned char* ws;
    int ph_lo, ph_hi;
};
struct Frame {
    LAS unsigned char* lds;
    int tid, lane, wave, vcu, G;
    unsigned char* ws;
};

template <int MT, int KH0 = 0, int KH1 = 2>
__device__ __forceinline__ void mma_ktile(f32x4 (&acc)[MT][4], LAS const unsigned char* As, LAS const unsigned char* Bs, const unsigned (&foa)[2], const unsigned (&fob)[2][2]) {
#pragma unroll
    for (int kh = KH0; kh < KH1; ++kh) {
        bf16x8 af[MT], bfr[4];
#pragma unroll
        for (int m = 0; m < MT; ++m) af[m] = *(LAS const bf16x8*)(As + m * 2048 + foa[kh]);
#pragma unroll
        for (int n = 0; n < 4; ++n) bfr[n] = *(LAS const bf16x8*)(Bs + n * 2048 + fob[kh][n & 1]);
#pragma unroll
        for (int m = 0; m < MT; ++m)
#pragma unroll
            for (int n = 0; n < 4; ++n)
                acc[m][n] = __builtin_amdgcn_mfma_f32_16x16x32_bf16(bfr[n], af[m], acc[m][n], 0, 0, 0);
    }
}
__device__ __forceinline__ void loadB32(f32x4 (&r)[8], const float* p, size_t ldb) {
#pragma unroll
    for (int i = 0; i < 8; ++i) { r[i] = *(const f32x4*)p; p += ldb; }
}
__device__ __forceinline__ void storeB32(const f32x4 (&r)[8], LAS unsigned char* Bs, int n0, int c) {
#pragma unroll
    for (int j = 0; j < 4; ++j) {
        u32x4 w; w.x = pk2(r[0][j], r[1][j]); w.y = pk2(r[2][j], r[3][j]); w.z = pk2(r[4][j], r[5][j]); w.w = pk2(r[6][j], r[7][j]);
        const int n = n0 + j, x = (n >> 3) & 3, g = ((x & 1) << 1) | (x >> 1);
        *(LAS u32x4*)(Bs + n * 128 + ((c ^ (n & 7) ^ g) << 4)) = w;
    }
}
template <int MT>
__device__ __forceinline__ void dmaA(LAS unsigned char* As, const bf16* p0, const bf16* p1, int wave) {
    __builtin_amdgcn_global_load_lds((const unsigned*)p0, (LAS unsigned*)(As + wave * 1024), 16, 0, 0);
    if (MT == 4) __builtin_amdgcn_global_load_lds((const unsigned*)p1, (LAS unsigned*)(As + wave * 1024 + 8192), 16, 0, 0);
}
#define LGKM_BAR() do { asm volatile("s_waitcnt lgkmcnt(0)" ::: "memory"); __builtin_amdgcn_s_barrier(); asm volatile("" ::: "memory"); } while (0)
template <bool A_LDS>
__device__ __forceinline__ int a_tile_off(int t) { return A_LDS ? ((t < 2) ? L_ACTLO + t * 16384 : L_AS0 + (t - 2) * 16384) : L_AS0 + (t % 3) * 16384; }
template <bool A_LDS, int MT = 4>
__device__ __forceinline__ void gemm_loop(f32x4 (&acc)[MT][4], const Frame& F, const bf16* ap0, const bf16* ap1, const float* bp, size_t ldb, int nk, int rot = 0) {
    LAS unsigned char* lds = F.lds;
    const int lane = F.lane, wave = F.wave, wr = wave >> 2, wc = wave & 3, fr = lane & 15, fq = lane >> 4;
    unsigned foa[2], fob[2][2];
#pragma unroll
    for (int kh = 0; kh < 2; ++kh) {
        foa[kh] = (unsigned)(fr * 128 + ((((4 * kh + fq)) ^ (fr & 7)) << 4));
#pragma unroll
        for (int par = 0; par < 2; ++par) fob[kh][par] = (unsigned)(fr * 128 + (((4 * kh + fq) ^ (fr & 7) ^ ((fr >> 3) << 1) ^ par) << 4));
    }
    const int n0 = 4 * lane;
    const float* bpp = bp + (size_t)(8 * wave) * ldb;
    const size_t tstep = 64 * ldb;
    f32x4 r0[8], r1[8];
#define WAITV(more) do { if (more) { if (A_LDS) asm volatile("s_waitcnt vmcnt(8)" ::: "memory"); else if (MT == 4) asm volatile("s_waitcnt vmcnt(10)" ::: "memory"); else asm volatile("s_waitcnt vmcnt(9)" ::: "memory"); } else asm volatile("s_waitcnt vmcnt(0)" ::: "memory"); } while (0)
#define KT(t) (((t) ^ rot) & (nk - 1))
#define ENDWAIT(nb, na) do { if (nb) { if (A_LDS) asm volatile("s_waitcnt vmcnt(8)" ::: "memory"); else if (MT == 4) asm volatile("s_waitcnt vmcnt(10)" ::: "memory"); else asm volatile("s_waitcnt vmcnt(9)" ::: "memory"); } \
                             else if ((na) && !A_LDS) { if (MT == 4) asm volatile("s_waitcnt vmcnt(2)" ::: "memory"); else asm volatile("s_waitcnt vmcnt(1)" ::: "memory"); } \
                             else asm volatile("s_waitcnt vmcnt(0)" ::: "memory"); } while (0)
    loadB32(r0, bpp + (size_t)KT(0) * tstep, ldb);
    if (!A_LDS) dmaA<MT>(lds + L_AS0, ap0 + KT(0) * 64, ap1 + KT(0) * 64, wave);
    if (nk > 1) { loadB32(r1, bpp + (size_t)KT(1) * tstep, ldb); if (!A_LDS) dmaA<MT>(lds + L_AS0 + 16384, ap0 + KT(1) * 64, ap1 + KT(1) * 64, wave); }
    __builtin_amdgcn_sched_barrier(0);
    WAITV(nk > 1);
    storeB32(r0, lds + L_BS0, n0, wave);
    if (nk > 2) loadB32(r0, bpp + (size_t)KT(2) * tstep, ldb);
    __builtin_amdgcn_sched_barrier(0);
    if (nk > 2) { asm volatile("s_waitcnt vmcnt(8)" ::: "memory"); } else asm volatile("s_waitcnt vmcnt(0)" ::: "memory");
    LGKM_BAR();
    for (int t = 0; t < nk; t += 2) {
        if (t + 1 < nk) storeB32(r1, lds + L_BS0 + 32768, n0, wave);
        if (t + 3 < nk) loadB32(r1, bpp + (size_t)KT(t + 3) * tstep, ldb);
        __builtin_amdgcn_sched_barrier(0);
        mma_ktile<MT, 0, 1>(acc, lds + (A_LDS ? a_tile_off<true>(KT(t)) : a_tile_off<false>(t)) + wr * (MT * 2048), lds + L_BS0 + wc * 8192, foa, fob);
        __builtin_amdgcn_sched_barrier(0);
        if (t + 2 < nk) { if (!A_LDS) dmaA<MT>(lds + a_tile_off<false>(t + 2), ap0 + KT(t + 2) * 64, ap1 + KT(t + 2) * 64, wave); }
        __builtin_amdgcn_sched_barrier(0);
        mma_ktile<MT, 1, 2>(acc, lds + (A_LDS ? a_tile_off<true>(KT(t)) : a_tile_off<false>(t)) + wr * (MT * 2048), lds + L_BS0 + wc * 8192, foa, fob);
        __builtin_amdgcn_sched_barrier(0);
        ENDWAIT(t + 3 < nk, t + 2 < nk);
        LGKM_BAR();
        if (t + 1 >= nk) break;
        if (t + 2 < nk) storeB32(r0, lds + L_BS0, n0, wave);
        if (t + 4 < nk) loadB32(r0, bpp + (size_t)KT(t + 4) * tstep, ldb);
        __builtin_amdgcn_sched_barrier(0);
        mma_ktile<MT, 0, 1>(acc, lds + (A_LDS ? a_tile_off<true>(KT(t + 1)) : a_tile_off<false>(t + 1)) + wr * (MT * 2048), lds + L_BS0 + 32768 + wc * 8192, foa, fob);
        __builtin_amdgcn_sched_barrier(0);
        if (t + 3 < nk) { if (!A_LDS) dmaA<MT>(lds + a_tile_off<false>(t + 3), ap0 + KT(t + 3) * 64, ap1 + KT(t + 3) * 64, wave); }
        __builtin_amdgcn_sched_barrier(0);
        mma_ktile<MT, 1, 2>(acc, lds + (A_LDS ? a_tile_off<true>(KT(t + 1)) : a_tile_off<false>(t + 1)) + wr * (MT * 2048), lds + L_BS0 + 32768 + wc * 8192, foa, fob);
        __builtin_amdgcn_sched_barrier(0);
        ENDWAIT(t + 4 < nk, t + 3 < nk);
        LGKM_BAR();
    }
#undef ENDWAIT
#undef WAITV
#undef KT
}
template <int OFF>
__device__ __forceinline__ void gld16(f32x4& d, const float* p) { asm volatile("global_load_dwordx4 %0, %1, off offset:%2" : "=&v"(d) : "v"(p), "n"(OFF) : "memory"); }
template <int LDB>
__device__ __forceinline__ void loadB32a(f32x4 (&r)[8], const float* p) {
    if (LDB == 256) {
        const float* q = p + 4 * LDB;
        gld16<-4096>(r[0], q); gld16<-3072>(r[1], q); gld16<-2048>(r[2], q); gld16<-1024>(r[3], q); gld16<0>(r[4], q); gld16<1024>(r[5], q); gld16<2048>(r[6], q); gld16<3072>(r[7], q);
    } else {
        const float* q0 = p + LDB; const float* q1 = p + 3 * LDB; const float* q2 = p + 5 * LDB; const float* q3 = p + 7 * LDB;
        gld16<-4096>(r[0], q0); gld16<0>(r[1], q0); gld16<-4096>(r[2], q1); gld16<0>(r[3], q1); gld16<-4096>(r[4], q2); gld16<0>(r[5], q2); gld16<-4096>(r[6], q3); gld16<0>(r[7], q3);
    }
}
#define TIE8(r) "+v"(r[0]), "+v"(r[1]), "+v"(r[2]), "+v"(r[3]), "+v"(r[4]), "+v"(r[5]), "+v"(r[6]), "+v"(r[7])
template <int N> __device__ __forceinline__ void wait_vmc() {
    static_assert(N >= 0 && N <= 12 && N % 2 == 0, "vmcnt");
    if (N == 0) asm volatile("s_waitcnt vmcnt(0)" ::: "memory"); else if (N == 2) asm volatile("s_waitcnt vmcnt(2)" ::: "memory"); else if (N == 4) asm volatile("s_waitcnt vmcnt(4)" ::: "memory");
    else if (N == 6) asm volatile("s_waitcnt vmcnt(6)" ::: "memory"); else if (N == 8) asm volatile("s_waitcnt vmcnt(8)" ::: "memory"); else if (N == 10) asm volatile("s_waitcnt vmcnt(10)" ::: "memory");
    else asm volatile("s_waitcnt vmcnt(12)" ::: "memory");
}
template <bool A_LDS, int NK, int LDB, bool LATE = false>
__device__ __forceinline__ void gemm_loopa(f32x4 (&acc)[4][4], const Frame& F, const bf16* ap0, const bf16* ap1, const float* bp, int rot) {
    static_assert(LDB == 256 || LDB == 1024, "row pitch of the f32 B source");
    constexpr int MT = 4;
    LAS unsigned char* lds = F.lds;
    const int lane = F.lane, wave = F.wave, wr = wave >> 2, wc = wave & 3, fr = lane & 15, fq = lane >> 4;
    unsigned foa[2], fob[2][2];
#pragma unroll
    for (int kh = 0; kh < 2; ++kh) {
        foa[kh] = (unsigned)(fr * 128 + ((((4 * kh + fq)) ^ (fr & 7)) << 4));
#pragma unroll
        for (int par = 0; par < 2; ++par) fob[kh][par] = (unsigned)(fr * 128 + (((4 * kh + fq) ^ (fr & 7) ^ ((fr >> 3) << 1) ^ par) << 4));
    }
    const int n0 = 4 * lane;
    const float* bpp = bp + (size_t)(8 * wave) * LDB;
    constexpr size_t tstep = (size_t)64 * LDB;
    f32x4 r0[8], r1[8];
#define KT(t) (((t) ^ rot) & (NK - 1))
#define XWAIT(nb, na, RS) do { if (nb) { if (A_LDS) asm volatile("s_waitcnt vmcnt(8)" : TIE8(RS) :: "memory"); else asm volatile("s_waitcnt vmcnt(10)" : TIE8(RS) :: "memory"); } \
                               else if ((na) && !A_LDS) asm volatile("s_waitcnt vmcnt(2)" : TIE8(RS) :: "memory"); \
                               else asm volatile("s_waitcnt vmcnt(0)" : TIE8(RS) :: "memory"); } while (0)
#define X_ATILE(t) (lds + (A_LDS ? a_tile_off<true>(KT(t)) : a_tile_off<false>(t)) + wr * (MT * 2048))
#define X_EVEN(t, H1, H2, H3) do { \
        if (H1) storeB32(r1, lds + L_BS0 + 32768, n0, wave); \
        if (H3) loadB32a<LDB>(r1, bpp + (size_t)KT((t) + 3) * tstep); \
        __builtin_amdgcn_sched_barrier(0); \
        mma_ktile<MT, 0, 1>(acc, X_ATILE(t), lds + L_BS0 + wc * 8192, foa, fob); \
        __builtin_amdgcn_sched_barrier(0); \
        if ((H2) && !A_LDS) dmaA<MT>(lds + a_tile_off<false>((t) + 2), ap0 + KT((t) + 2) * 64, ap1 + KT((t) + 2) * 64, wave); \
        __builtin_amdgcn_sched_barrier(0); \
        mma_ktile<MT, 1, 2>(acc, X_ATILE(t), lds + L_BS0 + wc * 8192, foa, fob); \
        __builtin_amdgcn_sched_barrier(0); \
        XWAIT(H3, H2, r0); \
        LGKM_BAR(); } while (0)
#define X_ODD(t, H2, H3, H4) do { \
        if (H2) storeB32(r0, lds + L_BS0, n0, wave); \
        if (H4) loadB32a<LDB>(r0, bpp + (size_t)KT((t) + 4) * tstep); \
        __builtin_amdgcn_sched_barrier(0); \
        mma_ktile<MT, 0, 1>(acc, X_ATILE((t) + 1), lds + L_BS0 + 32768 + wc * 8192, foa, fob); \
        __builtin_amdgcn_sched_barrier(0); \
        if ((H3) && !A_LDS) dmaA<MT>(lds + a_tile_off<false>((t) + 3), ap0 + KT((t) + 3) * 64, ap1 + KT((t) + 3) * 64, wave); \
        __builtin_amdgcn_sched_barrier(0); \
        mma_ktile<MT, 1, 2>(acc, X_ATILE((t) + 1), lds + L_BS0 + 32768 + wc * 8192, foa, fob); \
        __builtin_amdgcn_sched_barrier(0); \
        XWAIT(H4, H3, r1); \
        LGKM_BAR(); } while (0)
    loadB32a<LDB>(r0, bpp + (size_t)KT(0) * tstep);
    if (!A_LDS) dmaA<MT>(lds + L_AS0, ap0 + KT(0) * 64, ap1 + KT(0) * 64, wave);
    loadB32a<LDB>(r1, bpp + (size_t)KT(1) * tstep);
    if (!A_LDS) dmaA<MT>(lds + L_AS0 + 16384, ap0 + KT(1) * 64, ap1 + KT(1) * 64, wave);
    __builtin_amdgcn_sched_barrier(0);
    if (A_LDS) asm volatile("s_waitcnt vmcnt(8)" : TIE8(r0) :: "memory"); else asm volatile("s_waitcnt vmcnt(10)" : TIE8(r0) :: "memory");
    storeB32(r0, lds + L_BS0, n0, wave);
    loadB32a<LDB>(r0, bpp + (size_t)KT(2) * tstep);
    __builtin_amdgcn_sched_barrier(0);
    asm volatile("s_waitcnt vmcnt(8)" : TIE8(r1) :: "memory");
    LGKM_BAR();
    constexpr int T0 = (NK > 4) ? ((NK - 3) / 2) * 2 : 0;
    if (!LATE) {
#pragma unroll 1
        for (int t = 0; t < T0; t += 2) { X_EVEN(t, true, true, true); X_ODD(t, true, true, true); }
#pragma unroll
        for (int t = T0; t < NK; t += 2) { X_EVEN(t, t + 1 < NK, t + 2 < NK, t + 3 < NK); X_ODD(t, t + 2 < NK, t + 3 < NK, t + 4 < NK); }
    } else {
#define L_NB(s) ((s) + 3 < NK)
#define L_NA(s) (!A_LDS && (s) + 2 < NK)
#define L_STEP(s, RS, BOFF, WA, WB) do { \
        mma_ktile<MT, 0, 2>(acc, X_ATILE(s), lds + L_BS0 + (BOFF) + wc * 8192, foa, fob); \
        __builtin_amdgcn_sched_barrier(0); \
        if ((s) + 1 < NK) { wait_vmc<WA>(); asm volatile("" : TIE8(RS) :: "memory"); storeB32(RS, lds + L_BS0 + (32768 - (BOFF)), n0, wave); } \
        if (L_NB(s)) loadB32a<LDB>(RS, bpp + (size_t)KT((s) + 3) * tstep); \
        if (L_NA(s)) dmaA<MT>(lds + a_tile_off<false>((s) + 2), ap0 + KT((s) + 2) * 64, ap1 + KT((s) + 2) * 64, wave); \
        __builtin_amdgcn_sched_barrier(0); \
        if (!A_LDS && (s) + 1 < NK) wait_vmc<WB>(); \
        LGKM_BAR(); } while (0)
        constexpr int WAS = A_LDS ? 8 : 10, WBS = 10;
#pragma unroll 1
        for (int t = 0; t < T0; t += 2) { L_STEP(t, r1, 0, WAS, WBS); L_STEP(t + 1, r0, 32768, WAS, WBS); }
#define L_WA(s) ((((s) >= 2 ? L_NA((s) - 2) : ((s) == 0 && !A_LDS)) ? 2 : 0) + (((s) >= 1 ? L_NB((s) - 1) : true) ? 8 : 0) + (((s) >= 1 && L_NA((s) - 1)) ? 2 : 0))
#define L_WB(s) ((L_NB(s) ? 8 : 0) + (L_NA(s) ? 2 : 0))
#define L_TAIL(s, RS, BOFF) L_STEP(s, RS, BOFF, (L_WA(s) > 10 ? 10 : L_WA(s)), L_WB(s))
        static_assert(T0 % 2 == 0 && NK - T0 == 4, "tail of four steps");
        L_TAIL(T0, r1, 0); L_TAIL(T0 + 1, r0, 32768); L_TAIL(T0 + 2, r1, 0); L_TAIL(T0 + 3, r0, 32768);
#undef L_TAIL
#undef L_WA
#undef L_WB
#undef L_STEP
#undef L_NA
#undef L_NB
    }
#undef X_EVEN
#undef X_ODD
#undef X_ATILE
#undef XWAIT
#undef KT
}
template <bool A_LDS, int NK, int LDB, bool LATE, bool PRE, bool CHAIN>
__device__ __forceinline__ void gemm_chain(f32x4 (&acc)[4][4], const Frame& F, f32x4 (&r0)[8], f32x4 (&r1)[8], const char* abase, unsigned ao0, unsigned ao1, const float* bp, const float* bpn, int rot, int rb) {
    static_assert(LDB == 256 || LDB == 1024, "row pitch of the f32 B source");
    constexpr int MT = 4;
    LAS unsigned char* lds = F.lds;
    const int lane = F.lane, wave = F.wave, wr = wave >> 2, wc = wave & 3, fr = lane & 15, fq = lane >> 4;
    unsigned foa[2], fob[2][2];
#pragma unroll
    for (int kh = 0; kh < 2; ++kh) {
        foa[kh] = (unsigned)(fr * 128 + ((((4 * kh + fq)) ^ (fr & 7)) << 4));
#pragma unroll
        for (int par = 0; par < 2; ++par) fob[kh][par] = (unsigned)(fr * 128 + (((4 * kh + fq) ^ (fr & 7) ^ ((fr >> 3) << 1) ^ par) << 4));
    }
    const int n0 = 4 * lane;
    const float* bpp = bp + (size_t)(8 * wave) * LDB;
    const float* bppn = bpn + (size_t)(8 * wave) * LDB;
    constexpr size_t tstep = (size_t)64 * LDB;
#define KT(t) (((t) ^ rot) & (NK - 1))
#define C_BPTR(j) ((((j) < NK) ? bpp : bppn) + (size_t)KT(j) * tstep)
#define C_ASLOT(j) (L_AS0 + (((j) + rb) % 3) * 16384)
#define C_ADMA(j) do { unsigned a0_ = ao0, a1_ = ao1; asm volatile("" : "+v"(a0_), "+v"(a1_)); const unsigned ko_ = (unsigned)KT(j) * 128u;     \
        dmaA<MT>(lds + C_ASLOT(j), (const bf16*)(abase + (a0_ + ko_)), (const bf16*)(abase + (a1_ + ko_)), wave); } while (0)
#define XWAIT(nb, na, RS) do { if (nb) { if (A_LDS) asm volatile("s_waitcnt vmcnt(8)" : TIE8(RS) :: "memory"); else asm volatile("s_waitcnt vmcnt(10)" : TIE8(RS) :: "memory"); } \
                               else if ((na) && !A_LDS) asm volatile("s_waitcnt vmcnt(2)" : TIE8(RS) :: "memory"); \
                               else asm volatile("s_waitcnt vmcnt(0)" : TIE8(RS) :: "memory"); } while (0)
#define X_ATILE(t) (lds + (A_LDS ? a_tile_off<true>(KT(t)) : C_ASLOT(t)) + wr * (MT * 2048))
#define X_EVEN(t, H1, H2, H3) do { \
        if (H1) storeB32(r1, lds + L_BS0 + 32768, n0, wave); \
        if (H3) loadB32a<LDB>(r1, C_BPTR((t) + 3)); \
        __builtin_amdgcn_sched_barrier(0); \
        mma_ktile<MT, 0, 1>(acc, X_ATILE(t), lds + L_BS0 + wc * 8192, foa, fob); \
        __builtin_amdgcn_sched_barrier(0); \
        if ((H2) && !A_LDS) C_ADMA((t) + 2); \
        __builtin_amdgcn_sched_barrier(0); \
        mma_ktile<MT, 1, 2>(acc, X_ATILE(t), lds + L_BS0 + wc * 8192, foa, fob); \
        __builtin_amdgcn_sched_barrier(0); \
        XWAIT(H3, H2, r0); \
        LGKM_BAR(); } while (0)
#define X_ODD(t, H2, H3, H4) do { \
        if (H2) storeB32(r0, lds + L_BS0, n0, wave); \
        if (H4) loadB32a<LDB>(r0, C_BPTR((t) + 4)); \
        __builtin_amdgcn_sched_barrier(0); \
        mma_ktile<MT, 0, 1>(acc, X_ATILE((t) + 1), lds + L_BS0 + 32768 + wc * 8192, foa, fob); \
        __builtin_amdgcn_sched_barrier(0); \
        if ((H3) && !A_LDS) C_ADMA((t) + 3); \
        __builtin_amdgcn_sched_barrier(0); \
        mma_ktile<MT, 1, 2>(acc, X_ATILE((t) + 1), lds + L_BS0 + 32768 + wc * 8192, foa, fob); \
        __builtin_amdgcn_sched_barrier(0); \
        XWAIT(H4, H3, r1); \
        LGKM_BAR(); } while (0)
    if (!PRE) {
        loadB32a<LDB>(r0, C_BPTR(0));
        if (!A_LDS) C_ADMA(0);
        loadB32a<LDB>(r1, C_BPTR(1));
        if (!A_LDS) C_ADMA(1);
        __builtin_amdgcn_sched_barrier(0);
        if (A_LDS) asm volatile("s_waitcnt vmcnt(8)" : TIE8(r0) :: "memory"); else asm volatile("s_waitcnt vmcnt(10)" : TIE8(r0) :: "memory");
        storeB32(r0, lds + L_BS0, n0, wave);
        loadB32a<LDB>(r0, C_BPTR(2));
        __builtin_amdgcn_sched_barrier(0);
        asm volatile("s_waitcnt vmcnt(8)" : TIE8(r1) :: "memory");
        LGKM_BAR();
    }
    constexpr int T0 = CHAIN ? NK : ((NK > 4) ? ((NK - 3) / 2) * 2 : 0);
    if (!LATE) {
#pragma unroll 1
        for (int t = 0; t < T0; t += 2) { X_EVEN(t, true, true, true); X_ODD(t, true, true, true); }
        if (!CHAIN) {
#pragma unroll
            for (int t = T0; t < NK; t += 2) { X_EVEN(t, t + 1 < NK, t + 2 < NK, t + 3 < NK); X_ODD(t, t + 2 < NK, t + 3 < NK, t + 4 < NK); }
        }
    } else {
#define L_NB(s) (CHAIN || (s) + 3 < NK)
#define L_NA(s) (!A_LDS && (CHAIN || (s) + 2 < NK))
#define L_STEP(s, RS, BOFF, WA, WB) do { \
        mma_ktile<MT, 0, 2>(acc, X_ATILE(s), lds + L_BS0 + (BOFF) + wc * 8192, foa, fob); \
        __builtin_amdgcn_sched_barrier(0); \
        if (CHAIN || (s) + 1 < NK) { wait_vmc<WA>(); asm volatile("" : TIE8(RS) :: "memory"); storeB32(RS, lds + L_BS0 + (32768 - (BOFF)), n0, wave); } \
        if (L_NB(s)) loadB32a<LDB>(RS, C_BPTR((s) + 3)); \
        if (L_NA(s)) C_ADMA((s) + 2); \
        __builtin_amdgcn_sched_barrier(0); \
        if (!A_LDS && (CHAIN || (s) + 1 < NK)) wait_vmc<WB>(); \
        LGKM_BAR(); } while (0)
        constexpr int WAS = A_LDS ? 8 : 10, WBS = 10;
#pragma unroll 1
        for (int t = 0; t < T0; t += 2) { L_STEP(t, r1, 0, WAS, WBS); L_STEP(t + 1, r0, 32768, WAS, WBS); }
        if (!CHAIN) {
#define L_WA(s) ((((s) >= 2 ? L_NA((s) - 2) : ((s) == 0 && !A_LDS)) ? 2 : 0) + (((s) >= 1 ? L_NB((s) - 1) : true) ? 8 : 0) + (((s) >= 1 && L_NA((s) - 1)) ? 2 : 0))
#define L_WB(s) ((L_NB(s) ? 8 : 0) + (L_NA(s) ? 2 : 0))
#define L_TAIL(s, RS, BOFF) L_STEP(s, RS, BOFF, (L_WA(s) > 10 ? 10 : L_WA(s)), L_WB(s))
            static_assert(CHAIN || (T0 % 2 == 0 && NK - T0 == 4), "tail of four steps");
            L_TAIL(T0, r1, 0); L_TAIL(T0 + 1, r0, 32768); L_TAIL(T0 + 2, r1, 0); L_TAIL(T0 + 3, r0, 32768);
#undef L_TAIL
#undef L_WA
#undef L_WB
        }
#undef L_STEP
#undef L_NA
#undef L_NB
    }
#undef X_EVEN
#undef X_ODD
#undef X_ATILE
#undef XWAIT
#undef C_ADMA
#undef C_ASLOT
#undef C_BPTR
#undef KT
}
__device__ __forceinline__ int swz4(int row) { return (0x78 >> (2 * ((row >> 2) & 3))) & 3; }
template <int MT>
__device__ __forceinline__ void gemm_ring(f32x4 (&acc)[MT][4], const Frame& F, const bf16* abase, const unsigned (&aoff)[2], const bf16* bblk, int nst) {
    LAS unsigned char* lds = F.lds;
    const int tid = F.tid, lane = F.lane, wave = F.wave, wr = wave >> 2, wc = wave & 3, fr = lane & 15, fq = lane >> 4;
    const unsigned fo = (unsigned)(fr * 64 + ((fq ^ swz4(fr)) << 4));
    const unsigned boff = (unsigned)(tid * 16);
    const bool a_wave = (MT != 2) || (wave < 4);
#define RG_STAGE(t) do { const int sl_ = ((t) & 3) * 32768; \
        _Pragma("unroll") for (int i = 0; i < 2; ++i) __builtin_amdgcn_global_load_lds((const unsigned*)((const char*)bblk + (size_t)(t) * 16384 + boff + i * 8192), (LAS unsigned*)(lds + sl_ + 16384 + wave * 1024 + i * 8192), 16, 0, 0); \
        if (MT == 8) { _Pragma("unroll") for (int i = 0; i < 2; ++i) __builtin_amdgcn_global_load_lds((const unsigned*)((const char*)abase + (size_t)(t) * 64 + aoff[i]), (LAS unsigned*)(lds + sl_ + wave * 1024 + i * 8192), 16, 0, 0); } \
        else if (a_wave) __builtin_amdgcn_global_load_lds((const unsigned*)((const char*)abase + (size_t)(t) * 64 + aoff[0]), (LAS unsigned*)(lds + sl_ + wave * 1024), 16, 0, 0); } while (0)
#define RG_WAIT(k) do { if (MT == 8) { if ((k) == 2) asm volatile("s_waitcnt vmcnt(8)" ::: "memory"); else if ((k) == 1) asm volatile("s_waitcnt vmcnt(4)" ::: "memory"); else asm volatile("s_waitcnt vmcnt(0)" ::: "memory"); } \
        else if (a_wave) { if ((k) == 2) asm volatile("s_waitcnt vmcnt(6)" ::: "memory"); else if ((k) == 1) asm volatile("s_waitcnt vmcnt(3)" ::: "memory"); else asm volatile("s_waitcnt vmcnt(0)" ::: "memory"); } \
        else { if ((k) == 2) asm volatile("s_waitcnt vmcnt(4)" ::: "memory"); else if ((k) == 1) asm volatile("s_waitcnt vmcnt(2)" ::: "memory"); else asm volatile("s_waitcnt vmcnt(0)" ::: "memory"); } } while (0)
    RG_STAGE(0);
    if (nst > 1) RG_STAGE(1);
    if (nst > 2) RG_STAGE(2);
#pragma unroll 1
    for (int t = 0; t < nst; ++t) {
        const int ahead = (nst - 1 - t) < 2 ? (nst - 1 - t) : 2;
        if (ahead == 2) RG_WAIT(2); else if (ahead == 1) RG_WAIT(1); else RG_WAIT(0);
        LGKM_BAR();
        __builtin_amdgcn_sched_barrier(0);
        {
            LAS const unsigned char* As = lds + (t & 3) * 32768 + wr * (MT * 1024);
            LAS const unsigned char* Bs = lds + (t & 3) * 32768 + 16384 + wc * 4096;
            bf16x8 bfr[4];
#pragma unroll
            for (int n = 0; n < 4; ++n) bfr[n] = *(LAS const bf16x8*)(Bs + n * 1024 + fo);
            constexpr int MH = MT > 4 ? 4 : MT;
#pragma unroll
            for (int m0 = 0; m0 < MT; m0 += MH) {
                bf16x8 af[MH];
#pragma unroll
                for (int m = 0; m < MH; ++m) af[m] = *(LAS const bf16x8*)(As + (m0 + m) * 1024 + fo);
#pragma unroll
                for (int m = 0; m < MH; ++m)
#pragma unroll
                    for (int n = 0; n < 4; ++n)
                        acc[m0 + m][n] = __builtin_amdgcn_mfma_f32_16x16x32_bf16(bfr[n], af[m], acc[m0 + m][n], 0, 0, 0);
                if (m0 == 0) {
                    __builtin_amdgcn_sched_barrier(0);
                    if (t + 3 < nst) RG_STAGE(t + 3);
                    __builtin_amdgcn_sched_barrier(0);
                }
            }
        }
        __builtin_amdgcn_sched_barrier(0);
    }
    LGKM_BAR();
#undef RG_STAGE
#undef RG_WAIT
}
__device__ __forceinline__ void ring_aoff(unsigned (&aoff)[2], int tid, int ld_elems) {
#pragma unroll
    for (int i = 0; i < 2; ++i) { const int p = tid + 512 * i, row = p >> 2, lc = (p & 3) ^ swz4(row); aoff[i] = (unsigned)(row * ld_elems + lc * 8) * 2u; }
}
template <int MT>
__device__ __forceinline__ void zero_accT(f32x4 (&acc)[MT][4]) {
#pragma unroll
    for (int m = 0; m < MT; ++m)
#pragma unroll
        for (int n = 0; n < 4; ++n) acc[m][n] = (f32x4){0.f, 0.f, 0.f, 0.f};
}
__device__ __forceinline__ void convert_block(const Frame& F, const float* colp, size_t ldb, int kt, bf16* blk) {
    f32x4 r[8];
    loadB32(r, colp + (size_t)(kt * 64 + 8 * F.wave) * ldb, ldb);
#pragma unroll
    for (int j = 0; j < 4; ++j) {
        u32x4 w; w.x = pk2(r[0][j], r[1][j]); w.y = pk2(r[2][j], r[3][j]); w.z = pk2(r[4][j], r[5][j]); w.w = pk2(r[6][j], r[7][j]);
        const int n = 4 * F.lane + j;
        *(u32x4*)((char*)blk + (F.wave >> 2) * 16384 + n * 64 + (((F.wave & 3) ^ swz4(n)) << 4)) = w;
    }
}
__device__ __forceinline__ void zero_acc(f32x4 (&acc)[4][4]) {
#pragma unroll
    for (int m = 0; m < 4; ++m)
#pragma unroll
        for (int n = 0; n < 4; ++n) acc[m][n] = (f32x4){0.f, 0.f, 0.f, 0.f};
}

__device__ __forceinline__ void phase0(const Frame& F, const float* x, const float* g, const float* b, const float* w_in, const float* w_out, const float* w_router) {
    const int gw = F.vcu * 8 + F.wave, NGW = F.G * 8;
    bf16* H0B = (bf16*)(F.ws + WS_H0B);
    f32x4 gv[4], bv[4];
#pragma unroll
    for (int c = 0; c < 4; ++c) { gv[c] = *(const f32x4*)(g + 4 * F.lane + 256 * c); bv[c] = *(const f32x4*)(b + 4 * F.lane + 256 * c); }
    for (int row = gw; row < T_TOK; row += NGW) {
        const float* xr = x + (size_t)row * DM + 4 * F.lane;
        f32x4 v[4]; float s = 0.f;
#pragma unroll
        for (int c = 0; c < 4; ++c) { v[c] = *(const f32x4*)(xr + 256 * c); s += (v[c].x + v[c].y) + (v[c].z + v[c].w); }
        const float mean = wave_sum(s) * (1.f / DM); float s2 = 0.f;
#pragma unroll
        for (int c = 0; c < 4; ++c) { v[c] = v[c] - mean; s2 += (v[c].x * v[c].x + v[c].y * v[c].y) + (v[c].z * v[c].z + v[c].w * v[c].w); }
        const float rstd = 1.f / sqrtf(wave_sum(s2) * (1.f / DM) + 1e-5f);
        bf16* orow = H0B + (size_t)row * DM + 4 * F.lane;
#pragma unroll
        for (int c = 0; c < 4; ++c) {
            const f32x4 y = v[c] * rstd * gv[c] + bv[c];
            u32x2 w; w.x = pk2(y.x, y.y); w.y = pk2(y.z, y.w);
            *(u32x2*)(orow + 256 * c) = w;
        }
    }
    {
        bf16* WIMG = (bf16*)(F.ws + WS_WIMG);
        for (int blk = F.vcu; blk < WIMG_N; blk += F.G) {
            const int s = 4 * F.lane;
            if (blk >= 128 && blk < WIMG_OUT) convert_block(F, w_in + (blk / 16) * 256 + s, INW, blk % 16, WIMG + (size_t)blk * 16384);
            else if (blk >= WIMG_RT) convert_block(F, w_router + s, NEXP, blk - WIMG_RT, WIMG + (size_t)blk * 16384);
        }
    }
    {
        bf16* WTI = (bf16*)(F.ws + WS_WT_IN); bf16* WTO = (bf16*)(F.ws + WS_WT_OUT);
        LAS float* scr = (LAS float*)(F.lds + F.wave * 8448);
        for (int it = gw; it < 1024 + 512; it += NGW) {
            const bool isin = it < 1024; const int r = isin ? it : it - 1024;
            const int nblk = isin ? 64 : 32, kb = r / nblk, nb = r % nblk, k0 = 64 * kb, n0 = 32 * nb, N = isin ? INW : DM;
            const float* W = isin ? w_in : w_out; bf16* WT = isin ? WTI : WTO;
#pragma unroll 8
            for (int i = 0; i < 32; ++i) { const int kk = 2 * i + (F.lane >> 5); scr[kk * 33 + (F.lane & 31)] = W[(size_t)(k0 + kk) * N + n0 + (F.lane & 31)]; }
            asm volatile("s_waitcnt lgkmcnt(0)" ::: "memory");
            const int c = F.lane & 7;
#pragma unroll
            for (int j = 0; j < 4; ++j) {
                const int n = (F.lane >> 3) + 8 * j; const LAS float* sp = scr + (8 * c) * 33 + n;
                u32x4 o; o.x = pk2(sp[0 * 33], sp[1 * 33]); o.y = pk2(sp[2 * 33], sp[3 * 33]); o.z = pk2(sp[4 * 33], sp[5 * 33]); o.w = pk2(sp[6 * 33], sp[7 * 33]);
                const int col = n0 + n;
                const int row = (isin && col < 512) ? ((col & ~48) | ((col & 16) << 1) | ((col & 32) >> 1)) : col;
                *(u32x4*)(WT + (size_t)row * DM + k0 + 8 * c) = o;
            }
            asm volatile("s_waitcnt lgkmcnt(0)" ::: "memory");
        }
    }
    float* COS = (float*)(F.ws + WS_COS); float* SIN = (float*)(F.ws + WS_SIN);
    for (int i = F.vcu * 512 + F.tid; i < SEQ * 32; i += F.G * 512) {
        const int pos = i >> 5, j = i & 31;
        const float inv = exp2f(-(float)j * (13.287712379549449f / 32.0f));
        const float ang = (float)pos * inv;
        double rev = (double)ang * 0.15915494309189535;
        rev -= __builtin_rint(rev);
        const float rv = (float)rev;
        COS[i] = __builtin_amdgcn_cosf(rv); SIN[i] = __builtin_amdgcn_sinf(rv);
    }
}

template <int MT>
__device__ __forceinline__ void p1_epilogue(f32x4 (&acc)[MT][4], const Frame& F, int row_base, int nt) {
    bf16* PROJ = (bf16*)(F.ws + WS_PROJ);
    const float* COS = (const float*)(F.ws + WS_COS); const float* SIN = (const float*)(F.ws + WS_SIN);
    const int lane = F.lane, wr = F.wave >> 2, wc = F.wave & 3, fr = lane & 15, fq = lane >> 4;
    const float scale = (nt == 1 || nt == 6 || nt == 7) ? 0.125f : 1.0f;
#pragma unroll
    for (int m = 0; m < MT; ++m) {
        const int row = row_base + wr * (16 * MT) + m * 16 + fr;
        if (nt < 2) {
            const int pos = row & (SEQ - 1);
#pragma unroll
            for (int n = 0; n < 2; ++n) {
                const f32x4 c = *(const f32x4*)(COS + pos * 32 + 16 * n + 4 * fq), s = *(const f32x4*)(SIN + pos * 32 + 16 * n + 4 * fq);
                const f32x4 x1 = acc[m][n], x2 = acc[m][n + 2];
                acc[m][n] = x1 * c - x2 * s; acc[m][n + 2] = x1 * s + x2 * c;
            }
        }
        bf16* orow = PROJ + (size_t)row * INW + nt * 256 + wc * 64 + 4 * fq;
#pragma unroll
        for (int n = 0; n < 4; ++n) {
            const f32x4 v = acc[m][n] * scale;
            u32x2 w; w.x = pk2(v.x, v.y); w.y = pk2(v.z, v.w);
            *(u32x2*)(orow + 16 * n) = w;
        }
        asm volatile("" ::: "memory");
    }
}
struct SchedP1 { int vcu, G; __device__ __forceinline__ bool next(int i, pg8::Unit& u) const { const int L = vcu + i * G; if (L >= 512) return false; u.pm = L >> 3; u.pn = L & 7; return true; } };
struct EpiP1 {
    bf16* PROJ; const float* COS; const float* SIN;
    __device__ __forceinline__ void operator()(const f32x4 (&acc)[2][2][4][2], const pg8::Unit& u, int wr, int wc, int fr, int fq) const {
        const float scale = (u.pn == 1 || u.pn == 6 || u.pn == 7) ? 0.125f : 1.0f;
#pragma unroll
        for (int ai = 0; ai < 2; ++ai)
#pragma unroll
            for (int m = 0; m < 4; ++m) {
                const int row = u.pm * 256 + ai * 128 + wr * 64 + m * 16 + fr;
                if (u.pn < 2) {
                    const int pos = row & (SEQ - 1), d0 = 16 * (wc & 1) + 4 * fq;
                    const f32x4 c = *(const f32x4*)(COS + pos * 32 + d0), s = *(const f32x4*)(SIN + pos * 32 + d0);
#pragma unroll
                    for (int bj = 0; bj < 2; ++bj) {
                        const f32x4 x1 = acc[ai][bj][m][0], x2 = acc[ai][bj][m][1];
                        const f32x4 o1 = (x1 * c - x2 * s) * scale, o2 = (x1 * s + x2 * c) * scale;
                        bf16* dst = PROJ + (size_t)row * INW + u.pn * 256 + bj * 128 + (wc >> 1) * 64 + d0;
                        u32x2 w1, w2; w1.x = pk2(o1.x, o1.y); w1.y = pk2(o1.z, o1.w); w2.x = pk2(o2.x, o2.y); w2.y = pk2(o2.z, o2.w);
                        *(u32x2*)dst = w1; *(u32x2*)(dst + 32) = w2;
                    }
                } else {
#pragma unroll
                    for (int bj = 0; bj < 2; ++bj)
#pragma unroll
                        for (int n = 0; n < 2; ++n) {
                            const f32x4 v = acc[ai][bj][m][n] * scale;
                            u32x2 w; w.x = pk2(v.x, v.y); w.y = pk2(v.z, v.w);
                            *(u32x2*)(PROJ + (size_t)row * INW + u.pn * 256 + bj * 128 + wc * 32 + 16 * n + 4 * fq) = w;
                        }
                }
                asm volatile("" ::: "memory");
            }
    }
};
__device__ __forceinline__ void phase1(const Frame& F) {
    const bf16* H0B = (const bf16*)(F.ws + WS_H0B);
    const bf16* WIMG = (const bf16*)(F.ws + WS_WIMG);
    {
        const pg8::Gemm g{H0B, (const bf16*)(F.ws + WS_WT_IN), DM};
        const SchedP1 S{F.vcu, F.G};
        const EpiP1 E{(bf16*)(F.ws + WS_PROJ), (const float*)(F.ws + WS_COS), (const float*)(F.ws + WS_SIN)};
        pg8::gemm_phase<EpiP1, SchedP1>(F.lds, g, S, E);
    }
    unsigned aoff[2]; ring_aoff(aoff, F.tid, DM);
    for (int mt = F.vcu; mt < 256; mt += F.G) {
        f32x4 acc[2][4]; zero_accT<2>(acc);
        gemm_ring<2>(acc, F, H0B + (size_t)mt * 64 * DM, aoff, WIMG + (size_t)(WIMG_IN + 8 * 16) * 16384, DM / 32);
        p1_epilogue<2>(acc, F, mt * 64, 8);
    }
}

__device__ __forceinline__ bf16x8 tr_frag(LAS const unsigned char* a0, LAS const unsigned char* a1) {
    const s16x4 lo = __builtin_amdgcn_ds_read_tr16_b64_v4i16((LAS s16x4*)a0);
    const s16x4 hi = __builtin_amdgcn_ds_read_tr16_b64_v4i16((LAS s16x4*)a1);
    bf16x8 r; r[0] = lo[0]; r[1] = lo[1]; r[2] = lo[2]; r[3] = lo[3]; r[4] = hi[0]; r[5] = hi[1]; r[6] = hi[2]; r[7] = hi[3];
    return r;
}
__device__ __forceinline__ int tr128_off(int row, int col) { return row * 128 + 32 * ((col >> 4) ^ ((row >> 1) & 3)) + 2 * (col & 15); }
__device__ __forceinline__ int tr256_off(int row, int col) { return row * 256 + 32 * ((col >> 4) ^ (row & 7)) + 2 * (col & 15); }
__device__ __forceinline__ bf16x8 pack_p(const f32x4& a, const f32x4& b) {
    u32x4 w; w.x = pk2(a.x, a.y); w.y = pk2(a.z, a.w); w.z = pk2(b.x, b.y); w.w = pk2(b.z, b.w);
    return __builtin_bit_cast(bf16x8, w);
}

__device__ __forceinline__ int t5_bucket(int n) {
    if (n < 16) return n;
    const float ratio = logf((float)n / 16.0f) / 2.0794415416798357f;
    int large = 16 + (int)(ratio * 16.0f);
    return large < 31 ? large : 31;
}
__device__ __forceinline__ void swa_unit(const Frame& F, int su, const float* rel_bias, const float* sinks) {
    LAS unsigned char* lds = F.lds;
    const bf16* PROJ = (const bf16*)(F.ws + WS_PROJ);
    bf16* MIXIN = (bf16*)(F.ws + WS_MIXIN);
    const int tid = F.tid, lane = F.lane, wave = F.wave, fr = lane & 15, fq = lane >> 4;
    const int b = su >> 7, nb = (su >> 1) & 63, kvh = su & 1;
    const int tok_prev = b * SEQ + (nb > 0 ? nb - 1 : 0) * 128, tok_cur = b * SEQ + nb * 128;
    constexpr int L_K = 0, L_V = 32768, L_BT = 65536;
#pragma unroll
    for (int i = 0; i < 4; ++i) {
        const int p = tid + 512 * i, row = p >> 3, pc = p & 7;
        const int tok = (row < 128 ? tok_prev + row : tok_cur + row - 128);
        const bf16* src = PROJ + (size_t)tok * INW;
        const int lck = pc ^ (row & 7);
        __builtin_amdgcn_global_load_lds((const unsigned*)(src + 2048 + kvh * 64 + lck * 8), (LAS unsigned*)(lds + L_K + wave * 1024 + i * 8192), 16, 0, 0);
        const int vcol = 16 * ((pc >> 1) ^ ((row >> 1) & 3)) + 8 * (pc & 1);
        __builtin_amdgcn_global_load_lds((const unsigned*)(src + 2176 + kvh * 64 + vcol), (LAS unsigned*)(lds + L_V + wave * 1024 + i * 8192), 16, 0, 0);
    }
    {
        const int g = tid >> 7, dist = tid & 127;
        ((LAS float*)(lds + L_BT))[tid] = rel_bias[t5_bucket(dist) * 8 + kvh * 4 + g];
    }
    BLOCK_SYNC();
#pragma unroll 1
    for (int task = wave; task < 32; task += 8) {
        const int g = task >> 3, a = task & 7, nj0 = a & ~1, head = kvh * 4 + g;
        const float sink = sinks[head];
        LAS const float* bt = (LAS const float*)(lds + L_BT) + g * 128;
        const int i = a * 16 + fr;
        bf16x8 qf[2];
#pragma unroll
        for (int kk = 0; kk < 2; ++kk)
            qf[kk] = *(const bf16x8*)(PROJ + (size_t)(tok_cur + i) * INW + 1536 + head * 64 + kk * 32 + fq * 8);
        f32x4 s[10];
#pragma unroll
        for (int nl = 0; nl < 10; ++nl) {
            s[nl] = (f32x4){0.f, 0.f, 0.f, 0.f};
            const int krow = 16 * (nj0 + nl) + fr;
#pragma unroll
            for (int kk = 0; kk < 2; ++kk) {
                const bf16x8 kf = *(LAS const bf16x8*)(lds + L_K + krow * 128 + (((kk * 4 + fq) ^ (fr & 7)) << 4));
                s[nl] = __builtin_amdgcn_mfma_f32_16x16x32_bf16(kf, qf[kk], s[nl], 0, 0, 0);
            }
        }
        float m = sink;
#pragma unroll
        for (int nl = 0; nl < 10; ++nl)
#pragma unroll
            for (int j = 0; j < 4; ++j) {
                const int jp = 16 * (nj0 + nl) + 4 * fq + j;
                const int dist = i + 128 - jp;
                const bool ok = (dist >= 0) && (dist < 128) && (nb > 0 || jp >= 128);
                const float v = ok ? s[nl][j] + bt[dist & 127] : -INFINITY;
                s[nl][j] = v; m = fmaxf(m, v);
            }
        m = fmaxf(m, __shfl_xor(m, 16)); m = fmaxf(m, __shfl_xor(m, 32));
        float d = 0.f;
#pragma unroll
        for (int nl = 0; nl < 10; ++nl)
#pragma unroll
            for (int j = 0; j < 4; ++j) { const float p = __expf(s[nl][j] - m); s[nl][j] = p; d += p; }
        d += __shfl_xor(d, 16); d += __shfl_xor(d, 32);
        const float inv = 1.0f / (d + __expf(sink - m));
        f32x4 o[4];
#pragma unroll
        for (int ne = 0; ne < 4; ++ne) o[ne] = (f32x4){0.f, 0.f, 0.f, 0.f};
#pragma unroll
        for (int ks = 0; ks < 5; ++ks) {
            const bf16x8 pf = pack_p(s[2 * ks], s[2 * ks + 1]);
            const int r0 = 16 * (nj0 + 2 * ks) + 4 * fq + (fr >> 2);
#pragma unroll
            for (int ne = 0; ne < 4; ++ne) {
                const bf16x8 vf = tr_frag(lds + L_V + tr128_off(r0, 16 * ne) + 8 * (fr & 3), lds + L_V + tr128_off(r0 + 16, 16 * ne) + 8 * (fr & 3));
                o[ne] = __builtin_amdgcn_mfma_f32_16x16x32_bf16(vf, pf, o[ne], 0, 0, 0);
            }
        }
        bf16* orow = MIXIN + (size_t)(tok_cur + i) * DM + 512 + head * 64 + 4 * fq;
#pragma unroll
        for (int ne = 0; ne < 4; ++ne) {
            const f32x4 v = o[ne] * inv;
            u32x2 w; w.x = pk2(v.x, v.y); w.y = pk2(v.z, v.w);
            *(u32x2*)(orow + 16 * ne) = w;
        }
    }
    BLOCK_SYNC();
}

__device__ __forceinline__ float ret_log2gamma(int h) { return log2f(1.0f - exp2f(-5.0f - (float)h)); }
__device__ __forceinline__ void stage_v256(const Frame& F, const bf16* PROJ, int tok0, int h, int L_V) {
#pragma unroll
    for (int i = 0; i < 4; ++i) {
        const int p = F.tid + 512 * i, row = p >> 4, pc = p & 15;
        const int col = 16 * ((pc >> 1) ^ (row & 7)) + 8 * (pc & 1);
        __builtin_amdgcn_global_load_lds((const unsigned*)(PROJ + (size_t)(tok0 + row) * INW + 512 + h * 128 + col), (LAS unsigned*)(F.lds + L_V + F.wave * 1024 + i * 8192), 16, 0, 0);
    }
}
__device__ __forceinline__ void kv_unit(const Frame& F, int ku) {
    LAS unsigned char* lds = F.lds;
    const bf16* PROJ = (const bf16*)(F.ws + WS_PROJ);
    float* KVT = (float*)(F.ws + WS_KVT);
    const int tid = F.tid, lane = F.lane, wave = F.wave, fr = lane & 15, fq = lane >> 4;
    const int b = ku >> 8, n = (ku >> 2) & 63, h = ku & 3;
    const int tok0 = b * SEQ + n * 128;
    constexpr int L_K = 0, L_V = 16384;
    const float l2g = ret_log2gamma(h);
    stage_v256(F, PROJ, tok0, h, L_V);
#pragma unroll
    for (int i = 0; i < 2; ++i) {
        const int p = tid + 512 * i, row = p >> 3, pc = p & 7;
        const int col = 16 * ((pc >> 1) ^ ((row >> 1) & 3)) + 8 * (pc & 1);
        const u32x4 kv = *(const u32x4*)(PROJ + (size_t)(tok0 + row) * INW + 256 + h * 64 + col);
        const float z = exp2f((float)(127 - row) * l2g);
        u32x4 w;
        w.x = pk2(bflo(kv.x) * z, bfhi(kv.x) * z); w.y = pk2(bflo(kv.y) * z, bfhi(kv.y) * z);
        w.z = pk2(bflo(kv.z) * z, bfhi(kv.z) * z); w.w = pk2(bflo(kv.w) * z, bfhi(kv.w) * z);
        *(LAS u32x4*)(lds + L_K + p * 16) = w;
    }
    BLOCK_SYNC();
    const int ne = wave;
    f32x4 acc[4];
#pragma unroll
    for (int nd = 0; nd < 4; ++nd) acc[nd] = (f32x4){0.f, 0.f, 0.f, 0.f};
#pragma unroll
    for (int ks = 0; ks < 4; ++ks) {
        const int r0 = 32 * ks + 4 * fq + (fr >> 2);
        const bf16x8 vf = tr_frag(lds + L_V + tr256_off(r0, 16 * ne) + 8 * (fr & 3), lds + L_V + tr256_off(r0 + 16, 16 * ne) + 8 * (fr & 3));
#pragma unroll
        for (int nd = 0; nd < 4; ++nd) {
            const bf16x8 kf = tr_frag(lds + L_K + tr128_off(r0, 16 * nd) + 8 * (fr & 3), lds + L_K + tr128_off(r0 + 16, 16 * nd) + 8 * (fr & 3));
            acc[nd] = __builtin_amdgcn_mfma_f32_16x16x32_bf16(kf, vf, acc[nd], 0, 0, 0);
        }
    }
    float* dst = KVT + (size_t)ku * 8192 + (16 * ne + fr) * 64 + 4 * fq;
#pragma unroll
    for (int nd = 0; nd < 4; ++nd) *(f32x4*)(dst + 16 * nd) = acc[nd];
    BLOCK_SYNC();
}

__device__ __forceinline__ void phase_scan(const Frame& F) {
    const float* KVT = (const float*)(F.ws + WS_KVT);
    bf16* ST = (bf16*)(F.ws + WS_STATE);
    for (int gid = F.vcu * 512 + F.tid; gid < 65536; gid += F.G * 512) {
        const int b = gid >> 15, h = (gid >> 13) & 3, ed = gid & 8191;
        const float cd = exp2f(128.0f * ret_log2gamma(h));
        float s = 0.f;
        const size_t base = (size_t)b * 64 * 4 * 8192 + (size_t)h * 8192 + ed;
#pragma unroll 8
        for (int n = 0; n < 64; ++n) {
            const size_t idx = base + (size_t)n * 4 * 8192;
            const float kv = KVT[idx];
            ST[idx] = (bf16)(pk2(s, 0.f) & 0xffffu);
            s = s * cd + kv;
        }
    }
}

__device__ __forceinline__ void ret_unit(const Frame& F, int ku) {
    LAS unsigned char* lds = F.lds;
    const bf16* PROJ = (const bf16*)(F.ws + WS_PROJ);
    const bf16* ST = (const bf16*)(F.ws + WS_STATE);
    bf16* MIXIN = (bf16*)(F.ws + WS_MIXIN);
    const int tid = F.tid, lane = F.lane, w = F.wave, fr = lane & 15, fq = lane >> 4;
    const int b = ku >> 8, n = (ku >> 2) & 63, h = ku & 3;
    const int tok0 = b * SEQ + n * 128;
    constexpr int L_K = 0, L_V = 16384;
    const float l2g = ret_log2gamma(h);
    stage_v256(F, PROJ, tok0, h, L_V);
#pragma unroll
    for (int i = 0; i < 2; ++i) {
        const int p = tid + 512 * i, row = p >> 3, pc = p & 7;
        const int lck = pc ^ (row & 7);
        __builtin_amdgcn_global_load_lds((const unsigned*)(PROJ + (size_t)(tok0 + row) * INW + 256 + h * 64 + lck * 8), (LAS unsigned*)(lds + L_K + w * 1024 + i * 8192), 16, 0, 0);
    }
    const int i_row = 16 * w + fr;
    const size_t tok = (size_t)tok0 + i_row;
    bf16x8 qf[2];
#pragma unroll
    for (int kk = 0; kk < 2; ++kk) qf[kk] = *(const bf16x8*)(PROJ + tok * INW + h * 64 + kk * 32 + fq * 8);
    f32x4 o[8];
#pragma unroll
    for (int ne = 0; ne < 8; ++ne) o[ne] = (f32x4){0.f, 0.f, 0.f, 0.f};
    const bf16* stb = ST + (size_t)ku * 8192;
#pragma unroll
    for (int ne = 0; ne < 8; ++ne)
#pragma unroll
        for (int kk = 0; kk < 2; ++kk) {
            const bf16x8 sf = *(const bf16x8*)(stb + (16 * ne + fr) * 64 + kk * 32 + fq * 8);
            o[ne] = __builtin_amdgcn_mfma_f32_16x16x32_bf16(sf, qf[kk], o[ne], 0, 0, 0);
        }
    const float xi = exp2f((float)(i_row + 1) * l2g);
#pragma unroll
    for (int ne = 0; ne < 8; ++ne) o[ne] = o[ne] * xi;
    BLOCK_SYNC();
    f32x4 s[8];
#pragma unroll
    for (int nj = 0; nj < 8; ++nj) {
        s[nj] = (f32x4){0.f, 0.f, 0.f, 0.f};
        if (nj <= w) {
#pragma unroll
            for (int kk = 0; kk < 2; ++kk) {
                const bf16x8 kf = *(LAS const bf16x8*)(lds + L_K + (16 * nj + fr) * 128 + (((kk * 4 + fq) ^ (fr & 7)) << 4));
                s[nj] = __builtin_amdgcn_mfma_f32_16x16x32_bf16(kf, qf[kk], s[nj], 0, 0, 0);
            }
#pragma unroll
            for (int j = 0; j < 4; ++j) {
                const int jj = 16 * nj + 4 * fq + j;
                const int diff = i_row - jj;
                s[nj][j] = diff >= 0 ? s[nj][j] * exp2f((float)diff * l2g) : 0.f;
            }
        }
    }
#pragma unroll
    for (int ks = 0; ks < 4; ++ks) {
        if (2 * ks <= w) {
            const bf16x8 pf = pack_p(s[2 * ks], s[2 * ks + 1]);
            const int r0 = 32 * ks + 4 * fq + (fr >> 2);
#pragma unroll
            for (int ne = 0; ne < 8; ++ne) {
                const bf16x8 vf = tr_frag(lds + L_V + tr256_off(r0, 16 * ne) + 8 * (fr & 3), lds + L_V + tr256_off(r0 + 16, 16 * ne) + 8 * (fr & 3));
                o[ne] = __builtin_amdgcn_mfma_f32_16x16x32_bf16(vf, pf, o[ne], 0, 0, 0);
            }
        }
    }
    float sm = 0.f;
#pragma unroll
    for (int ne = 0; ne < 8; ++ne) sm += (o[ne].x + o[ne].y) + (o[ne].z + o[ne].w);
    sm += __shfl_xor(sm, 16); sm += __shfl_xor(sm, 32);
    const float mean = sm * (1.f / 128.f);
    float sq = 0.f;
#pragma unroll
    for (int ne = 0; ne < 8; ++ne) { o[ne] = o[ne] - mean; sq += (o[ne].x * o[ne].x + o[ne].y * o[ne].y) + (o[ne].z * o[ne].z + o[ne].w * o[ne].w); }
    sq += __shfl_xor(sq, 16); sq += __shfl_xor(sq, 32);
    const float rstd = 1.0f / sqrtf(sq * (1.f / 128.f) + 1e-6f);
    const bf16* grow = PROJ + tok * INW + 1024 + h * 128 + 4 * fq;
    bf16* orow = MIXIN + tok * DM + h * 128 + 4 * fq;
#pragma unroll
    for (int ne = 0; ne < 8; ++ne) {
        const u32x2 gg = *(const u32x2*)(grow + 16 * ne);
        const float g0 = bflo(gg.x), g1 = bfhi(gg.x), g2 = bflo(gg.y), g3 = bfhi(gg.y);
        const f32x4 v = o[ne] * rstd;
        const float y0 = v.x * g0 / (1.f + __expf(-g0)), y1 = v.y * g1 / (1.f + __expf(-g1)), y2 = v.z * g2 / (1.f + __expf(-g2)), y3 = v.w * g3 / (1.f + __expf(-g3));
        u32x2 wv; wv.x = pk2(y0, y1); wv.y = pk2(y2, y3);
        *(u32x2*)(orow + 16 * ne) = wv;
    }
    BLOCK_SYNC();
}

struct SchedP5 { int vcu, G; __device__ __forceinline__ bool next(int i, pg8::Unit& u) const { const int L = vcu + i * G; if (L >= 256) return false; u.pm = L >> 2; u.pn = L & 3; return true; } };
struct EpiP5 {
    const bf16* H0B; bf16* PRE1;
    __device__ __forceinline__ void operator()(const f32x4 (&acc)[2][2][4][2], const pg8::Unit& u, int wr, int wc, int fr, int fq) const {
#pragma unroll
        for (int ai = 0; ai < 2; ++ai)
#pragma unroll
            for (int m = 0; m < 4; ++m) {
                const size_t row = (size_t)(u.pm * 256 + ai * 128 + wr * 64 + m * 16 + fr);
#pragma unroll
                for (int bj = 0; bj < 2; ++bj)
#pragma unroll
                    for (int n = 0; n < 2; ++n) {
                        const size_t off = row * DM + u.pn * 256 + bj * 128 + wc * 32 + 16 * n + 4 * fq;
                        const u32x2 hh = *(const u32x2*)(H0B + off);
                        f32x4 v = acc[ai][bj][m][n];
                        v.x += ALPHA * bflo(hh.x); v.y += ALPHA * bfhi(hh.x); v.z += ALPHA * bflo(hh.y); v.w += ALPHA * bfhi(hh.y);
                        u32x2 pw; pw.x = pk2(v.x, v.y); pw.y = pk2(v.z, v.w);
                        *(u32x2*)(PRE1 + off) = pw;
                    }
                asm volatile("" ::: "memory");
            }
    }
};
__device__ __forceinline__ void phase_outproj(const Frame& F) {
    const pg8::Gemm g{(const bf16*)(F.ws + WS_MIXIN), (const bf16*)(F.ws + WS_WT_OUT), DM};
    const SchedP5 S{F.vcu, F.G};
    const EpiP5 E{(const bf16*)(F.ws + WS_H0B), (bf16*)(F.ws + WS_PRE1)};
    pg8::gemm_phase<EpiP5, SchedP5>(F.lds, g, S, E);
}

__device__ __forceinline__ unsigned fkey(float f) { const unsigned u = __float_as_uint(f); return u ^ ((u >> 31) ? 0xffffffffu : 0x80000000u); }
__device__ __forceinline__ int lanes_below(unsigned long long m) { return (int)__builtin_amdgcn_mbcnt_hi((unsigned)(m >> 32), __builtin_amdgcn_mbcnt_lo((unsigned)m, 0u)); }
__device__ __forceinline__ void phase_router(const Frame& F, const float* g, const float* bb, const float* w_router, const float* rbias) {
    LAS unsigned char* lds = F.lds;
    const bf16* PRE1 = (const bf16*)(F.ws + WS_PRE1);
    bf16* H1B = (bf16*)(F.ws + WS_H1B);
    unsigned* gcnt = (unsigned*)(F.ws + WS_CTL) + CW_CNT;
    u32x2* LIST2 = (u32x2*)(F.ws + WS_LIST2);
    const int tid = F.tid, lane = F.lane, wave = F.wave, wr = wave >> 2, wc = wave & 3, fr = lane & 15, fq = lane >> 4;
    LAS float* selw = (LAS float*)(lds + L_TAB + TB_SELW);
    LAS int* hist = (LAS int*)(lds + L_TAB + TB_HIST);
    LAS int* basee = (LAS int*)(lds + L_TAB + TB_BASE);
    LAS int* sel = (LAS int*)(lds + L_TAB + TB_SEL);
    for (int mt = F.vcu; mt < 256; mt += F.G) {
        const int row0 = mt * 64;
        asm volatile("" ::: "memory");
        {
            f32x4 gv[4], bv[4];
#pragma unroll
            for (int c = 0; c < 4; ++c) { gv[c] = *(const f32x4*)(g + 4 * lane + 256 * c); bv[c] = *(const f32x4*)(bb + 4 * lane + 256 * c); }
#pragma unroll 1
            for (int batch = 0; batch < 2; ++batch) {
                f32x4 v[4][4];
#pragma unroll
                for (int r = 0; r < 4; ++r)
#pragma unroll
                    for (int c = 0; c < 4; ++c) { const u32x2 pw = *(const u32x2*)(PRE1 + (size_t)(row0 + wave * 8 + batch * 4 + r) * DM + 4 * lane + 256 * c); v[r][c] = (f32x4){bflo(pw.x), bfhi(pw.x), bflo(pw.y), bfhi(pw.y)}; }
#pragma unroll
                for (int r = 0; r < 4; ++r) {
                    float s = 0.f;
#pragma unroll
                    for (int c = 0; c < 4; ++c) s += (v[r][c].x + v[r][c].y) + (v[r][c].z + v[r][c].w);
                    const float mean = wave_sum(s) * (1.f / DM); float s2 = 0.f;
#pragma unroll
                    for (int c = 0; c < 4; ++c) { v[r][c] = v[r][c] - mean; s2 += (v[r][c].x * v[r][c].x + v[r][c].y * v[r][c].y) + (v[r][c].z * v[r][c].z + v[r][c].w * v[r][c].w); }
                    const float rstd = 1.f / sqrtf(wave_sum(s2) * (1.f / DM) + 1e-5f);
                    bf16* orow = H1B + (size_t)(row0 + wave * 8 + batch * 4 + r) * DM + 4 * lane;
#pragma unroll
                    for (int c = 0; c < 4; ++c) {
                        const f32x4 y = v[r][c] * rstd * gv[c] + bv[c];
                        u32x2 wv; wv.x = pk2(y.x, y.y); wv.y = pk2(y.z, y.w);
                        *(u32x2*)(orow + 256 * c) = wv;
                    }
                }
            }
        }
        if (tid < 256) hist[tid] = 0;
        BLOCK_SYNC();
        asm volatile("" ::: "memory");
        unsigned aoff[2]; ring_aoff(aoff, tid, DM);
        f32x4 acc[2][4]; zero_accT<2>(acc);
        gemm_ring<2>(acc, F, H1B + (size_t)row0 * DM, aoff, (const bf16*)(F.ws + WS_WIMG) + (size_t)WIMG_RT * 16384, DM / 32);
        LAS float* sc = (LAS float*)lds;
#pragma unroll
        for (int m = 0; m < 2; ++m) {
            const int row = wr * 32 + m * 16 + fr;
#pragma unroll
            for (int n = 0; n < 4; ++n) {
                f32x4 v = acc[m][n];
                v.x = 1.f / (1.f + __expf(-v.x)); v.y = 1.f / (1.f + __expf(-v.y)); v.z = 1.f / (1.f + __expf(-v.z)); v.w = 1.f / (1.f + __expf(-v.w));
                *(LAS f32x4*)(sc + row * 260 + wc * 64 + n * 16 + 4 * fq) = v;
            }
        }
        BLOCK_SYNC();
        asm volatile("" ::: "memory");
        const f32x4 rb = *(const f32x4*)(rbias + 4 * lane);
        const int grp = lane >> 3;
#pragma unroll 1
        for (int r = 0; r < 8; ++r) {
            const int rl = wave * 8 + r;
            const f32x4 v = *(LAS const f32x4*)(sc + rl * 260 + 4 * lane);
            const f32x4 ch = v + rb;
            float a1 = fmaxf(ch.x, ch.y), a2 = fminf(ch.x, ch.y);
            { const float b1 = fmaxf(ch.z, ch.w), b2 = fminf(ch.z, ch.w); const float n1 = fmaxf(a1, b1), n2 = fmaxf(fminf(a1, b1), fmaxf(a2, b2)); a1 = n1; a2 = n2; }
#pragma unroll
            for (int o = 1; o < 8; o <<= 1) {
                const float b1 = __shfl_xor(a1, o), b2 = __shfl_xor(a2, o);
                const float n1 = fmaxf(a1, b1), n2 = fmaxf(fminf(a1, b1), fmaxf(a2, b2));
                a1 = n1; a2 = n2;
            }
            const float gsum = a1 + a2;
            int rank = 0;
#pragma unroll
            for (int j = 0; j < 8; ++j) { const float sj = __shfl(gsum, 8 * j); rank += (sj > gsum || (sj == gsum && j < grp)) ? 1 : 0; }
            const bool gsel = rank < 4;
            unsigned key[4];
            key[0] = gsel ? fkey(ch.x) : 0u; key[1] = gsel ? fkey(ch.y) : 0u; key[2] = gsel ? fkey(ch.z) : 0u; key[3] = gsel ? fkey(ch.w) : 0u;
            unsigned tau = 0u;
#pragma unroll 1
            for (int bit = 31; bit >= 0; --bit) {
                const unsigned cand = tau | (1u << bit);
                const int cnt = __popcll(__ballot(key[0] >= cand)) + __popcll(__ballot(key[1] >= cand)) + __popcll(__ballot(key[2] >= cand)) + __popcll(__ballot(key[3] >= cand));
                if (cnt >= 8) tau = cand;
            }
            unsigned long long gm[4], em[4];
            int ngt = 0;
#pragma unroll
            for (int j = 0; j < 4; ++j) { gm[j] = __ballot(key[j] > tau); em[j] = __ballot(key[j] == tau); ngt += __popcll(gm[j]); }
            const int need = 8 - ngt;
            int eqb = lanes_below(em[0]) + lanes_below(em[1]) + lanes_below(em[2]) + lanes_below(em[3]);
            bool s[4];
#pragma unroll
            for (int j = 0; j < 4; ++j) { const bool eq = key[j] == tau; s[j] = (key[j] > tau) || (eq && eqb < need); eqb += eq ? 1 : 0; }
            unsigned long long sm[4];
#pragma unroll
            for (int j = 0; j < 4; ++j) sm[j] = __ballot(s[j]);
            int kpos = lanes_below(sm[0]) + lanes_below(sm[1]) + lanes_below(sm[2]) + lanes_below(sm[3]);
            const float wl = (s[0] ? v.x : 0.f) + (s[1] ? v.y : 0.f) + (s[2] ? v.z : 0.f) + (s[3] ? v.w : 0.f);
            const float wscale = 2.5f / wave_sum(wl);
#pragma unroll
            for (int j = 0; j < 4; ++j) {
                if (s[j]) {
                    selw[rl * 8 + kpos] = v[j] * wscale;
                    const int e = 4 * lane + j;
                    const int lpos = __hip_atomic_fetch_add(hist + e, 1, __ATOMIC_RELAXED, __HIP_MEMORY_SCOPE_WORKGROUP);
                    sel[rl * 8 + kpos] = (e << 16) | lpos;
                    ++kpos;
                }
            }
        }
        BLOCK_SYNC();
        if (tid < 256) { const int c = hist[tid]; basee[tid] = c > 0 ? (int)__hip_atomic_fetch_add(gcnt + tid, (unsigned)c, __ATOMIC_RELAXED, __HIP_MEMORY_SCOPE_AGENT) : 0; }
        BLOCK_SYNC();
        {
            const int sv = sel[tid], e = sv >> 16, lpos = sv & 0xffff;
            u32x2 ent; ent.x = (unsigned)(mt * 512 + tid); ent.y = __float_as_uint(selw[tid]);
            LIST2[(size_t)e * LCAP + basee[e] + lpos] = ent;
        }
        BLOCK_SYNC();
    }
}

__device__ __forceinline__ void phase_moe(const Frame& F, const float* w_gate, const float* w_up, const float* w_down, const float* ws_gate, const float* ws_up, const float* ws_down) {
    LAS unsigned char* lds = F.lds;
    const bf16* H1B = (const bf16*)(F.ws + WS_H1B);
    const unsigned* gcnt = (const unsigned*)(F.ws + WS_CTL) + CW_CNT;
    const u32x2* LIST2 = (const u32x2*)(F.ws + WS_LIST2);
    bf16* YROWS = (bf16*)(F.ws + WS_YROWS);
    const int tid = F.tid, lane = F.lane, wave = F.wave, wr = wave >> 2, wc = wave & 3, fr = lane & 15, fq = lane >> 4;
    const int lchunk = (tid & 7) ^ ((tid >> 3) & 7);
    LAS int* prefix = (LAS int*)(lds + L_TAB + TB_PREFIX);
    LAS int* rtok = (LAS int*)(lds + L_TAB + TB_RTOK);
    LAS int* ryrow = (LAS int*)(lds + L_TAB + TB_RYROW);
    LAS float* rw = (LAS float*)(lds + L_TAB + TB_RW);
    LAS int* cntl = (LAS int*)(lds + L_TAB + TB_CNT);
    if (tid < 256) cntl[tid] = (int)gcnt[tid];
    if (wave == 0) {
        int c4[4], loc = 0;
#pragma unroll
        for (int j = 0; j < 4; ++j) { c4[j] = ((int)gcnt[lane * 4 + j] + 127) >> 7; loc += c4[j]; }
        int incl = loc;
#pragma unroll
        for (int o = 1; o < 64; o <<= 1) { const int t = __shfl_up(incl, o); if (lane >= o) incl += t; }
        int run = incl - loc;
#pragma unroll
        for (int j = 0; j < 4; ++j) { prefix[lane * 4 + j] = run; run += c4[j]; }
        if (lane == 63) prefix[256] = run;
    }
    BLOCK_SYNC();
    const int R = prefix[256];
    const int nr = (R > F.vcu) ? (R - F.vcu + F.G - 1) / F.G : 0;
    const int base = R % F.G, L = F.G - base;
    const bool lightonly = L >= 64;
    const int sd = (F.vcu - base + F.G) % F.G;
    const int ns = lightonly ? ((sd < L && sd < 128) ? (128 - sd + L - 1) / L : 0) : ((sd < 128) ? 1 : 0);
    const int sstep = lightonly ? L : F.G;
#define MOE_ITEM(it_, e_, tile_) do { if ((it_) >= nr) { e_ = 256; tile_ = sd + ((it_) - nr) * sstep; } else { const int u_ = F.vcu + (it_) * F.G; int lo_ = 0, hi_ = 255; \
        while (lo_ < hi_) { const int mid_ = (lo_ + hi_ + 1) >> 1; if (prefix[mid_] <= u_) lo_ = mid_; else hi_ = mid_ - 1; } e_ = lo_; tile_ = u_ - prefix[lo_]; } } while (0)
#define MOE_FETCH(e_, tile_, tok_, yr_, wv_) do { tok_ = 0; yr_ = -1; wv_ = 0.f; const int ft_ = F.wave * 64 + fresh_lane(); if (ft_ < 128) { const int idx_ = (tile_) * 128 + ft_; \
        if ((e_) == 256) { tok_ = idx_; yr_ = idx_ * 9 + 8; wv_ = 1.0f; } \
        else if (idx_ < cntl[e_]) { const u32x2 en_ = LIST2[(size_t)(e_) * LCAP + idx_]; tok_ = (int)(en_.x >> 3); yr_ = tok_ * 9 + (int)(en_.x & 7u); wv_ = __uint_as_float(en_.y); } } } while (0)
    int ptok = 0, pyr = -1; float pwv = 0.f;
    if (nr + ns > 0) { int e0, t0; MOE_ITEM(0, e0, t0); MOE_FETCH(e0, t0, ptok, pyr, pwv); }
    for (int it = 0; it < nr + ns; ++it) {
        int e, tile;
        MOE_ITEM(it, e, tile);
        const int otid = F.wave * 64 + fresh_lane();
        Frame F2 = F; F2.tid = otid; F2.lane = otid & 63;
        const int lane = F2.lane, fr = lane & 15, fq = lane >> 4;
        const int lchunk = (otid & 7) ^ ((otid >> 3) & 7);
        if (otid < 128) { rtok[otid] = ptok; ryrow[otid] = pyr; rw[otid] = pwv; }
        BLOCK_SYNC();
        const float* Wg = (e == 256) ? ws_gate : w_gate + (size_t)e * 262144;
        const float* Wu = (e == 256) ? ws_up : w_up + (size_t)e * 262144;
        const float* Wd = (e == 256) ? ws_down : w_down + (size_t)e * 262144;
        const unsigned ao0 = (unsigned)rtok[otid >> 3] * (unsigned)(DM * 2) + (unsigned)lchunk * 16u, ao1 = (unsigned)rtok[(otid >> 3) + 64] * (unsigned)(DM * 2) + (unsigned)lchunk * 16u;
        const int rot = tile & 3;
#define MOE_EPI1(C0) do { const int ol_ = fresh_lane(); const int efr = ol_ & 15, efq = ol_ >> 4; \
            _Pragma("unroll") for (int m = 0; m < 4; ++m) { const int row = wr * 64 + m * 16 + efr; \
                _Pragma("unroll") for (int n = 0; n < 2; ++n) { const f32x4 gt = acc[m][n], up = acc[m][n + 2]; \
                    const float a0 = gt.x / (1.f + __expf(-gt.x)) * up.x, a1 = gt.y / (1.f + __expf(-gt.y)) * up.y, a2 = gt.z / (1.f + __expf(-gt.z)) * up.z, a3 = gt.w / (1.f + __expf(-gt.w)) * up.w; \
                    const int col = (C0) + 32 * wc + 16 * n + 4 * efq, kt = col >> 6, c64 = col & 63; \
                    u32x2 wv; wv.x = pk2(a0, a1); wv.y = pk2(a2, a3); \
                    *(LAS u32x2*)(lds + a_tile_off<true>(kt) + row * 128 + (((c64 >> 3) ^ (row & 7)) << 4) + (c64 & 7) * 2) = wv; } } } while (0)
#define MOE_EPI2(NC) do { const int ol_ = fresh_lane(); const int efr = ol_ & 15, efq = ol_ >> 4; \
            _Pragma("unroll") for (int m = 0; m < 4; ++m) { const int row = wr * 64 + m * 16 + efr; const int yr = ryrow[row]; const float wv = rw[row]; \
                if (yr >= 0) { bf16* dst = YROWS + (size_t)yr * DM + (NC) * 256 + wc * 64 + 16 * efq; u32x4 w0, w1; \
                    w0.x = pk2(acc[m][0].x * wv, acc[m][0].y * wv); w0.y = pk2(acc[m][0].z * wv, acc[m][0].w * wv); \
                    w0.z = pk2(acc[m][1].x * wv, acc[m][1].y * wv); w0.w = pk2(acc[m][1].z * wv, acc[m][1].w * wv); \
                    w1.x = pk2(acc[m][2].x * wv, acc[m][2].y * wv); w1.y = pk2(acc[m][2].z * wv, acc[m][2].w * wv); \
                    w1.z = pk2(acc[m][3].x * wv, acc[m][3].y * wv); w1.w = pk2(acc[m][3].z * wv, acc[m][3].w * wv); \
                    *(u32x4*)dst = w0; *(u32x4*)(dst + 8) = w1; } } } while (0)
#define MOE_UNIT(LT) do { \
            f32x4 r0[8], r1[8]; \
            const int s = 4 * lane, sl = s & 63; \
            const float* bpA = ((s & 32) ? Wu : Wg) + 32 * (s >> 6) + (s & 31); \
            f32x4 acc[4][4]; zero_acc(acc); \
            gemm_chain<false, DM / 64, 256, LT, false, true>(acc, F2, r0, r1, (const char*)H1B, ao0, ao1, bpA, bpA + 128, rot, 0); \
            MOE_EPI1(0); \
            zero_acc(acc); \
            gemm_chain<false, DM / 64, 256, LT, true, false>(acc, F2, r0, r1, (const char*)H1B, ao0, ao1, bpA + 128, bpA + 128, rot, 1); \
            MOE_EPI1(128); \
            BLOCK_SYNC(); \
            if (it + 1 < nr + ns) { int e1, t1; MOE_ITEM(it + 1, e1, t1); MOE_FETCH(e1, t1, ptok, pyr, pwv); }       \
            const float* bpD = Wd + (s & 192) + 16 * ((sl >> 2) & 3) + 4 * (sl >> 4) + (sl & 3); \
            zero_acc(acc); \
            gemm_chain<true, 4, DM, LT, false, true>(acc, F2, r0, r1, nullptr, 0u, 0u, bpD, bpD + 256, rot, 0); \
            MOE_EPI2(0); \
            zero_acc(acc); \
            gemm_chain<true, 4, DM, LT, true, true>(acc, F2, r0, r1, nullptr, 0u, 0u, bpD + 256, bpD + 512, rot, 0); \
            MOE_EPI2(1); \
            zero_acc(acc); \
            gemm_chain<true, 4, DM, LT, true, true>(acc, F2, r0, r1, nullptr, 0u, 0u, bpD + 512, bpD + 768, rot, 0); \
            MOE_EPI2(2); \
            zero_acc(acc); \
            gemm_chain<true, 4, DM, LT, true, false>(acc, F2, r0, r1, nullptr, 0u, 0u, bpD + 768, bpD + 768, rot, 0); \
            MOE_EPI2(3); } while (0)
        if (wave >= 4) MOE_UNIT(true); else MOE_UNIT(false);
#undef MOE_UNIT
#undef MOE_EPI1
#undef MOE_EPI2
        BLOCK_SYNC();
    }
}

__device__ __forceinline__ void phase_final(const Frame& F, const float* g, const float* b, float* out) {
    const bf16* H1B = (const bf16*)(F.ws + WS_H1B);
    const bf16* YROWS = (const bf16*)(F.ws + WS_YROWS);
    const int gw = F.vcu * 8 + F.wave, NGW = F.G * 8, lane = F.lane;
    f32x4 gv[4], bv[4];
#pragma unroll
    for (int c = 0; c < 2; ++c)
#pragma unroll
        for (int hh = 0; hh < 2; ++hh) { gv[2 * c + hh] = *(const f32x4*)(g + 8 * lane + 512 * c + 4 * hh); bv[2 * c + hh] = *(const f32x4*)(b + 8 * lane + 512 * c + 4 * hh); }
    for (int row = gw; row < T_TOK; row += NGW) {
        float v[16];
#pragma unroll
        for (int c = 0; c < 2; ++c) {
            const u32x4 hv = *(const u32x4*)(H1B + (size_t)row * DM + 8 * lane + 512 * c);
            v[8 * c + 0] = ALPHA * bflo(hv.x); v[8 * c + 1] = ALPHA * bfhi(hv.x); v[8 * c + 2] = ALPHA * bflo(hv.y); v[8 * c + 3] = ALPHA * bfhi(hv.y);
            v[8 * c + 4] = ALPHA * bflo(hv.z); v[8 * c + 5] = ALPHA * bfhi(hv.z); v[8 * c + 6] = ALPHA * bflo(hv.w); v[8 * c + 7] = ALPHA * bfhi(hv.w);
#pragma unroll
            for (int sidx = 0; sidx < 9; ++sidx) {
                const u32x4 yv = *(const u32x4*)(YROWS + ((size_t)row * 9 + sidx) * DM + 8 * lane + 512 * c);
                v[8 * c + 0] += bflo(yv.x); v[8 * c + 1] += bfhi(yv.x); v[8 * c + 2] += bflo(yv.y); v[8 * c + 3] += bfhi(yv.y);
                v[8 * c + 4] += bflo(yv.z); v[8 * c + 5] += bfhi(yv.z); v[8 * c + 6] += bflo(yv.w); v[8 * c + 7] += bfhi(yv.w);
            }
        }
        float s = 0.f;
#pragma unroll
        for (int i = 0; i < 16; ++i) s += v[i];
        const float mean = wave_sum(s) * (1.f / DM); float s2 = 0.f;
#pragma unroll
        for (int i = 0; i < 16; ++i) { v[i] -= mean; s2 += v[i] * v[i]; }
        const float rstd = 1.f / sqrtf(wave_sum(s2) * (1.f / DM) + 1e-5f);
        float* orow = out + (size_t)row * DM + 8 * lane;
#pragma unroll
        for (int c = 0; c < 2; ++c)
#pragma unroll
            for (int hh = 0; hh < 2; ++hh) {
                f32x4 y;
                y.x = v[8 * c + 4 * hh + 0] * rstd; y.y = v[8 * c + 4 * hh + 1] * rstd; y.z = v[8 * c + 4 * hh + 2] * rstd; y.w = v[8 * c + 4 * hh + 3] * rstd;
                y = y * gv[2 * c + hh] + bv[2 * c + hh];
                *(f32x4*)(orow + 512 * c + 4 * hh) = y;
            }
    }
}

__global__ void __launch_bounds__(512, 2) fwd_kernel(Args a) {
    extern __shared__ __attribute__((aligned(16))) unsigned char lds_raw[];
    Frame F;
    F.lds = (LAS unsigned char*)lds_raw;
    F.tid = threadIdx.x; F.lane = F.tid & 63; F.wave = __builtin_amdgcn_readfirstlane(F.tid >> 6);
    F.G = gridDim.x; { const int bx = blockIdx.x; F.vcu = (F.G % 8 == 0) ? (bx % 8) * (F.G / 8) + bx / 8 : bx; }
    F.ws = a.ws;
    volatile LAS unsigned* MISC = (volatile LAS unsigned*)(F.lds + L_TAB + TB_MISC);
    if (F.tid < 16) MISC[F.tid] = 0u;
    __syncthreads();
    unsigned* ctl = (unsigned*)(a.ws + WS_CTL);
    const int lo = a.ph_lo, hi = a.ph_hi;
    XcdBarrier bar; bar.bar = ctl + CW_BAR; bar.x = 0; bar.st = MISC + 8; bar.w0 = 0;
    if (hi - lo > 1) bar = xcd_barrier_post(ctl + CW_BAR, MISC + 8);
    bar.w0 = (F.wave == 0) ? 1 : 0;
#define IN(k) (lo <= (k) && (k) < hi)
#define SEAM(k) do { if (IN(k) && IN((k) + 1)) xcd_barrier(bar); } while (0)
#define FRESH(Fn) Frame Fn = F; Fn.lane = fresh_lane(); Fn.tid = F.wave * 64 + Fn.lane
    if (IN(0)) { FRESH(F0); phase0(F0, a.in[0], a.in[1], a.in[2], a.in[3], a.in[4], a.in[9]); }
    SEAM(0);
    if (IN(1)) { FRESH(F1); phase1(F1); }
    SEAM(1);
    if (IN(2)) {
        FRESH(F2);
        for (int su = F.vcu; su < 256; su += F.G) swa_unit(F2, su, a.in[5], a.in[6]);
        for (int ku = F.vcu; ku < 512; ku += F.G) kv_unit(F2, ku);
    }
    SEAM(2);
    if (IN(3)) { FRESH(F3); phase_scan(F3); }
    SEAM(3);
    if (IN(4)) { FRESH(F4); for (int ku = F.vcu; ku < 512; ku += F.G) ret_unit(F4, ku); }
    SEAM(4);
    if (IN(5)) { FRESH(F5); phase_outproj(F5); }
    SEAM(5);
    if (IN(6)) { FRESH(F6); phase_router(F6, a.in[7], a.in[8], a.in[9], a.in[10]); }
    SEAM(6);
    if (IN(7)) { FRESH(F7); phase_moe(F7, a.in[11], a.in[12], a.in[13], a.in[14], a.in[15], a.in[16]); }
    SEAM(7);
    if (IN(8)) { FRESH(F8); phase_final(F8, a.in[17], a.in[18], a.out); }
#undef FRESH
#undef IN
#undef SEAM
}

extern "C" void kernel_launch(void* const* d_in, const int* in_sizes, int n_in, void* d_out, int out_size, void* d_ws, size_t ws_size, hipStream_t stream) {
    static int grid = 0;
    if (grid == 0) {
        if (n_in != 19 || out_size != T_TOK * DM || ws_size < WS_END) { fprintf(stderr, "kernel_launch: unexpected problem shape (n_in %d out %d ws %zu)\n", n_in, out_size, ws_size); grid = -1; return; }
        int dev = 0, cus = 0, per_cu = 0;
        if (hipGetDevice(&dev) != hipSuccess || hipDeviceGetAttribute(&cus, hipDeviceAttributeMultiprocessorCount, dev) != hipSuccess) { grid = -1; return; }
        if (hipFuncSetAttribute((const void*)fwd_kernel, hipFuncAttributeMaxDynamicSharedMemorySize, LDS_BYTES) != hipSuccess) { fprintf(stderr, "kernel_launch: hipFuncSetAttribute failed\n"); grid = -1; return; }
        if (hipOccupancyMaxActiveBlocksPerMultiprocessor(&per_cu, (const void*)fwd_kernel, 512, LDS_BYTES) != hipSuccess || per_cu < 1)
            fprintf(stderr, "kernel_launch: occupancy query reports %d\n", per_cu);
        (void)hipGetLastError();
        grid = cus;
    }
    if (grid < 0) return;
    (void)hipMemsetAsync((char*)d_ws + WS_CTL, 0, CTL_BYTES, stream);
    Args a{};
    for (int i = 0; i < 19; ++i) a.in[i] = (const float*)d_in[i];
    a.out = (float*)d_out; a.ws = (unsigned char*)d_ws;
    if (MK_N_LAUNCHES == 1) {
        a.ph_lo = 0; a.ph_hi = NPHASE;
        hipLaunchKernelGGL(fwd_kernel, dim3(grid), dim3(512), LDS_BYTES, stream, a);
    } else {
        for (int p = 0; p < NPHASE; ++p) {
            a.ph_lo = p; a.ph_hi = p + 1;
            hipLaunchKernelGGL(fwd_kernel, dim3(grid), dim3(512), LDS_BYTES, stream, a);
        }
    }
}
```

```cpp
#include <hip/hip_runtime.h>
#include <cstdio>
#include <cstdint>

#ifndef MK_N_LAUNCHES
#define MK_N_LAUNCHES 1
#endif

#define LAS __attribute__((address_space(3)))
typedef unsigned short bf16;
typedef short bf16x8 __attribute__((ext_vector_type(8)));
typedef short s16x4 __attribute__((ext_vector_type(4)));
typedef float f32x4 __attribute__((ext_vector_type(4)));
typedef float f32x2 __attribute__((ext_vector_type(2)));
typedef unsigned u32x4 __attribute__((ext_vector_type(4)));
typedef unsigned u32x2 __attribute__((ext_vector_type(2)));
typedef __bf16 bf2_t __attribute__((ext_vector_type(2)));

constexpr int T_TOK = 16384, SEQ = 8192, DM = 1024, INW = 2304, NEXP = 256;
constexpr int NPHASE = 9;
constexpr float ALPHA = 1.189207115002721f;
constexpr int LCAP = 16384;

constexpr size_t MiB = 1u << 20;
constexpr size_t WS_CTL = 0, CTL_BYTES = 1 * MiB;
constexpr size_t WS_COS = 1 * MiB, WS_SIN = 2 * MiB;
constexpr size_t WS_H0B = 4 * MiB;
constexpr size_t WS_PROJ = 36 * MiB;
constexpr size_t WS_MIXIN = 108 * MiB;
constexpr size_t WS_PRE1 = 140 * MiB;
constexpr size_t WS_H1B = 204 * MiB;
constexpr size_t WS_KVT = 236 * MiB;
constexpr size_t WS_STATE = 252 * MiB;
constexpr size_t WS_LISTS = 260 * MiB;
constexpr size_t WS_ROWW = 276 * MiB;
constexpr size_t WS_YROWS = 280 * MiB;
constexpr size_t WS_WIMG = 576 * MiB;
constexpr int WIMG_IN = 0, WIMG_OUT = 144, WIMG_RT = 208, WIMG_N = 224;
constexpr size_t WS_WT_IN = 620 * MiB;
constexpr size_t WS_WT_OUT = 624 * MiB;
constexpr size_t WS_LIST2 = 584 * MiB;
constexpr size_t WS_END = 626 * MiB;
constexpr int CW_BAR = 4096;
constexpr int CW_CNT = 16384;

constexpr int L_BS0 = 0, L_AS0 = 65536, L_ACTLO = 114688, L_TAB = 147456, LDS_BYTES = 163840;
constexpr int TB_MISC = 0;
constexpr int TB_RTOK = 256;
constexpr int TB_RYROW = 768;
constexpr int TB_RW = 1280;
constexpr int TB_PREFIX = 2048;
constexpr int TB_HIST = 4096;
constexpr int TB_BASE = 5120;
constexpr int TB_SEL = 6144;
constexpr int TB_SELW = 10496;
constexpr int TB_CNT = 12544;
constexpr int TB_UNIT = 10240;

__device__ __forceinline__ unsigned pk2(float lo, float hi) { f32x2 v = {lo, hi}; bf2_t r = __builtin_convertvector(v, bf2_t); return __builtin_bit_cast(unsigned, r); }
__device__ __forceinline__ float bflo(unsigned u) { return __uint_as_float(u << 16); }
__device__ __forceinline__ float bfhi(unsigned u) { return __uint_as_float(u & 0xffff0000u); }
__device__ __forceinline__ float wave_sum(float v) {
#pragma unroll
    for (int o = 1; o < 64; o <<= 1) v += __shfl_xor(v, o);
    return v;
}
#define VM_WAIT() asm volatile("s_waitcnt vmcnt(0)" ::: "memory")
#define ALL_WAIT() asm volatile("s_waitcnt vmcnt(0) lgkmcnt(0)" ::: "memory")
#define BLOCK_SYNC() do { ALL_WAIT(); __syncthreads(); } while (0)

__device__ __forceinline__ int fresh_lane() { int l; asm volatile("v_mbcnt_lo_u32_b32 %0, -1, 0\n\tv_mbcnt_hi_u32_b32 %0, -1, %0" : "=v"(l)); return l; }
#define XB_TMO      128
#define XB_XCNT(j)  (256  + 64 * (j))
#define XB_XSUB(j)  (1280 + 64 * (j))
#define XB_XGEN(j)  (2304 + 64 * (j))
#define XB_TOP      3328
#define XB_TOPGEN   3392
#define XCD_BAR_WORDS 3456
#define XB_SPIN_CAP (1u << 18)
__device__ __forceinline__ unsigned xb_ld(unsigned* p)              { return __hip_atomic_load(p, __ATOMIC_RELAXED, __HIP_MEMORY_SCOPE_AGENT); }
__device__ __forceinline__ unsigned xb_add(unsigned* p, unsigned v) { return __hip_atomic_fetch_add(p, v, __ATOMIC_RELAXED, __HIP_MEMORY_SCOPE_AGENT); }
__device__ __forceinline__ unsigned xb_xcc_id() { return (unsigned)__builtin_amdgcn_s_getreg((3 << 11) | 20) & 0xFu; }
#define XB_SPIN(cond, bar) do { unsigned _sp = 0; while (cond) { __builtin_amdgcn_s_sleep(1); \
    if ((++_sp & 255u) == 0u) { if (xb_ld(&(bar)[XB_TMO])) break; if (_sp > XB_SPIN_CAP) { atomicAdd(&(bar)[XB_TMO], 1u); break; } } } } while (0)
struct XcdBarrier { unsigned* bar; unsigned x; volatile LAS unsigned* st; int w0; };
__device__ __forceinline__ XcdBarrier xcd_barrier_post(unsigned* bar, volatile LAS unsigned* st) {
    XcdBarrier b; b.bar = bar; b.x = xb_xcc_id(); b.st = st; b.w0 = 0;
    if (threadIdx.x == 0) (void)xb_add(&bar[XB_XCNT(b.x)], 1u);
    return b;
}
__device__ __forceinline__ void xcd_barrier_complete(unsigned* bar, unsigned x, unsigned& nloc, unsigned& nx) {
    const unsigned G = gridDim.x * gridDim.y * gridDim.z;
    unsigned sum, cnt, mine, sp = 0u;
    for (;;) {
        sum = 0u; cnt = 0u; mine = 0u;
#pragma unroll
        for (unsigned j = 0; j < 16; ++j) { const unsigned c = xb_ld(&bar[XB_XCNT(j)]); sum += c; cnt += (c > 0u) ? 1u : 0u; mine = (j == x) ? c : mine; }
        if (sum == G) break;
        __builtin_amdgcn_s_sleep(1);
        if ((++sp & 255u) == 0u) { if (xb_ld(&bar[XB_TMO])) break; if (sp > XB_SPIN_CAP) { atomicAdd(&bar[XB_TMO], 1u); break; } }
    }
    nloc = mine > 0u ? mine : 1u; nx = cnt > 0u ? cnt : 1u;
}
__device__ __forceinline__ void xcd_barrier(const XcdBarrier& b) {
    asm volatile("s_waitcnt vmcnt(0)" ::: "memory");
    __syncthreads();
    if (b.w0 && fresh_lane() == 0) {
        unsigned* bar = b.bar;
        __builtin_amdgcn_s_waitcnt(0);
        unsigned nloc = b.st[0], nx = b.st[1];
        if (nloc == 0u) { xcd_barrier_complete(bar, b.x, nloc, nx); b.st[0] = nloc; b.st[1] = nx; }
        const unsigned old = xb_add(&bar[XB_XSUB(b.x)], 1u);
        const unsigned gen = old / nloc;
        if (old + 1u == (gen + 1u) * nloc) {
            __builtin_amdgcn_fence(__ATOMIC_RELEASE, "agent");
            asm volatile("s_waitcnt vmcnt(0)" ::: "memory");
            const unsigned og = xb_add(&bar[XB_TOP], 1u);
            const unsigned tg = og / nx;
            if (og + 1u == (tg + 1u) * nx) xb_add(&bar[XB_TOPGEN], 1u);
            else XB_SPIN(xb_ld(&bar[XB_TOPGEN]) == tg, bar);
            __builtin_amdgcn_fence(__ATOMIC_ACQUIRE, "agent");
            xb_add(&bar[XB_XGEN(b.x)], 1u);
            asm volatile("s_waitcnt vmcnt(0)" ::: "memory");
        } else {
            XB_SPIN(xb_ld(&bar[XB_XGEN(b.x)]) == gen, bar);
            __builtin_amdgcn_fence(__ATOMIC_ACQUIRE, "agent");
            asm volatile("s_waitcnt vmcnt(0)" ::: "memory");
        }
    }
    __syncthreads();
}


namespace pg8 {
#define PG8_LAS __attribute__((address_space(3)))
typedef unsigned short bf16_t;
constexpr int BM = 256, BK = 64, HALF = 128, HTB = HALF * BK * 2;
__host__ __device__ __forceinline__ int lds_byte(int r, int c) { const int st = (r >> 4) * 2 + (c >> 5), rr = r & 15, cc = c & 31, ob = rr * 64 + cc * 2; return st * 1024 + (ob ^ (((ob >> 9) & 1) << 5)); }
__host__ __device__ __forceinline__ void stage_rc(int b, int& R, int& C) { const int st = b / 1024, sb = b % 1024, swz = sb ^ (((sb >> 9) & 1) << 5); R = (st >> 1) * 16 + swz / 64; C = (st & 1) * 32 + (swz % 64) / 2; }
struct Unit { int pm, pn; };
struct Gemm { const bf16_t* A; const bf16_t* Bt; int K; };
template <class Epi, class Sched>
__device__ __forceinline__ void gemm_phase(PG8_LAS unsigned char* lds, const Gemm g, const Sched& S, const Epi& E) {
    const int tid = threadIdx.x, wid = __builtin_amdgcn_readfirstlane(tid >> 6), lane = tid & 63, wr = wid >> 2, wc = wid & 3, fr = lane & 15, fq = lane >> 4;
    const int K = g.K, nt = K / BK;
    unsigned voffA[2], voffB[2];
#pragma unroll
    for (int i = 0; i < 2; ++i) { int R, C; stage_rc(tid * 16 + i * 8192, R, C); voffA[i] = (unsigned)(R * K + C) * 2u; voffB[i] = (unsigned)(R * K + C) * 2u; }
    const size_t kstep = (size_t)(BK * 2);
    const size_t hstep = (size_t)HALF * K * 2;
    const size_t tstep = 2 * hstep;
    const unsigned ldsw = (unsigned)wid * 1024u;
    const int aoff = lds_byte(wr * 64 + fr, fq * 8), boff = lds_byte(wc * 32 + fr, fq * 8);
#define PG8_SA(b, h) (((b) * 2 + (h)) * HTB)
#define PG8_SB(b, h) ((4 + (b) * 2 + (h)) * HTB)
#define PG8_STAGE(bufoff, gbase, voff) do { _Pragma("unroll") for (int _i = 0; _i < 2; ++_i) \
        __builtin_amdgcn_global_load_lds((const unsigned*)((const char*)(gbase) + (voff)[_i]), (PG8_LAS unsigned*)(lds + (bufoff) + ldsw + _i * 8192), 16, 0, 0); } while (0)
#define PG8_LDA(dst, b, h) do { _Pragma("unroll") for (int m = 0; m < 4; ++m) _Pragma("unroll") for (int k = 0; k < 2; ++k) dst[m][k] = *(const PG8_LAS bf16x8*)(lds + PG8_SA(b, h) + aoff + m * 2048 + k * 1024); } while (0)
#define PG8_LDB(dst, b, h) do { _Pragma("unroll") for (int n = 0; n < 2; ++n) _Pragma("unroll") for (int k = 0; k < 2; ++k) dst[n][k] = *(const PG8_LAS bf16x8*)(lds + PG8_SB(b, h) + boff + n * 2048 + k * 1024); } while (0)
#define PG8_MMA(ai, bj, At, Bt) do { __builtin_amdgcn_s_setprio(1); _Pragma("unroll") for (int m = 0; m < 4; ++m) _Pragma("unroll") for (int n = 0; n < 2; ++n) _Pragma("unroll") for (int k = 0; k < 2; ++k) \
        acc[ai][bj][m][n] = __builtin_amdgcn_mfma_f32_16x16x32_bf16(Bt[n][k], At[m][k], acc[ai][bj][m][n], 0, 0, 0); __builtin_amdgcn_s_setprio(0); } while (0)
#define PG8_WAIT_V(n) asm volatile("s_waitcnt vmcnt(" #n ")" ::: "memory")
#define PG8_WAIT_L(n) asm volatile("s_waitcnt lgkmcnt(" #n ")" ::: "memory")
#define PG8_BAR __builtin_amdgcn_s_barrier()
#define PG8_SCHED __builtin_amdgcn_sched_barrier(0)
    Unit cur, nxt; int ui = 0;
    if (!S.next(0, cur)) return;
    f32x4 acc[2][2][4][2];
#pragma unroll
    for (int a = 0; a < 2; ++a)
#pragma unroll
        for (int b = 0; b < 2; ++b)
#pragma unroll
            for (int m = 0; m < 4; ++m)
#pragma unroll
                for (int n = 0; n < 2; ++n) acc[a][b][m][n] = (f32x4){0.f, 0.f, 0.f, 0.f};
    bf16x8 At[4][2], B0[2][2], B1[2][2];
    const char* cA = (const char*)g.A + (size_t)cur.pm * tstep; const char* cB = (const char*)g.Bt + (size_t)cur.pn * tstep;
    PG8_STAGE(PG8_SB(0, 0), cB, voffB); PG8_STAGE(PG8_SA(0, 0), cA, voffA); PG8_STAGE(PG8_SB(0, 1), cB + hstep, voffB); PG8_STAGE(PG8_SA(0, 1), cA + hstep, voffA);
    if (wr == 1) PG8_BAR;
    PG8_WAIT_V(4); PG8_BAR;
    PG8_STAGE(PG8_SB(1, 0), cB + kstep, voffB); PG8_STAGE(PG8_SA(1, 0), cA + kstep, voffA); PG8_STAGE(PG8_SB(1, 1), cB + hstep + kstep, voffB);
    PG8_WAIT_V(6); PG8_BAR;
    for (;;) {
        const bool has_next = S.next(ui + 1, nxt);
        const char* nA = has_next ? (const char*)g.A + (size_t)nxt.pm * tstep : cA; const char* nB = has_next ? (const char*)g.Bt + (size_t)nxt.pn * tstep : cB;
        for (int t = 0; t < nt; t += 2) {
            const bool last = (t == nt - 2);
            const char* a1 = cA + (size_t)(t + 1) * kstep;
            const char* a2 = last ? nA : cA + (size_t)(t + 2) * kstep; const char* b2 = last ? nB : cB + (size_t)(t + 2) * kstep;
            const char* a3 = a2 + kstep; const char* b3 = b2 + kstep;
            PG8_LDB(B0, 0, 0); PG8_SCHED; PG8_LDA(At, 0, 0); PG8_STAGE(PG8_SA(1, 1), a1 + hstep, voffA);
            PG8_WAIT_L(8); PG8_BAR; PG8_WAIT_L(0); PG8_MMA(0, 0, At, B0); PG8_BAR; PG8_SCHED;
            PG8_LDB(B1, 0, 1); PG8_STAGE(PG8_SB(0, 0), b2, voffB);
            PG8_BAR; PG8_WAIT_L(0); PG8_MMA(0, 1, At, B1); PG8_BAR;
            PG8_LDA(At, 0, 1); PG8_STAGE(PG8_SA(0, 0), a2, voffA);
            PG8_BAR; PG8_WAIT_L(0); PG8_MMA(1, 0, At, B0); PG8_BAR; PG8_SCHED;
            PG8_STAGE(PG8_SB(0, 1), b2 + hstep, voffB);
            PG8_WAIT_V(6); PG8_BAR; PG8_MMA(1, 1, At, B1); PG8_BAR;
            PG8_LDB(B0, 1, 0); PG8_SCHED; PG8_LDA(At, 1, 0); PG8_STAGE(PG8_SA(0, 1), a2 + hstep, voffA);
            PG8_WAIT_L(8); PG8_BAR; PG8_WAIT_L(0); PG8_MMA(0, 0, At, B0); PG8_BAR; PG8_SCHED;
            PG8_LDB(B1, 1, 1); PG8_STAGE(PG8_SB(1, 0), b3, voffB);
            PG8_BAR; PG8_WAIT_L(0); PG8_MMA(0, 1, At, B1); PG8_BAR;
            PG8_LDA(At, 1, 1); PG8_STAGE(PG8_SA(1, 0), a3, voffA);
            PG8_BAR; PG8_WAIT_L(0); PG8_MMA(1, 0, At, B0); PG8_BAR; PG8_SCHED;
            PG8_STAGE(PG8_SB(1, 1), b3 + hstep, voffB);
            PG8_WAIT_V(6); PG8_BAR; PG8_MMA(1, 1, At, B1); PG8_BAR;
        }
            E(acc, cur, wr, wc, fr, fq);
            if (!has_next) break;
#pragma unroll
        for (int a = 0; a < 2; ++a)
#pragma unroll
            for (int b = 0; b < 2; ++b)
#pragma unroll
                for (int m = 0; m < 4; ++m)
#pragma unroll
                    for (int n = 0; n < 2; ++n) acc[a][b][m][n] = (f32x4){0.f, 0.f, 0.f, 0.f};
        cur = nxt; cA = nA; cB = nB; ++ui;
    }
    PG8_WAIT_V(0);
    if (wr == 0) PG8_BAR;
    PG8_BAR;
#undef PG8_SA
#undef PG8_SB
#undef PG8_STAGE
#undef PG8_LDA
#undef PG8_LDB
#undef PG8_MMA
#undef PG8_WAIT_V
#undef PG8_WAIT_L
#undef PG8_BAR
#undef PG8_SCHED
}
}

struct Args {
    const float* in[19];
    float* out;
    unsigned char* ws;
    int ph_lo, ph_hi;
};
struct Frame {
    LAS unsigned char* lds;
    int tid, lane, wave, vcu, G;
    unsigned char* ws;
};

template <int MT, int KH0 = 0, int KH1 = 2>
__device__ __forceinline__ void mma_ktile(f32x4 (&acc)[MT][4], LAS const unsigned char* As, LAS const unsigned char* Bs, const unsigned (&foa)[2], const unsigned (&fob)[2][2]) {
#pragma unroll
    for (int kh = KH0; kh < KH1; ++kh) {
        bf16x8 af[MT], bfr[4];
#pragma unroll
        for (int m = 0; m < MT; ++m) af[m] = *(LAS const bf16x8*)(As + m * 2048 + foa[kh]);
#pragma unroll
        for (int n = 0; n < 4; ++n) bfr[n] = *(LAS const bf16x8*)(Bs + n * 2048 + fob[kh][n & 1]);
#pragma unroll
        for (int m = 0; m < MT; ++m)
#pragma unroll
            for (int n = 0; n < 4; ++n)
                acc[m][n] = __builtin_amdgcn_mfma_f32_16x16x32_bf16(bfr[n], af[m], acc[m][n], 0, 0, 0);
    }
}
__device__ __forceinline__ void loadB32(f32x4 (&r)[8], const float* p, size_t ldb) {
#pragma unroll
    for (int i = 0; i < 8; ++i) { r[i] = *(const f32x4*)p; p += ldb; }
}
__device__ __forceinline__ void storeB32(const f32x4 (&r)[8], LAS unsigned char* Bs, int n0, int c) {
#pragma unroll
    for (int j = 0; j < 4; ++j) {
        u32x4 w; w.x = pk2(r[0][j], r[1][j]); w.y = pk2(r[2][j], r[3][j]); w.z = pk2(r[4][j], r[5][j]); w.w = pk2(r[6][j], r[7][j]);
        const int n = n0 + j, x = (n >> 3) & 3, g = ((x & 1) << 1) | (x >> 1);
        *(LAS u32x4*)(Bs + n * 128 + ((c ^ (n & 7) ^ g) << 4)) = w;
    }
}
template <int MT>
__device__ __forceinline__ void dmaA(LAS unsigned char* As, const bf16* p0, const bf16* p1, int wave) {
    __builtin_amdgcn_global_load_lds((const unsigned*)p0, (LAS unsigned*)(As + wave * 1024), 16, 0, 0);
    if (MT == 4) __builtin_amdgcn_global_load_lds((const unsigned*)p1, (LAS unsigned*)(As + wave * 1024 + 8192), 16, 0, 0);
}
#define LGKM_BAR() do { asm volatile("s_waitcnt lgkmcnt(0)" ::: "memory"); __builtin_amdgcn_s_barrier(); asm volatile("" ::: "memory"); } while (0)
template <bool A_LDS>
__device__ __forceinline__ int a_tile_off(int t) { return A_LDS ? ((t < 2) ? L_ACTLO + t * 16384 : L_AS0 + (t - 2) * 16384) : L_AS0 + (t % 3) * 16384; }
template <bool A_LDS, int MT = 4>
__device__ __forceinline__ void gemm_loop(f32x4 (&acc)[MT][4], const Frame& F, const bf16* ap0, const bf16* ap1, const float* bp, size_t ldb, int nk, int rot = 0) {
    LAS unsigned char* lds = F.lds;
    const int lane = F.lane, wave = F.wave, wr = wave >> 2, wc = wave & 3, fr = lane & 15, fq = lane >> 4;
    unsigned foa[2], fob[2][2];
#pragma unroll
    for (int kh = 0; kh < 2; ++kh) {
        foa[kh] = (unsigned)(fr * 128 + ((((4 * kh + fq)) ^ (fr & 7)) << 4));
#pragma unroll
        for (int par = 0; par < 2; ++par) fob[kh][par] = (unsigned)(fr * 128 + (((4 * kh + fq) ^ (fr & 7) ^ ((fr >> 3) << 1) ^ par) << 4));
    }
    const int n0 = 4 * lane;
    const float* bpp = bp + (size_t)(8 * wave) * ldb;
    const size_t tstep = 64 * ldb;
    f32x4 r0[8], r1[8];
#define WAITV(more) do { if (more) { if (A_LDS) asm volatile("s_waitcnt vmcnt(8)" ::: "memory"); else if (MT == 4) asm volatile("s_waitcnt vmcnt(10)" ::: "memory"); else asm volatile("s_waitcnt vmcnt(9)" ::: "memory"); } else asm volatile("s_waitcnt vmcnt(0)" ::: "memory"); } while (0)
#define KT(t) (((t) ^ rot) & (nk - 1))
#define ENDWAIT(nb, na) do { if (nb) { if (A_LDS) asm volatile("s_waitcnt vmcnt(8)" ::: "memory"); else if (MT == 4) asm volatile("s_waitcnt vmcnt(10)" ::: "memory"); else asm volatile("s_waitcnt vmcnt(9)" ::: "memory"); } \
                             else if ((na) && !A_LDS) { if (MT == 4) asm volatile("s_waitcnt vmcnt(2)" ::: "memory"); else asm volatile("s_waitcnt vmcnt(1)" ::: "memory"); } \
                             else asm volatile("s_waitcnt vmcnt(0)" ::: "memory"); } while (0)
    loadB32(r0, bpp + (size_t)KT(0) * tstep, ldb);
    if (!A_LDS) dmaA<MT>(lds + L_AS0, ap0 + KT(0) * 64, ap1 + KT(0) * 64, wave);
    if (nk > 1) { loadB32(r1, bpp + (size_t)KT(1) * tstep, ldb); if (!A_LDS) dmaA<MT>(lds + L_AS0 + 16384, ap0 + KT(1) * 64, ap1 + KT(1) * 64, wave); }
    __builtin_amdgcn_sched_barrier(0);
    WAITV(nk > 1);
    storeB32(r0, lds + L_BS0, n0, wave);
    if (nk > 2) loadB32(r0, bpp + (size_t)KT(2) * tstep, ldb);
    __builtin_amdgcn_sched_barrier(0);
    if (nk > 2) { asm volatile("s_waitcnt vmcnt(8)" ::: "memory"); } else asm volatile("s_waitcnt vmcnt(0)" ::: "memory");
    LGKM_BAR();
    for (int t = 0; t < nk; t += 2) {
        if (t + 1 < nk) storeB32(r1, lds + L_BS0 + 32768, n0, wave);
        if (t + 3 < nk) loadB32(r1, bpp + (size_t)KT(t + 3) * tstep, ldb);
        __builtin_amdgcn_sched_barrier(0);
        mma_ktile<MT, 0, 1>(acc, lds + (A_LDS ? a_tile_off<true>(KT(t)) : a_tile_off<false>(t)) + wr * (MT * 2048), lds + L_BS0 + wc * 8192, foa, fob);
        __builtin_amdgcn_sched_barrier(0);
        if (t + 2 < nk) { if (!A_LDS) dmaA<MT>(lds + a_tile_off<false>(t + 2), ap0 + KT(t + 2) * 64, ap1 + KT(t + 2) * 64, wave); }
        __builtin_amdgcn_sched_barrier(0);
        mma_ktile<MT, 1, 2>(acc, lds + (A_LDS ? a_tile_off<true>(KT(t)) : a_tile_off<false>(t)) + wr * (MT * 2048), lds + L_BS0 + wc * 8192, foa, fob);
        __builtin_amdgcn_sched_barrier(0);
        ENDWAIT(t + 3 < nk, t + 2 < nk);
        LGKM_BAR();
        if (t + 1 >= nk) break;
        if (t + 2 < nk) storeB32(r0, lds + L_BS0, n0, wave);
        if (t + 4 < nk) loadB32(r0, bpp + (size_t)KT(t + 4) * tstep, ldb);
        __builtin_amdgcn_sched_barrier(0);
        mma_ktile<MT, 0, 1>(acc, lds + (A_LDS ? a_tile_off<true>(KT(t + 1)) : a_tile_off<false>(t + 1)) + wr * (MT * 2048), lds + L_BS0 + 32768 + wc * 8192, foa, fob);
        __builtin_amdgcn_sched_barrier(0);
        if (t + 3 < nk) { if (!A_LDS) dmaA<MT>(lds + a_tile_off<false>(t + 3), ap0 + KT(t + 3) * 64, ap1 + KT(t + 3) * 64, wave); }
        __builtin_amdgcn_sched_barrier(0);
        mma_ktile<MT, 1, 2>(acc, lds + (A_LDS ? a_tile_off<true>(KT(t + 1)) : a_tile_off<false>(t + 1)) + wr * (MT * 2048), lds + L_BS0 + 32768 + wc * 8192, foa, fob);
        __builtin_amdgcn_sched_barrier(0);
        ENDWAIT(t + 4 < nk, t + 3 < nk);
        LGKM_BAR();
    }
#undef ENDWAIT
#undef WAITV
#undef KT
}
template <int OFF>
__device__ __forceinline__ void gld16(f32x4& d, const float* p) { asm volatile("global_load_dwordx4 %0, %1, off offset:%2" : "=&v"(d) : "v"(p), "n"(OFF) : "memory"); }
template <int LDB>
__device__ __forceinline__ void loadB32a(f32x4 (&r)[8], const float* p) {
    if (LDB == 256) {
        const float* q = p + 4 * LDB;
        gld16<-4096>(r[0], q); gld16<-3072>(r[1], q); gld16<-2048>(r[2], q); gld16<-1024>(r[3], q); gld16<0>(r[4], q); gld16<1024>(r[5], q); gld16<2048>(r[6], q); gld16<3072>(r[7], q);
    } else {
        const float* q0 = p + LDB; const float* q1 = p + 3 * LDB; const float* q2 = p + 5 * LDB; const float* q3 = p + 7 * LDB;
        gld16<-4096>(r[0], q0); gld16<0>(r[1], q0); gld16<-4096>(r[2], q1); gld16<0>(r[3], q1); gld16<-4096>(r[4], q2); gld16<0>(r[5], q2); gld16<-4096>(r[6], q3); gld16<0>(r[7], q3);
    }
}
#define TIE8(r) "+v"(r[0]), "+v"(r[1]), "+v"(r[2]), "+v"(r[3]), "+v"(r[4]), "+v"(r[5]), "+v"(r[6]), "+v"(r[7])
template <int N> __device__ __forceinline__ void wait_vmc() {
    static_assert(N >= 0 && N <= 12 && N % 2 == 0, "vmcnt");
    if (N == 0) asm volatile("s_waitcnt vmcnt(0)" ::: "memory"); else if (N == 2) asm volatile("s_waitcnt vmcnt(2)" ::: "memory"); else if (N == 4) asm volatile("s_waitcnt vmcnt(4)" ::: "memory");
    else if (N == 6) asm volatile("s_waitcnt vmcnt(6)" ::: "memory"); else if (N == 8) asm volatile("s_waitcnt vmcnt(8)" ::: "memory"); else if (N == 10) asm volatile("s_waitcnt vmcnt(10)" ::: "memory");
    else asm volatile("s_waitcnt vmcnt(12)" ::: "memory");
}
template <bool A_LDS, int NK, int LDB, bool LATE = false>
__device__ __forceinline__ void gemm_loopa(f32x4 (&acc)[4][4], const Frame& F, const bf16* ap0, const bf16* ap1, const float* bp, int rot) {
    static_assert(LDB == 256 || LDB == 1024, "row pitch of the f32 B source");
    constexpr int MT = 4;
    LAS unsigned char* lds = F.lds;
    const int lane = F.lane, wave = F.wave, wr = wave >> 2, wc = wave & 3, fr = lane & 15, fq = lane >> 4;
    unsigned foa[2], fob[2][2];
#pragma unroll
    for (int kh = 0; kh < 2; ++kh) {
        foa[kh] = (unsigned)(fr * 128 + ((((4 * kh + fq)) ^ (fr & 7)) << 4));
#pragma unroll
        for (int par = 0; par < 2; ++par) fob[kh][par] = (unsigned)(fr * 128 + (((4 * kh + fq) ^ (fr & 7) ^ ((fr >> 3) << 1) ^ par) << 4));
    }
    const int n0 = 4 * lane;
    const float* bpp = bp + (size_t)(8 * wave) * LDB;
    constexpr size_t tstep = (size_t)64 * LDB;
    f32x4 r0[8], r1[8];
#define KT(t) (((t) ^ rot) & (NK - 1))
#define XWAIT(nb, na, RS) do { if (nb) { if (A_LDS) asm volatile("s_waitcnt vmcnt(8)" : TIE8(RS) :: "memory"); else asm volatile("s_waitcnt vmcnt(10)" : TIE8(RS) :: "memory"); } \
                               else if ((na) && !A_LDS) asm volatile("s_waitcnt vmcnt(2)" : TIE8(RS) :: "memory"); \
                               else asm volatile("s_waitcnt vmcnt(0)" : TIE8(RS) :: "memory"); } while (0)
#define X_ATILE(t) (lds + (A_LDS ? a_tile_off<true>(KT(t)) : a_tile_off<false>(t)) + wr * (MT * 2048))
#define X_EVEN(t, H1, H2, H3) do { \
        if (H1) storeB32(r1, lds + L_BS0 + 32768, n0, wave); \
        if (H3) loadB32a<LDB>(r1, bpp + (size_t)KT((t) + 3) * tstep); \
        __builtin_amdgcn_sched_barrier(0); \
        mma_ktile<MT, 0, 1>(acc, X_ATILE(t), lds + L_BS0 + wc * 8192, foa, fob); \
        __builtin_amdgcn_sched_barrier(0); \
        if ((H2) && !A_LDS) dmaA<MT>(lds + a_tile_off<false>((t) + 2), ap0 + KT((t) + 2) * 64, ap1 + KT((t) + 2) * 64, wave); \
        __builtin_amdgcn_sched_barrier(0); \
        mma_ktile<MT, 1, 2>(acc, X_ATILE(t), lds + L_BS0 + wc * 8192, foa, fob); \
        __builtin_amdgcn_sched_barrier(0); \
        XWAIT(H3, H2, r0); \
        LGKM_BAR(); } while (0)
#define X_ODD(t, H2, H3, H4) do { \
        if (H2) storeB32(r0, lds + L_BS0, n0, wave); \
        if (H4) loadB32a<LDB>(r0, bpp + (size_t)KT((t) + 4) * tstep); \
        __builtin_amdgcn_sched_barrier(0); \
        mma_ktile<MT, 0, 1>(acc, X_ATILE((t) + 1), lds + L_BS0 + 32768 + wc * 8192, foa, fob); \
        __builtin_amdgcn_sched_barrier(0); \
        if ((H3) && !A_LDS) dmaA<MT>(lds + a_tile_off<false>((t) + 3), ap0 + KT((t) + 3) * 64, ap1 + KT((t) + 3) * 64, wave); \
        __builtin_amdgcn_sched_barrier(0); \
        mma_ktile<MT, 1, 2>(acc, X_ATILE((t) + 1), lds + L_BS0 + 32768 + wc * 8192, foa, fob); \
        __builtin_amdgcn_sched_barrier(0); \
        XWAIT(H4, H3, r1); \
        LGKM_BAR(); } while (0)
    loadB32a<LDB>(r0, bpp + (size_t)KT(0) * tstep);
    if (!A_LDS) dmaA<MT>(lds + L_AS0, ap0 + KT(0) * 64, ap1 + KT(0) * 64, wave);
    loadB32a<LDB>(r1, bpp + (size_t)KT(1) * tstep);
    if (!A_LDS) dmaA<MT>(lds + L_AS0 + 16384, ap0 + KT(1) * 64, ap1 + KT(1) * 64, wave);
    __builtin_amdgcn_sched_barrier(0);
    if (A_LDS) asm volatile("s_waitcnt vmcnt(8)" : TIE8(r0) :: "memory"); else asm volatile("s_waitcnt vmcnt(10)" : TIE8(r0) :: "memory");
    storeB32(r0, lds + L_BS0, n0, wave);
    loadB32a<LDB>(r0, bpp + (size_t)KT(2) * tstep);
    __builtin_amdgcn_sched_barrier(0);
    asm volatile("s_waitcnt vmcnt(8)" : TIE8(r1) :: "memory");
    LGKM_BAR();
    constexpr int T0 = (NK > 4) ? ((NK - 3) / 2) * 2 : 0;
    if (!LATE) {
#pragma unroll 1
        for (int t = 0; t < T0; t += 2) { X_EVEN(t, true, true, true); X_ODD(t, true, true, true); }
#pragma unroll
        for (int t = T0; t < NK; t += 2) { X_EVEN(t, t + 1 < NK, t + 2 < NK, t + 3 < NK); X_ODD(t, t + 2 < NK, t + 3 < NK, t + 4 < NK); }
    } else {
#define L_NB(s) ((s) + 3 < NK)
#define L_NA(s) (!A_LDS && (s) + 2 < NK)
#define L_STEP(s, RS, BOFF, WA, WB) do { \
        mma_ktile<MT, 0, 2>(acc, X_ATILE(s), lds + L_BS0 + (BOFF) + wc * 8192, foa, fob); \
        __builtin_amdgcn_sched_barrier(0); \
        if ((s) + 1 < NK) { wait_vmc<WA>(); asm volatile("" : TIE8(RS) :: "memory"); storeB32(RS, lds + L_BS0 + (32768 - (BOFF)), n0, wave); } \
        if (L_NB(s)) loadB32a<LDB>(RS, bpp + (size_t)KT((s) + 3) * tstep); \
        if (L_NA(s)) dmaA<MT>(lds + a_tile_off<false>((s) + 2), ap0 + KT((s) + 2) * 64, ap1 + KT((s) + 2) * 64, wave); \
        __builtin_amdgcn_sched_barrier(0); \
        if (!A_LDS && (s) + 1 < NK) wait_vmc<WB>(); \
        LGKM_BAR(); } while (0)
        constexpr int WAS = A_LDS ? 8 : 10, WBS = 10;
#pragma unroll 1
        for (int t = 0; t < T0; t += 2) { L_STEP(t, r1, 0, WAS, WBS); L_STEP(t + 1, r0, 32768, WAS, WBS); }
#define L_WA(s) ((((s) >= 2 ? L_NA((s) - 2) : ((s) == 0 && !A_LDS)) ? 2 : 0) + (((s) >= 1 ? L_NB((s) - 1) : true) ? 8 : 0) + (((s) >= 1 && L_NA((s) - 1)) ? 2 : 0))
#define L_WB(s) ((L_NB(s) ? 8 : 0) + (L_NA(s) ? 2 : 0))
#define L_TAIL(s, RS, BOFF) L_STEP(s, RS, BOFF, (L_WA(s) > 10 ? 10 : L_WA(s)), L_WB(s))
        static_assert(T0 % 2 == 0 && NK - T0 == 4, "tail of four steps");
        L_TAIL(T0, r1, 0); L_TAIL(T0 + 1, r0, 32768); L_TAIL(T0 + 2, r1, 0); L_TAIL(T0 + 3, r0, 32768);
#undef L_TAIL
#undef L_WA
#undef L_WB
#undef L_STEP
#undef L_NA
#undef L_NB
    }
#undef X_EVEN
#undef X_ODD
#undef X_ATILE
#undef XWAIT
#undef KT
}
template <bool A_LDS, int NK, int LDB, bool LATE, bool PRE, int NLDB, int NNK>
__device__ __forceinline__ void gemm_chain(f32x4 (&acc)[4][4], const Frame& F, f32x4 (&r0)[8], f32x4 (&r1)[8], const char* abase, unsigned ao0, unsigned ao1, const float* bp, const float* bpn, int rot, int rb) {
    static_assert(LDB == 256 || LDB == 1024, "row pitch of the f32 B source");
    static_assert(NLDB == 0 || NLDB == 256 || NLDB == 1024, "row pitch of the next f32 B source");
    constexpr int MT = 4;
    constexpr bool CHAIN = NLDB != 0;
    constexpr bool SAME = CHAIN && NLDB == LDB && NNK == NK;
    constexpr int NL = CHAIN ? NLDB : LDB, NN = CHAIN ? NNK : NK;
    LAS unsigned char* lds = F.lds;
    const int lane = F.lane, wave = F.wave, wr = wave >> 2, wc = wave & 3, fr = lane & 15, fq = lane >> 4;
    unsigned foa[2], fob[2][2];
#pragma unroll
    for (int kh = 0; kh < 2; ++kh) {
        foa[kh] = (unsigned)(fr * 128 + ((((4 * kh + fq)) ^ (fr & 7)) << 4));
#pragma unroll
        for (int par = 0; par < 2; ++par) fob[kh][par] = (unsigned)(fr * 128 + (((4 * kh + fq) ^ (fr & 7) ^ ((fr >> 3) << 1) ^ par) << 4));
    }
    const int n0 = 4 * lane;
    const float* bpp = bp + (size_t)(8 * wave) * LDB;
    const float* bppn = bpn + (size_t)(8 * wave) * NL;
    constexpr size_t tstep = (size_t)64 * LDB, tstepn = (size_t)64 * NL;
#define KT(t) (((t) ^ rot) & (NK - 1))
#define C_BPTR(j) ((((j) < NK) ? bpp : bppn) + (size_t)KT(j) * tstep)
#define C_LOAD(RS, j) do { if ((j) < NK) loadB32a<LDB>(RS, bpp + (size_t)KT(j) * tstep); else loadB32a<NL>(RS, bppn + (size_t)((((j) - NK) ^ rot) & (NN - 1)) * tstepn); } while (0)
#define C_ASLOT(j) (L_AS0 + (((j) + rb) % 3) * 16384)
#define C_ADMA(j) do { unsigned a0_ = ao0, a1_ = ao1; asm volatile("" : "+v"(a0_), "+v"(a1_)); const unsigned ko_ = (unsigned)KT(j) * 128u;     \
        dmaA<MT>(lds + C_ASLOT(j), (const bf16*)(abase + (a0_ + ko_)), (const bf16*)(abase + (a1_ + ko_)), wave); } while (0)
#define X_ATILE(t) (lds + (A_LDS ? a_tile_off<true>(KT(t)) : C_ASLOT(t)) + wr * (MT * 2048))
#define X_EVEN(t, H1, AD2, LD3, LOADSTMT) do { \
        if (H1) storeB32(r1, lds + L_BS0 + 32768, n0, wave); \
        if (LD3) { LOADSTMT; } \
        __builtin_amdgcn_sched_barrier(0); \
        mma_ktile<MT, 0, 1>(acc, X_ATILE(t), lds + L_BS0 + wc * 8192, foa, fob); \
        __builtin_amdgcn_sched_barrier(0); \
        if ((AD2) && !A_LDS) C_ADMA((t) + 2); \
        __builtin_amdgcn_sched_barrier(0); \
        mma_ktile<MT, 1, 2>(acc, X_ATILE(t), lds + L_BS0 + wc * 8192, foa, fob); \
        __builtin_amdgcn_sched_barrier(0); \
        wait_vmc<((LD3) ? 8 : 0) + (((AD2) && !A_LDS) ? 2 : 0)>(); asm volatile("" : TIE8(r0) :: "memory"); \
        LGKM_BAR(); } while (0)
#define X_ODD(t, H2, AD3, LD4, LOADSTMT) do { \
        if (H2) storeB32(r0, lds + L_BS0, n0, wave); \
        if (LD4) { LOADSTMT; } \
        __builtin_amdgcn_sched_barrier(0); \
        mma_ktile<MT, 0, 1>(acc, X_ATILE((t) + 1), lds + L_BS0 + 32768 + wc * 8192, foa, fob); \
        __builtin_amdgcn_sched_barrier(0); \
        if ((AD3) && !A_LDS) C_ADMA((t) + 3); \
        __builtin_amdgcn_sched_barrier(0); \
        mma_ktile<MT, 1, 2>(acc, X_ATILE((t) + 1), lds + L_BS0 + 32768 + wc * 8192, foa, fob); \
        __builtin_amdgcn_sched_barrier(0); \
        wait_vmc<((LD4) ? 8 : 0) + (((AD3) && !A_LDS) ? 2 : 0)>(); asm volatile("" : TIE8(r1) :: "memory"); \
        LGKM_BAR(); } while (0)
    if (!PRE) {
        loadB32a<LDB>(r0, bpp + (size_t)KT(0) * tstep);
        if (!A_LDS) C_ADMA(0);
        loadB32a<LDB>(r1, bpp + (size_t)KT(1) * tstep);
        if (!A_LDS) C_ADMA(1);
        __builtin_amdgcn_sched_barrier(0);
        if (A_LDS) asm volatile("s_waitcnt vmcnt(8)" : TIE8(r0) :: "memory"); else asm volatile("s_waitcnt vmcnt(10)" : TIE8(r0) :: "memory");
        storeB32(r0, lds + L_BS0, n0, wave);
        loadB32a<LDB>(r0, bpp + (size_t)KT(2) * tstep);
        __builtin_amdgcn_sched_barrier(0);
        asm volatile("s_waitcnt vmcnt(8)" : TIE8(r1) :: "memory");
        LGKM_BAR();
    }
    constexpr int T0 = SAME ? NK : NK - 4;
    static_assert(T0 >= 0 && T0 % 2 == 0, "step pairs");
    if (!LATE) {
#pragma unroll 1
        for (int t = 0; t < T0; t += 2) {
            X_EVEN(t, true, true, true, loadB32a<LDB>(r1, C_BPTR(t + 3)));
            X_ODD(t, true, true, true, loadB32a<LDB>(r0, C_BPTR(t + 4)));
        }
        if (!SAME) {
            X_EVEN(NK - 4, true, true, true, C_LOAD(r1, NK - 1));
            X_ODD(NK - 4, true, true, CHAIN, C_LOAD(r0, NK));
            X_EVEN(NK - 2, true, false, CHAIN, C_LOAD(r1, NK + 1));
            X_ODD(NK - 2, CHAIN, false, CHAIN, C_LOAD(r0, NK + 2));
        }
    } else {
#define L_STEP(s, RS, BOFF, ST, NB, NA, WA, WB, LOADSTMT) do { \
        mma_ktile<MT, 0, 2>(acc, X_ATILE(s), lds + L_BS0 + (BOFF) + wc * 8192, foa, fob); \
        __builtin_amdgcn_sched_barrier(0); \
        if (ST) { wait_vmc<WA>(); asm volatile("" : TIE8(RS) :: "memory"); storeB32(RS, lds + L_BS0 + (32768 - (BOFF)), n0, wave); } \
        if (NB) { LOADSTMT; } \
        if ((NA) && !A_LDS) C_ADMA((s) + 2); \
        __builtin_amdgcn_sched_barrier(0); \
        if (!A_LDS && (WB) >= 0) wait_vmc<((WB) >= 0 ? (WB) : 0)>(); \
        LGKM_BAR(); } while (0)
        constexpr int WAS = A_LDS ? 8 : 10, WBS = A_LDS ? -1 : 10;
#pragma unroll 1
        for (int t = 0; t < T0; t += 2) {
            L_STEP(t, r1, 0, true, true, true, WAS, WBS, loadB32a<LDB>(r1, C_BPTR(t + 3)));
            L_STEP(t + 1, r0, 32768, true, true, true, WAS, WBS, loadB32a<LDB>(r0, C_BPTR(t + 4)));
        }
        if (!SAME) {
            constexpr bool AL = A_LDS;
            constexpr int NB3 = CHAIN ? 8 : 0;
            L_STEP(NK - 4, r1, 0, true, true, true, (NK > 4 ? WAS : (AL ? 8 : 10)), (AL ? -1 : 10), C_LOAD(r1, NK - 1));
            L_STEP(NK - 3, r0, 32768, true, CHAIN, true, WAS, (AL ? -1 : NB3 + 2), C_LOAD(r0, NK));
            L_STEP(NK - 2, r1, 0, true, CHAIN, false, (AL ? NB3 : (2 + NB3 + 2 > 10 ? 10 : 2 + NB3 + 2)), (AL ? -1 : NB3), C_LOAD(r1, NK + 1));
            L_STEP(NK - 1, r0, 32768, CHAIN, CHAIN, false, (AL ? NB3 : 2 + NB3), -1, C_LOAD(r0, NK + 2));
        }
#undef L_STEP
    }
#undef X_EVEN
#undef X_ODD
#undef X_ATILE
#undef C_ADMA
#undef C_ASLOT
#undef C_LOAD
#undef C_BPTR
#undef KT
}
__device__ __forceinline__ int swz4(int row) { return (0x78 >> (2 * ((row >> 2) & 3))) & 3; }
template <int MT>
__device__ __forceinline__ void gemm_ring(f32x4 (&acc)[MT][4], const Frame& F, const bf16* abase, const unsigned (&aoff)[2], const bf16* bblk, int nst) {
    LAS unsigned char* lds = F.lds;
    const int tid = F.tid, lane = F.lane, wave = F.wave, wr = wave >> 2, wc = wave & 3, fr = lane & 15, fq = lane >> 4;
    const unsigned fo = (unsigned)(fr * 64 + ((fq ^ swz4(fr)) << 4));
    const unsigned boff = (unsigned)(tid * 16);
    const bool a_wave = (MT != 2) || (wave < 4);
#define RG_STAGE(t) do { const int sl_ = ((t) & 3) * 32768; \
        _Pragma("unroll") for (int i = 0; i < 2; ++i) __builtin_amdgcn_global_load_lds((const unsigned*)((const char*)bblk + (size_t)(t) * 16384 + boff + i * 8192), (LAS unsigned*)(lds + sl_ + 16384 + wave * 1024 + i * 8192), 16, 0, 0); \
        if (MT == 8) { _Pragma("unroll") for (int i = 0; i < 2; ++i) __builtin_amdgcn_global_load_lds((const unsigned*)((const char*)abase + (size_t)(t) * 64 + aoff[i]), (LAS unsigned*)(lds + sl_ + wave * 1024 + i * 8192), 16, 0, 0); } \
        else if (a_wave) __builtin_amdgcn_global_load_lds((const unsigned*)((const char*)abase + (size_t)(t) * 64 + aoff[0]), (LAS unsigned*)(lds + sl_ + wave * 1024), 16, 0, 0); } while (0)
#define RG_WAIT(k) do { if (MT == 8) { if ((k) == 2) asm volatile("s_waitcnt vmcnt(8)" ::: "memory"); else if ((k) == 1) asm volatile("s_waitcnt vmcnt(4)" ::: "memory"); else asm volatile("s_waitcnt vmcnt(0)" ::: "memory"); } \
        else if (a_wave) { if ((k) == 2) asm volatile("s_waitcnt vmcnt(6)" ::: "memory"); else if ((k) == 1) asm volatile("s_waitcnt vmcnt(3)" ::: "memory"); else asm volatile("s_waitcnt vmcnt(0)" ::: "memory"); } \
        else { if ((k) == 2) asm volatile("s_waitcnt vmcnt(4)" ::: "memory"); else if ((k) == 1) asm volatile("s_waitcnt vmcnt(2)" ::: "memory"); else asm volatile("s_waitcnt vmcnt(0)" ::: "memory"); } } while (0)
    RG_STAGE(0);
    if (nst > 1) RG_STAGE(1);
    if (nst > 2) RG_STAGE(2);
#pragma unroll 1
    for (int t = 0; t < nst; ++t) {
        const int ahead = (nst - 1 - t) < 2 ? (nst - 1 - t) : 2;
        if (ahead == 2) RG_WAIT(2); else if (ahead == 1) RG_WAIT(1); else RG_WAIT(0);
        LGKM_BAR();
        __builtin_amdgcn_sched_barrier(0);
        {
            LAS const unsigned char* As = lds + (t & 3) * 32768 + wr * (MT * 1024);
            LAS const unsigned char* Bs = lds + (t & 3) * 32768 + 16384 + wc * 4096;
            bf16x8 bfr[4];
#pragma unroll
            for (int n = 0; n < 4; ++n) bfr[n] = *(LAS const bf16x8*)(Bs + n * 1024 + fo);
            constexpr int MH = MT > 4 ? 4 : MT;
#pragma unroll
            for (int m0 = 0; m0 < MT; m0 += MH) {
                bf16x8 af[MH];
#pragma unroll
                for (int m = 0; m < MH; ++m) af[m] = *(LAS const bf16x8*)(As + (m0 + m) * 1024 + fo);
#pragma unroll
                for (int m = 0; m < MH; ++m)
#pragma unroll
                    for (int n = 0; n < 4; ++n)
                        acc[m0 + m][n] = __builtin_amdgcn_mfma_f32_16x16x32_bf16(bfr[n], af[m], acc[m0 + m][n], 0, 0, 0);
                if (m0 == 0) {
                    __builtin_amdgcn_sched_barrier(0);
                    if (t + 3 < nst) RG_STAGE(t + 3);
                    __builtin_amdgcn_sched_barrier(0);
                }
            }
        }
        __builtin_amdgcn_sched_barrier(0);
    }
    LGKM_BAR();
#undef RG_STAGE
#undef RG_WAIT
}
__device__ __forceinline__ void ring_aoff(unsigned (&aoff)[2], int tid, int ld_elems) {
#pragma unroll
    for (int i = 0; i < 2; ++i) { const int p = tid + 512 * i, row = p >> 2, lc = (p & 3) ^ swz4(row); aoff[i] = (unsigned)(row * ld_elems + lc * 8) * 2u; }
}
template <int MT>
__device__ __forceinline__ void zero_accT(f32x4 (&acc)[MT][4]) {
#pragma unroll
    for (int m = 0; m < MT; ++m)
#pragma unroll
        for (int n = 0; n < 4; ++n) acc[m][n] = (f32x4){0.f, 0.f, 0.f, 0.f};
}
__device__ __forceinline__ void convert_block(const Frame& F, const float* colp, size_t ldb, int kt, bf16* blk) {
    f32x4 r[8];
    loadB32(r, colp + (size_t)(kt * 64 + 8 * F.wave) * ldb, ldb);
#pragma unroll
    for (int j = 0; j < 4; ++j) {
        u32x4 w; w.x = pk2(r[0][j], r[1][j]); w.y = pk2(r[2][j], r[3][j]); w.z = pk2(r[4][j], r[5][j]); w.w = pk2(r[6][j], r[7][j]);
        const int n = 4 * F.lane + j;
        *(u32x4*)((char*)blk + (F.wave >> 2) * 16384 + n * 64 + (((F.wave & 3) ^ swz4(n)) << 4)) = w;
    }
}
__device__ __forceinline__ void zero_acc(f32x4 (&acc)[4][4]) {
#pragma unroll
    for (int m = 0; m < 4; ++m)
#pragma unroll
        for (int n = 0; n < 4; ++n) acc[m][n] = (f32x4){0.f, 0.f, 0.f, 0.f};
}

__device__ __forceinline__ void phase0(const Frame& F, const float* x, const float* g, const float* b, const float* w_in, const float* w_out, const float* w_router) {
    const int gw = F.vcu * 8 + F.wave, NGW = F.G * 8;
    bf16* H0B = (bf16*)(F.ws + WS_H0B);
    f32x4 gv[4], bv[4];
#pragma unroll
    for (int c = 0; c < 4; ++c) { gv[c] = *(const f32x4*)(g + 4 * F.lane + 256 * c); bv[c] = *(const f32x4*)(b + 4 * F.lane + 256 * c); }
    for (int row = gw; row < T_TOK; row += NGW) {
        const float* xr = x + (size_t)row * DM + 4 * F.lane;
        f32x4 v[4]; float s = 0.f;
#pragma unroll
        for (int c = 0; c < 4; ++c) { v[c] = *(const f32x4*)(xr + 256 * c); s += (v[c].x + v[c].y) + (v[c].z + v[c].w); }
        const float mean = wave_sum(s) * (1.f / DM); float s2 = 0.f;
#pragma unroll
        for (int c = 0; c < 4; ++c) { v[c] = v[c] - mean; s2 += (v[c].x * v[c].x + v[c].y * v[c].y) + (v[c].z * v[c].z + v[c].w * v[c].w); }
        const float rstd = 1.f / sqrtf(wave_sum(s2) * (1.f / DM) + 1e-5f);
        bf16* orow = H0B + (size_t)row * DM + 4 * F.lane;
#pragma unroll
        for (int c = 0; c < 4; ++c) {
            const f32x4 y = v[c] * rstd * gv[c] + bv[c];
            u32x2 w; w.x = pk2(y.x, y.y); w.y = pk2(y.z, y.w);
            *(u32x2*)(orow + 256 * c) = w;
        }
    }
    {
        bf16* WIMG = (bf16*)(F.ws + WS_WIMG);
        for (int blk = F.vcu; blk < WIMG_N; blk += F.G) {
            const int s = 4 * F.lane;
            if (blk >= 128 && blk < WIMG_OUT) convert_block(F, w_in + (blk / 16) * 256 + s, INW, blk % 16, WIMG + (size_t)blk * 16384);
            else if (blk >= WIMG_RT) convert_block(F, w_router + s, NEXP, blk - WIMG_RT, WIMG + (size_t)blk * 16384);
        }
    }
    {
        bf16* WTI = (bf16*)(F.ws + WS_WT_IN); bf16* WTO = (bf16*)(F.ws + WS_WT_OUT);
        LAS float* scr = (LAS float*)(F.lds + F.wave * 8448);
        for (int it = gw; it < 1024 + 512; it += NGW) {
            const bool isin = it < 1024; const int r = isin ? it : it - 1024;
            const int nblk = isin ? 64 : 32, kb = r / nblk, nb = r % nblk, k0 = 64 * kb, n0 = 32 * nb, N = isin ? INW : DM;
            const float* W = isin ? w_in : w_out; bf16* WT = isin ? WTI : WTO;
#pragma unroll 8
            for (int i = 0; i < 32; ++i) { const int kk = 2 * i + (F.lane >> 5); scr[kk * 33 + (F.lane & 31)] = W[(size_t)(k0 + kk) * N + n0 + (F.lane & 31)]; }
            asm volatile("s_waitcnt lgkmcnt(0)" ::: "memory");
            const int c = F.lane & 7;
#pragma unroll
            for (int j = 0; j < 4; ++j) {
                const int n = (F.lane >> 3) + 8 * j; const LAS float* sp = scr + (8 * c) * 33 + n;
                u32x4 o; o.x = pk2(sp[0 * 33], sp[1 * 33]); o.y = pk2(sp[2 * 33], sp[3 * 33]); o.z = pk2(sp[4 * 33], sp[5 * 33]); o.w = pk2(sp[6 * 33], sp[7 * 33]);
                const int col = n0 + n;
                const int row = (isin && col < 512) ? ((col & ~48) | ((col & 16) << 1) | ((col & 32) >> 1)) : col;
                *(u32x4*)(WT + (size_t)row * DM + k0 + 8 * c) = o;
            }
            asm volatile("s_waitcnt lgkmcnt(0)" ::: "memory");
        }
    }
    float* COS = (float*)(F.ws + WS_COS); float* SIN = (float*)(F.ws + WS_SIN);
    for (int i = F.vcu * 512 + F.tid; i < SEQ * 32; i += F.G * 512) {
        const int pos = i >> 5, j = i & 31;
        const float inv = exp2f(-(float)j * (13.287712379549449f / 32.0f));
        const float ang = (float)pos * inv;
        double rev = (double)ang * 0.15915494309189535;
        rev -= __builtin_rint(rev);
        const float rv = (float)rev;
        COS[i] = __builtin_amdgcn_cosf(rv); SIN[i] = __builtin_amdgcn_sinf(rv);
    }
}

template <int MT>
__device__ __forceinline__ void p1_epilogue(f32x4 (&acc)[MT][4], const Frame& F, int row_base, int nt) {
    bf16* PROJ = (bf16*)(F.ws + WS_PROJ);
    const float* COS = (const float*)(F.ws + WS_COS); const float* SIN = (const float*)(F.ws + WS_SIN);
    const int lane = F.lane, wr = F.wave >> 2, wc = F.wave & 3, fr = lane & 15, fq = lane >> 4;
    const float scale = (nt == 1 || nt == 6 || nt == 7) ? 0.125f : 1.0f;
#pragma unroll
    for (int m = 0; m < MT; ++m) {
        const int row = row_base + wr * (16 * MT) + m * 16 + fr;
        if (nt < 2) {
            const int pos = row & (SEQ - 1);
#pragma unroll
            for (int n = 0; n < 2; ++n) {
                const f32x4 c = *(const f32x4*)(COS + pos * 32 + 16 * n + 4 * fq), s = *(const f32x4*)(SIN + pos * 32 + 16 * n + 4 * fq);
                const f32x4 x1 = acc[m][n], x2 = acc[m][n + 2];
                acc[m][n] = x1 * c - x2 * s; acc[m][n + 2] = x1 * s + x2 * c;
            }
        }
        bf16* orow = PROJ + (size_t)row * INW + nt * 256 + wc * 64 + 4 * fq;
#pragma unroll
        for (int n = 0; n < 4; ++n) {
            const f32x4 v = acc[m][n] * scale;
            u32x2 w; w.x = pk2(v.x, v.y); w.y = pk2(v.z, v.w);
            *(u32x2*)(orow + 16 * n) = w;
        }
        asm volatile("" ::: "memory");
    }
}
struct SchedP1 { int vcu, G; __device__ __forceinline__ bool next(int i, pg8::Unit& u) const { const int L = vcu + i * G; if (L >= 512) return false; u.pm = L >> 3; u.pn = L & 7; return true; } };
struct EpiP1 {
    bf16* PROJ; const float* COS; const float* SIN;
    __device__ __forceinline__ void operator()(const f32x4 (&acc)[2][2][4][2], const pg8::Unit& u, int wr, int wc, int fr, int fq) const {
        const float scale = (u.pn == 1 || u.pn == 6 || u.pn == 7) ? 0.125f : 1.0f;
#pragma unroll
        for (int ai = 0; ai < 2; ++ai)
#pragma unroll
            for (int m = 0; m < 4; ++m) {
                const int row = u.pm * 256 + ai * 128 + wr * 64 + m * 16 + fr;
                if (u.pn < 2) {
                    const int pos = row & (SEQ - 1), d0 = 16 * (wc & 1) + 4 * fq;
                    const f32x4 c = *(const f32x4*)(COS + pos * 32 + d0), s = *(const f32x4*)(SIN + pos * 32 + d0);
#pragma unroll
                    for (int bj = 0; bj < 2; ++bj) {
                        const f32x4 x1 = acc[ai][bj][m][0], x2 = acc[ai][bj][m][1];
                        const f32x4 o1 = (x1 * c - x2 * s) * scale, o2 = (x1 * s + x2 * c) * scale;
                        bf16* dst = PROJ + (size_t)row * INW + u.pn * 256 + bj * 128 + (wc >> 1) * 64 + d0;
                        u32x2 w1, w2; w1.x = pk2(o1.x, o1.y); w1.y = pk2(o1.z, o1.w); w2.x = pk2(o2.x, o2.y); w2.y = pk2(o2.z, o2.w);
                        *(u32x2*)dst = w1; *(u32x2*)(dst + 32) = w2;
                    }
                } else {
#pragma unroll
                    for (int bj = 0; bj < 2; ++bj)
#pragma unroll
                        for (int n = 0; n < 2; ++n) {
                            const f32x4 v = acc[ai][bj][m][n] * scale;
                            u32x2 w; w.x = pk2(v.x, v.y); w.y = pk2(v.z, v.w);
                            *(u32x2*)(PROJ + (size_t)row * INW + u.pn * 256 + bj * 128 + wc * 32 + 16 * n + 4 * fq) = w;
                        }
                }
                asm volatile("" ::: "memory");
            }
    }
};
__device__ __forceinline__ void phase1(const Frame& F) {
    const bf16* H0B = (const bf16*)(F.ws + WS_H0B);
    const bf16* WIMG = (const bf16*)(F.ws + WS_WIMG);
    {
        const pg8::Gemm g{H0B, (const bf16*)(F.ws + WS_WT_IN), DM};
        const SchedP1 S{F.vcu, F.G};
        const EpiP1 E{(bf16*)(F.ws + WS_PROJ), (const float*)(F.ws + WS_COS), (const float*)(F.ws + WS_SIN)};
        pg8::gemm_phase<EpiP1, SchedP1>(F.lds, g, S, E);
    }
    unsigned aoff[2]; ring_aoff(aoff, F.tid, DM);
    for (int mt = F.vcu; mt < 256; mt += F.G) {
        f32x4 acc[2][4]; zero_accT<2>(acc);
        gemm_ring<2>(acc, F, H0B + (size_t)mt * 64 * DM, aoff, WIMG + (size_t)(WIMG_IN + 8 * 16) * 16384, DM / 32);
        p1_epilogue<2>(acc, F, mt * 64, 8);
    }
}

__device__ __forceinline__ bf16x8 tr_frag(LAS const unsigned char* a0, LAS const unsigned char* a1) {
    const s16x4 lo = __builtin_amdgcn_ds_read_tr16_b64_v4i16((LAS s16x4*)a0);
    const s16x4 hi = __builtin_amdgcn_ds_read_tr16_b64_v4i16((LAS s16x4*)a1);
    bf16x8 r; r[0] = lo[0]; r[1] = lo[1]; r[2] = lo[2]; r[3] = lo[3]; r[4] = hi[0]; r[5] = hi[1]; r[6] = hi[2]; r[7] = hi[3];
    return r;
}
__device__ __forceinline__ int tr128_off(int row, int col) { return row * 128 + 32 * ((col >> 4) ^ ((row >> 1) & 3)) + 2 * (col & 15); }
__device__ __forceinline__ int tr256_off(int row, int col) { return row * 256 + 32 * ((col >> 4) ^ (row & 7)) + 2 * (col & 15); }
__device__ __forceinline__ bf16x8 pack_p(const f32x4& a, const f32x4& b) {
    u32x4 w; w.x = pk2(a.x, a.y); w.y = pk2(a.z, a.w); w.z = pk2(b.x, b.y); w.w = pk2(b.z, b.w);
    return __builtin_bit_cast(bf16x8, w);
}

__device__ __forceinline__ int t5_bucket(int n) {
    if (n < 16) return n;
    const float ratio = logf((float)n / 16.0f) / 2.0794415416798357f;
    int large = 16 + (int)(ratio * 16.0f);
    return large < 31 ? large : 31;
}
__device__ __forceinline__ void swa_unit(const Frame& F, int su, const float* rel_bias, const float* sinks) {
    LAS unsigned char* lds = F.lds;
    const bf16* PROJ = (const bf16*)(F.ws + WS_PROJ);
    bf16* MIXIN = (bf16*)(F.ws + WS_MIXIN);
    const int tid = F.tid, lane = F.lane, wave = F.wave, fr = lane & 15, fq = lane >> 4;
    const int b = su >> 7, nb = (su >> 1) & 63, kvh = su & 1;
    const int tok_prev = b * SEQ + (nb > 0 ? nb - 1 : 0) * 128, tok_cur = b * SEQ + nb * 128;
    constexpr int L_K = 0, L_V = 32768, L_BT = 65536;
#pragma unroll
    for (int i = 0; i < 4; ++i) {
        const int p = tid + 512 * i, row = p >> 3, pc = p & 7;
        const int tok = (row < 128 ? tok_prev + row : tok_cur + row - 128);
        const bf16* src = PROJ + (size_t)tok * INW;
        const int lck = pc ^ (row & 7);
        __builtin_amdgcn_global_load_lds((const unsigned*)(src + 2048 + kvh * 64 + lck * 8), (LAS unsigned*)(lds + L_K + wave * 1024 + i * 8192), 16, 0, 0);
        const int vcol = 16 * ((pc >> 1) ^ ((row >> 1) & 3)) + 8 * (pc & 1);
        __builtin_amdgcn_global_load_lds((const unsigned*)(src + 2176 + kvh * 64 + vcol), (LAS unsigned*)(lds + L_V + wave * 1024 + i * 8192), 16, 0, 0);
    }
    {
        const int g = tid >> 7, dist = tid & 127;
        ((LAS float*)(lds + L_BT))[tid] = rel_bias[t5_bucket(dist) * 8 + kvh * 4 + g];
    }
    BLOCK_SYNC();
#pragma unroll 1
    for (int task = wave; task < 32; task += 8) {
        const int g = task >> 3, a = task & 7, nj0 = a & ~1, head = kvh * 4 + g;
        const float sink = sinks[head];
        LAS const float* bt = (LAS const float*)(lds + L_BT) + g * 128;
        const int i = a * 16 + fr;
        bf16x8 qf[2];
#pragma unroll
        for (int kk = 0; kk < 2; ++kk)
            qf[kk] = *(const bf16x8*)(PROJ + (size_t)(tok_cur + i) * INW + 1536 + head * 64 + kk * 32 + fq * 8);
        f32x4 s[10];
#pragma unroll
        for (int nl = 0; nl < 10; ++nl) {
            s[nl] = (f32x4){0.f, 0.f, 0.f, 0.f};
            const int krow = 16 * (nj0 + nl) + fr;
#pragma unroll
            for (int kk = 0; kk < 2; ++kk) {
                const bf16x8 kf = *(LAS const bf16x8*)(lds + L_K + krow * 128 + (((kk * 4 + fq) ^ (fr & 7)) << 4));
                s[nl] = __builtin_amdgcn_mfma_f32_16x16x32_bf16(kf, qf[kk], s[nl], 0, 0, 0);
            }
        }
        float m = sink;
#pragma unroll
        for (int nl = 0; nl < 10; ++nl)
#pragma unroll
            for (int j = 0; j < 4; ++j) {
                const int jp = 16 * (nj0 + nl) + 4 * fq + j;
                const int dist = i + 128 - jp;
                const bool ok = (dist >= 0) && (dist < 128) && (nb > 0 || jp >= 128);
                const float v = ok ? s[nl][j] + bt[dist & 127] : -INFINITY;
                s[nl][j] = v; m = fmaxf(m, v);
            }
        m = fmaxf(m, __shfl_xor(m, 16)); m = fmaxf(m, __shfl_xor(m, 32));
        float d = 0.f;
#pragma unroll
        for (int nl = 0; nl < 10; ++nl)
#pragma unroll
            for (int j = 0; j < 4; ++j) { const float p = __expf(s[nl][j] - m); s[nl][j] = p; d += p; }
        d += __shfl_xor(d, 16); d += __shfl_xor(d, 32);
        const float inv = 1.0f / (d + __expf(sink - m));
        f32x4 o[4];
#pragma unroll
        for (int ne = 0; ne < 4; ++ne) o[ne] = (f32x4){0.f, 0.f, 0.f, 0.f};
#pragma unroll
        for (int ks = 0; ks < 5; ++ks) {
            const bf16x8 pf = pack_p(s[2 * ks], s[2 * ks + 1]);
            const int r0 = 16 * (nj0 + 2 * ks) + 4 * fq + (fr >> 2);
#pragma unroll
            for (int ne = 0; ne < 4; ++ne) {
                const bf16x8 vf = tr_frag(lds + L_V + tr128_off(r0, 16 * ne) + 8 * (fr & 3), lds + L_V + tr128_off(r0 + 16, 16 * ne) + 8 * (fr & 3));
                o[ne] = __builtin_amdgcn_mfma_f32_16x16x32_bf16(vf, pf, o[ne], 0, 0, 0);
            }
        }
        bf16* orow = MIXIN + (size_t)(tok_cur + i) * DM + 512 + head * 64 + 4 * fq;
#pragma unroll
        for (int ne = 0; ne < 4; ++ne) {
            const f32x4 v = o[ne] * inv;
            u32x2 w; w.x = pk2(v.x, v.y); w.y = pk2(v.z, v.w);
            *(u32x2*)(orow + 16 * ne) = w;
        }
    }
    BLOCK_SYNC();
}

__device__ __forceinline__ float ret_log2gamma(int h) { return log2f(1.0f - exp2f(-5.0f - (float)h)); }
__device__ __forceinline__ void stage_v256(const Frame& F, const bf16* PROJ, int tok0, int h, int L_V) {
#pragma unroll
    for (int i = 0; i < 4; ++i) {
        const int p = F.tid + 512 * i, row = p >> 4, pc = p & 15;
        const int col = 16 * ((pc >> 1) ^ (row & 7)) + 8 * (pc & 1);
        __builtin_amdgcn_global_load_lds((const unsigned*)(PROJ + (size_t)(tok0 + row) * INW + 512 + h * 128 + col), (LAS unsigned*)(F.lds + L_V + F.wave * 1024 + i * 8192), 16, 0, 0);
    }
}
__device__ __forceinline__ void kv_unit(const Frame& F, int ku) {
    LAS unsigned char* lds = F.lds;
    const bf16* PROJ = (const bf16*)(F.ws + WS_PROJ);
    float* KVT = (float*)(F.ws + WS_KVT);
    const int tid = F.tid, lane = F.lane, wave = F.wave, fr = lane & 15, fq = lane >> 4;
    const int b = ku >> 8, n = (ku >> 2) & 63, h = ku & 3;
    const int tok0 = b * SEQ + n * 128;
    constexpr int L_K = 0, L_V = 16384;
    const float l2g = ret_log2gamma(h);
    stage_v256(F, PROJ, tok0, h, L_V);
#pragma unroll
    for (int i = 0; i < 2; ++i) {
        const int p = tid + 512 * i, row = p >> 3, pc = p & 7;
        const int col = 16 * ((pc >> 1) ^ ((row >> 1) & 3)) + 8 * (pc & 1);
        const u32x4 kv = *(const u32x4*)(PROJ + (size_t)(tok0 + row) * INW + 256 + h * 64 + col);
        const float z = exp2f((float)(127 - row) * l2g);
        u32x4 w;
        w.x = pk2(bflo(kv.x) * z, bfhi(kv.x) * z); w.y = pk2(bflo(kv.y) * z, bfhi(kv.y) * z);
        w.z = pk2(bflo(kv.z) * z, bfhi(kv.z) * z); w.w = pk2(bflo(kv.w) * z, bfhi(kv.w) * z);
        *(LAS u32x4*)(lds + L_K + p * 16) = w;
    }
    BLOCK_SYNC();
    const int ne = wave;
    f32x4 acc[4];
#pragma unroll
    for (int nd = 0; nd < 4; ++nd) acc[nd] = (f32x4){0.f, 0.f, 0.f, 0.f};
#pragma unroll
    for (int ks = 0; ks < 4; ++ks) {
        const int r0 = 32 * ks + 4 * fq + (fr >> 2);
        const bf16x8 vf = tr_frag(lds + L_V + tr256_off(r0, 16 * ne) + 8 * (fr & 3), lds + L_V + tr256_off(r0 + 16, 16 * ne) + 8 * (fr & 3));
#pragma unroll
        for (int nd = 0; nd < 4; ++nd) {
            const bf16x8 kf = tr_frag(lds + L_K + tr128_off(r0, 16 * nd) + 8 * (fr & 3), lds + L_K + tr128_off(r0 + 16, 16 * nd) + 8 * (fr & 3));
            acc[nd] = __builtin_amdgcn_mfma_f32_16x16x32_bf16(kf, vf, acc[nd], 0, 0, 0);
        }
    }
    float* dst = KVT + (size_t)ku * 8192 + (16 * ne + fr) * 64 + 4 * fq;
#pragma unroll
    for (int nd = 0; nd < 4; ++nd) *(f32x4*)(dst + 16 * nd) = acc[nd];
    BLOCK_SYNC();
}

__device__ __forceinline__ void phase_scan(const Frame& F) {
    const float* KVT = (const float*)(F.ws + WS_KVT);
    bf16* ST = (bf16*)(F.ws + WS_STATE);
    for (int gid = F.vcu * 512 + F.tid; gid < 65536; gid += F.G * 512) {
        const int b = gid >> 15, h = (gid >> 13) & 3, ed = gid & 8191;
        const float cd = exp2f(128.0f * ret_log2gamma(h));
        float s = 0.f;
        const size_t base = (size_t)b * 64 * 4 * 8192 + (size_t)h * 8192 + ed;
#pragma unroll 8
        for (int n = 0; n < 64; ++n) {
            const size_t idx = base + (size_t)n * 4 * 8192;
            const float kv = KVT[idx];
            ST[idx] = (bf16)(pk2(s, 0.f) & 0xffffu);
            s = s * cd + kv;
        }
    }
}

__device__ __forceinline__ void ret_unit(const Frame& F, int ku) {
    LAS unsigned char* lds = F.lds;
    const bf16* PROJ = (const bf16*)(F.ws + WS_PROJ);
    const bf16* ST = (const bf16*)(F.ws + WS_STATE);
    bf16* MIXIN = (bf16*)(F.ws + WS_MIXIN);
    const int tid = F.tid, lane = F.lane, w = F.wave, fr = lane & 15, fq = lane >> 4;
    const int b = ku >> 8, n = (ku >> 2) & 63, h = ku & 3;
    const int tok0 = b * SEQ + n * 128;
    constexpr int L_K = 0, L_V = 16384;
    const float l2g = ret_log2gamma(h);
    stage_v256(F, PROJ, tok0, h, L_V);
#pragma unroll
    for (int i = 0; i < 2; ++i) {
        const int p = tid + 512 * i, row = p >> 3, pc = p & 7;
        const int lck = pc ^ (row & 7);
        __builtin_amdgcn_global_load_lds((const unsigned*)(PROJ + (size_t)(tok0 + row) * INW + 256 + h * 64 + lck * 8), (LAS unsigned*)(lds + L_K + w * 1024 + i * 8192), 16, 0, 0);
    }
    const int i_row = 16 * w + fr;
    const size_t tok = (size_t)tok0 + i_row;
    bf16x8 qf[2];
#pragma unroll
    for (int kk = 0; kk < 2; ++kk) qf[kk] = *(const bf16x8*)(PROJ + tok * INW + h * 64 + kk * 32 + fq * 8);
    f32x4 o[8];
#pragma unroll
    for (int ne = 0; ne < 8; ++ne) o[ne] = (f32x4){0.f, 0.f, 0.f, 0.f};
    const bf16* stb = ST + (size_t)ku * 8192;
#pragma unroll
    for (int ne = 0; ne < 8; ++ne)
#pragma unroll
        for (int kk = 0; kk < 2; ++kk) {
            const bf16x8 sf = *(const bf16x8*)(stb + (16 * ne + fr) * 64 + kk * 32 + fq * 8);
            o[ne] = __builtin_amdgcn_mfma_f32_16x16x32_bf16(sf, qf[kk], o[ne], 0, 0, 0);
        }
    const float xi = exp2f((float)(i_row + 1) * l2g);
#pragma unroll
    for (int ne = 0; ne < 8; ++ne) o[ne] = o[ne] * xi;
    BLOCK_SYNC();
    f32x4 s[8];
#pragma unroll
    for (int nj = 0; nj < 8; ++nj) {
        s[nj] = (f32x4){0.f, 0.f, 0.f, 0.f};
        if (nj <= w) {
#pragma unroll
            for (int kk = 0; kk < 2; ++kk) {
                const bf16x8 kf = *(LAS const bf16x8*)(lds + L_K + (16 * nj + fr) * 128 + (((kk * 4 + fq) ^ (fr & 7)) << 4));
                s[nj] = __builtin_amdgcn_mfma_f32_16x16x32_bf16(kf, qf[kk], s[nj], 0, 0, 0);
            }
#pragma unroll
            for (int j = 0; j < 4; ++j) {
                const int jj = 16 * nj + 4 * fq + j;
                const int diff = i_row - jj;
                s[nj][j] = diff >= 0 ? s[nj][j] * exp2f((float)diff * l2g) : 0.f;
            }
        }
    }
#pragma unroll
    for (int ks = 0; ks < 4; ++ks) {
        if (2 * ks <= w) {
            const bf16x8 pf = pack_p(s[2 * ks], s[2 * ks + 1]);
            const int r0 = 32 * ks + 4 * fq + (fr >> 2);
#pragma unroll
            for (int ne = 0; ne < 8; ++ne) {
                const bf16x8 vf = tr_frag(lds + L_V + tr256_off(r0, 16 * ne) + 8 * (fr & 3), lds + L_V + tr256_off(r0 + 16, 16 * ne) + 8 * (fr & 3));
                o[ne] = __builtin_amdgcn_mfma_f32_16x16x32_bf16(vf, pf, o[ne], 0, 0, 0);
            }
        }
    }
    float sm = 0.f;
#pragma unroll
    for (int ne = 0; ne < 8; ++ne) sm += (o[ne].x + o[ne].y) + (o[ne].z + o[ne].w);
    sm += __shfl_xor(sm, 16); sm += __shfl_xor(sm, 32);
    const float mean = sm * (1.f / 128.f);
    float sq = 0.f;
#pragma unroll
    for (int ne = 0; ne < 8; ++ne) { o[ne] = o[ne] - mean; sq += (o[ne].x * o[ne].x + o[ne].y * o[ne].y) + (o[ne].z * o[ne].z + o[ne].w * o[ne].w); }
    sq += __shfl_xor(sq, 16); sq += __shfl_xor(sq, 32);
    const float rstd = 1.0f / sqrtf(sq * (1.f / 128.f) + 1e-6f);
    const bf16* grow = PROJ + tok * INW + 1024 + h * 128 + 4 * fq;
    bf16* orow = MIXIN + tok * DM + h * 128 + 4 * fq;
#pragma unroll
    for (int ne = 0; ne < 8; ++ne) {
        const u32x2 gg = *(const u32x2*)(grow + 16 * ne);
        const float g0 = bflo(gg.x), g1 = bfhi(gg.x), g2 = bflo(gg.y), g3 = bfhi(gg.y);
        const f32x4 v = o[ne] * rstd;
        const float y0 = v.x * g0 / (1.f + __expf(-g0)), y1 = v.y * g1 / (1.f + __expf(-g1)), y2 = v.z * g2 / (1.f + __expf(-g2)), y3 = v.w * g3 / (1.f + __expf(-g3));
        u32x2 wv; wv.x = pk2(y0, y1); wv.y = pk2(y2, y3);
        *(u32x2*)(orow + 16 * ne) = wv;
    }
    BLOCK_SYNC();
}

struct SchedP5 { int vcu, G; __device__ __forceinline__ bool next(int i, pg8::Unit& u) const { const int L = vcu + i * G; if (L >= 256) return false; u.pm = L >> 2; u.pn = L & 3; return true; } };
struct EpiP5 {
    const bf16* H0B; bf16* PRE1;
    __device__ __forceinline__ void operator()(const f32x4 (&acc)[2][2][4][2], const pg8::Unit& u, int wr, int wc, int fr, int fq) const {
#pragma unroll
        for (int ai = 0; ai < 2; ++ai)
#pragma unroll
            for (int m = 0; m < 4; ++m) {
                const size_t row = (size_t)(u.pm * 256 + ai * 128 + wr * 64 + m * 16 + fr);
#pragma unroll
                for (int bj = 0; bj < 2; ++bj)
#pragma unroll
                    for (int n = 0; n < 2; ++n) {
                        const size_t off = row * DM + u.pn * 256 + bj * 128 + wc * 32 + 16 * n + 4 * fq;
                        const u32x2 hh = *(const u32x2*)(H0B + off);
                        f32x4 v = acc[ai][bj][m][n];
                        v.x += ALPHA * bflo(hh.x); v.y += ALPHA * bfhi(hh.x); v.z += ALPHA * bflo(hh.y); v.w += ALPHA * bfhi(hh.y);
                        u32x2 pw; pw.x = pk2(v.x, v.y); pw.y = pk2(v.z, v.w);
                        *(u32x2*)(PRE1 + off) = pw;
                    }
                asm volatile("" ::: "memory");
            }
    }
};
__device__ __forceinline__ void phase_outproj(const Frame& F) {
    const pg8::Gemm g{(const bf16*)(F.ws + WS_MIXIN), (const bf16*)(F.ws + WS_WT_OUT), DM};
    const SchedP5 S{F.vcu, F.G};
    const EpiP5 E{(const bf16*)(F.ws + WS_H0B), (bf16*)(F.ws + WS_PRE1)};
    pg8::gemm_phase<EpiP5, SchedP5>(F.lds, g, S, E);
}

__device__ __forceinline__ unsigned fkey(float f) { const unsigned u = __float_as_uint(f); return u ^ ((u >> 31) ? 0xffffffffu : 0x80000000u); }
__device__ __forceinline__ int lanes_below(unsigned long long m) { return (int)__builtin_amdgcn_mbcnt_hi((unsigned)(m >> 32), __builtin_amdgcn_mbcnt_lo((unsigned)m, 0u)); }
__device__ __forceinline__ void phase_router(const Frame& F, const float* g, const float* bb, const float* w_router, const float* rbias) {
    LAS unsigned char* lds = F.lds;
    const bf16* PRE1 = (const bf16*)(F.ws + WS_PRE1);
    bf16* H1B = (bf16*)(F.ws + WS_H1B);
    unsigned* gcnt = (unsigned*)(F.ws + WS_CTL) + CW_CNT;
    u32x2* LIST2 = (u32x2*)(F.ws + WS_LIST2);
    const int tid = F.tid, lane = F.lane, wave = F.wave, wr = wave >> 2, wc = wave & 3, fr = lane & 15, fq = lane >> 4;
    LAS float* selw = (LAS float*)(lds + L_TAB + TB_SELW);
    LAS int* hist = (LAS int*)(lds + L_TAB + TB_HIST);
    LAS int* basee = (LAS int*)(lds + L_TAB + TB_BASE);
    LAS int* sel = (LAS int*)(lds + L_TAB + TB_SEL);
    for (int mt = F.vcu; mt < 256; mt += F.G) {
        const int row0 = mt * 64;
        asm volatile("" ::: "memory");
        {
            f32x4 gv[4], bv[4];
#pragma unroll
            for (int c = 0; c < 4; ++c) { gv[c] = *(const f32x4*)(g + 4 * lane + 256 * c); bv[c] = *(const f32x4*)(bb + 4 * lane + 256 * c); }
#pragma unroll 1
            for (int batch = 0; batch < 2; ++batch) {
                f32x4 v[4][4];
#pragma unroll
                for (int r = 0; r < 4; ++r)
#pragma unroll
                    for (int c = 0; c < 4; ++c) { const u32x2 pw = *(const u32x2*)(PRE1 + (size_t)(row0 + wave * 8 + batch * 4 + r) * DM + 4 * lane + 256 * c); v[r][c] = (f32x4){bflo(pw.x), bfhi(pw.x), bflo(pw.y), bfhi(pw.y)}; }
#pragma unroll
                for (int r = 0; r < 4; ++r) {
                    float s = 0.f;
#pragma unroll
                    for (int c = 0; c < 4; ++c) s += (v[r][c].x + v[r][c].y) + (v[r][c].z + v[r][c].w);
                    const float mean = wave_sum(s) * (1.f / DM); float s2 = 0.f;
#pragma unroll
                    for (int c = 0; c < 4; ++c) { v[r][c] = v[r][c] - mean; s2 += (v[r][c].x * v[r][c].x + v[r][c].y * v[r][c].y) + (v[r][c].z * v[r][c].z + v[r][c].w * v[r][c].w); }
                    const float rstd = 1.f / sqrtf(wave_sum(s2) * (1.f / DM) + 1e-5f);
                    bf16* orow = H1B + (size_t)(row0 + wave * 8 + batch * 4 + r) * DM + 4 * lane;
#pragma unroll
                    for (int c = 0; c < 4; ++c) {
                        const f32x4 y = v[r][c] * rstd * gv[c] + bv[c];
                        u32x2 wv; wv.x = pk2(y.x, y.y); wv.y = pk2(y.z, y.w);
                        *(u32x2*)(orow + 256 * c) = wv;
                    }
                }
            }
        }
        if (tid < 256) hist[tid] = 0;
        BLOCK_SYNC();
        asm volatile("" ::: "memory");
        unsigned aoff[2]; ring_aoff(aoff, tid, DM);
        f32x4 acc[2][4]; zero_accT<2>(acc);
        gemm_ring<2>(acc, F, H1B + (size_t)row0 * DM, aoff, (const bf16*)(F.ws + WS_WIMG) + (size_t)WIMG_RT * 16384, DM / 32);
        LAS float* sc = (LAS float*)lds;
#pragma unroll
        for (int m = 0; m < 2; ++m) {
            const int row = wr * 32 + m * 16 + fr;
#pragma unroll
            for (int n = 0; n < 4; ++n) {
                f32x4 v = acc[m][n];
                v.x = 1.f / (1.f + __expf(-v.x)); v.y = 1.f / (1.f + __expf(-v.y)); v.z = 1.f / (1.f + __expf(-v.z)); v.w = 1.f / (1.f + __expf(-v.w));
                *(LAS f32x4*)(sc + row * 260 + wc * 64 + n * 16 + 4 * fq) = v;
            }
        }
        BLOCK_SYNC();
        asm volatile("" ::: "memory");
        const f32x4 rb = *(const f32x4*)(rbias + 4 * lane);
        const int grp = lane >> 3;
#pragma unroll 1
        for (int r = 0; r < 8; ++r) {
            const int rl = wave * 8 + r;
            const f32x4 v = *(LAS const f32x4*)(sc + rl * 260 + 4 * lane);
            const f32x4 ch = v + rb;
            float a1 = fmaxf(ch.x, ch.y), a2 = fminf(ch.x, ch.y);
            { const float b1 = fmaxf(ch.z, ch.w), b2 = fminf(ch.z, ch.w); const float n1 = fmaxf(a1, b1), n2 = fmaxf(fminf(a1, b1), fmaxf(a2, b2)); a1 = n1; a2 = n2; }
#pragma unroll
            for (int o = 1; o < 8; o <<= 1) {
                const float b1 = __shfl_xor(a1, o), b2 = __shfl_xor(a2, o);
                const float n1 = fmaxf(a1, b1), n2 = fmaxf(fminf(a1, b1), fmaxf(a2, b2));
                a1 = n1; a2 = n2;
            }
            const float gsum = a1 + a2;
            int rank = 0;
#pragma unroll
            for (int j = 0; j < 8; ++j) { const float sj = __shfl(gsum, 8 * j); rank += (sj > gsum || (sj == gsum && j < grp)) ? 1 : 0; }
            const bool gsel = rank < 4;
            unsigned key[4];
            key[0] = gsel ? fkey(ch.x) : 0u; key[1] = gsel ? fkey(ch.y) : 0u; key[2] = gsel ? fkey(ch.z) : 0u; key[3] = gsel ? fkey(ch.w) : 0u;
            unsigned tau = 0u;
#pragma unroll 1
            for (int bit = 31; bit >= 0; --bit) {
                const unsigned cand = tau | (1u << bit);
                const int cnt = __popcll(__ballot(key[0] >= cand)) + __popcll(__ballot(key[1] >= cand)) + __popcll(__ballot(key[2] >= cand)) + __popcll(__ballot(key[3] >= cand));
                if (cnt >= 8) tau = cand;
            }
            unsigned long long gm[4], em[4];
            int ngt = 0;
#pragma unroll
            for (int j = 0; j < 4; ++j) { gm[j] = __ballot(key[j] > tau); em[j] = __ballot(key[j] == tau); ngt += __popcll(gm[j]); }
            const int need = 8 - ngt;
            int eqb = lanes_below(em[0]) + lanes_below(em[1]) + lanes_below(em[2]) + lanes_below(em[3]);
            bool s[4];
#pragma unroll
            for (int j = 0; j < 4; ++j) { const bool eq = key[j] == tau; s[j] = (key[j] > tau) || (eq && eqb < need); eqb += eq ? 1 : 0; }
            unsigned long long sm[4];
#pragma unroll
            for (int j = 0; j < 4; ++j) sm[j] = __ballot(s[j]);
            int kpos = lanes_below(sm[0]) + lanes_below(sm[1]) + lanes_below(sm[2]) + lanes_below(sm[3]);
            const float wl = (s[0] ? v.x : 0.f) + (s[1] ? v.y : 0.f) + (s[2] ? v.z : 0.f) + (s[3] ? v.w : 0.f);
            const float wscale = 2.5f / wave_sum(wl);
#pragma unroll
            for (int j = 0; j < 4; ++j) {
                if (s[j]) {
                    selw[rl * 8 + kpos] = v[j] * wscale;
                    const int e = 4 * lane + j;
                    const int lpos = __hip_atomic_fetch_add(hist + e, 1, __ATOMIC_RELAXED, __HIP_MEMORY_SCOPE_WORKGROUP);
                    sel[rl * 8 + kpos] = (e << 16) | lpos;
                    ++kpos;
                }
            }
        }
        BLOCK_SYNC();
        if (tid < 256) { const int c = hist[tid]; basee[tid] = c > 0 ? (int)__hip_atomic_fetch_add(gcnt + tid, (unsigned)c, __ATOMIC_RELAXED, __HIP_MEMORY_SCOPE_AGENT) : 0; }
        BLOCK_SYNC();
        {
            const int sv = sel[tid], e = sv >> 16, lpos = sv & 0xffff;
            u32x2 ent; ent.x = (unsigned)(mt * 512 + tid); ent.y = __float_as_uint(selw[tid]);
            LIST2[(size_t)e * LCAP + basee[e] + lpos] = ent;
        }
        BLOCK_SYNC();
    }
}

__device__ __forceinline__ void phase_moe(const Frame& F, const float* w_gate, const float* w_up, const float* w_down, const float* ws_gate, const float* ws_up, const float* ws_down) {
    LAS unsigned char* lds = F.lds;
    const bf16* H1B = (const bf16*)(F.ws + WS_H1B);
    const unsigned* gcnt = (const unsigned*)(F.ws + WS_CTL) + CW_CNT;
    const u32x2* LIST2 = (const u32x2*)(F.ws + WS_LIST2);
    bf16* YROWS = (bf16*)(F.ws + WS_YROWS);
    const int tid = F.tid, lane = F.lane, wave = F.wave, wr = wave >> 2, wc = wave & 3, fr = lane & 15, fq = lane >> 4;
    const int lchunk = (tid & 7) ^ ((tid >> 3) & 7);
    LAS int* prefix = (LAS int*)(lds + L_TAB + TB_PREFIX);
    LAS int* rtok = (LAS int*)(lds + L_TAB + TB_RTOK);
    LAS int* ryrow = (LAS int*)(lds + L_TAB + TB_RYROW);
    LAS float* rw = (LAS float*)(lds + L_TAB + TB_RW);
    LAS int* cntl = (LAS int*)(lds + L_TAB + TB_CNT);
    if (tid < 256) cntl[tid] = (int)gcnt[tid];
    if (wave == 0) {
        int c4[4], loc = 0;
#pragma unroll
        for (int j = 0; j < 4; ++j) { c4[j] = ((int)gcnt[lane * 4 + j] + 127) >> 7; loc += c4[j]; }
        int incl = loc;
#pragma unroll
        for (int o = 1; o < 64; o <<= 1) { const int t = __shfl_up(incl, o); if (lane >= o) incl += t; }
        int run = incl - loc;
#pragma unroll
        for (int j = 0; j < 4; ++j) { prefix[lane * 4 + j] = run; run += c4[j]; }
        if (lane == 63) prefix[256] = run;
    }
    BLOCK_SYNC();
    const int R = prefix[256];
    const int nr = (R > F.vcu) ? (R - F.vcu + F.G - 1) / F.G : 0;
    const int base = R % F.G, L = F.G - base;
    const bool lightonly = L >= 64;
    const int sd = (F.vcu - base + F.G) % F.G;
    const int ns = lightonly ? ((sd < L && sd < 128) ? (128 - sd + L - 1) / L : 0) : ((sd < 128) ? 1 : 0);
    const int sstep = lightonly ? L : F.G;
#define MOE_ITEM(it_, e_, tile_) do { if ((it_) >= nr) { e_ = 256; tile_ = sd + ((it_) - nr) * sstep; } else { const int u_ = F.vcu + (it_) * F.G; int lo_ = 0, hi_ = 255; \
        while (lo_ < hi_) { const int mid_ = (lo_ + hi_ + 1) >> 1; if (prefix[mid_] <= u_) lo_ = mid_; else hi_ = mid_ - 1; } e_ = lo_; tile_ = u_ - prefix[lo_]; } } while (0)
#define MOE_FETCH(e_, tile_, tok_, yr_, wv_) do { tok_ = 0; yr_ = -1; wv_ = 0.f; const int ft_ = F.wave * 64 + fresh_lane(); if (ft_ < 128) { const int idx_ = (tile_) * 128 + ft_; \
        if ((e_) == 256) { tok_ = idx_; yr_ = idx_ * 9 + 8; wv_ = 1.0f; } \
        else if (idx_ < cntl[e_]) { const u32x2 en_ = LIST2[(size_t)(e_) * LCAP + idx_]; tok_ = (int)(en_.x >> 3); yr_ = tok_ * 9 + (int)(en_.x & 7u); wv_ = __uint_as_float(en_.y); } } } while (0)
    int ptok = 0, pyr = -1; float pwv = 0.f;
    if (nr + ns > 0) { int e0, t0; MOE_ITEM(0, e0, t0); MOE_FETCH(e0, t0, ptok, pyr, pwv); }
    for (int it = 0; it < nr + ns; ++it) {
        int e, tile;
        MOE_ITEM(it, e, tile);
        const int otid = F.wave * 64 + fresh_lane();
        Frame F2 = F; F2.tid = otid; F2.lane = otid & 63;
        const int lane = F2.lane, fr = lane & 15, fq = lane >> 4;
        const int lchunk = (otid & 7) ^ ((otid >> 3) & 7);
        if (otid < 128) { rtok[otid] = ptok; ryrow[otid] = pyr; rw[otid] = pwv; }
        BLOCK_SYNC();
        const float* Wg = (e == 256) ? ws_gate : w_gate + (size_t)e * 262144;
        const float* Wu = (e == 256) ? ws_up : w_up + (size_t)e * 262144;
        const float* Wd = (e == 256) ? ws_down : w_down + (size_t)e * 262144;
        const unsigned ao0 = (unsigned)rtok[otid >> 3] * (unsigned)(DM * 2) + (unsigned)lchunk * 16u, ao1 = (unsigned)rtok[(otid >> 3) + 64] * (unsigned)(DM * 2) + (unsigned)lchunk * 16u;
        const int rot = tile & 3;
#define MOE_EPI1(C0) do { const int ol_ = fresh_lane(); const int efr = ol_ & 15, efq = ol_ >> 4; \
            _Pragma("unroll") for (int m = 0; m < 4; ++m) { const int row = wr * 64 + m * 16 + efr; \
                _Pragma("unroll") for (int n = 0; n < 2; ++n) { const f32x4 gt = acc[m][n], up = acc[m][n + 2]; \
                    const float a0 = gt.x / (1.f + __expf(-gt.x)) * up.x, a1 = gt.y / (1.f + __expf(-gt.y)) * up.y, a2 = gt.z / (1.f + __expf(-gt.z)) * up.z, a3 = gt.w / (1.f + __expf(-gt.w)) * up.w; \
                    const int col = (C0) + 32 * wc + 16 * n + 4 * efq, kt = col >> 6, c64 = col & 63; \
                    u32x2 wv; wv.x = pk2(a0, a1); wv.y = pk2(a2, a3); \
                    *(LAS u32x2*)(lds + a_tile_off<true>(kt) + row * 128 + (((c64 >> 3) ^ (row & 7)) << 4) + (c64 & 7) * 2) = wv; } } } while (0)
#define MOE_EPI2(NC) do { const int ol_ = fresh_lane(); const int efr = ol_ & 15, efq = ol_ >> 4; \
            _Pragma("unroll") for (int m = 0; m < 4; ++m) { const int row = wr * 64 + m * 16 + efr; const int yr = ryrow[row]; const float wv = rw[row]; \
                if (yr >= 0) { bf16* dst = YROWS + (size_t)yr * DM + (NC) * 256 + wc * 64 + 16 * efq; u32x4 w0, w1; \
                    w0.x = pk2(acc[m][0].x * wv, acc[m][0].y * wv); w0.y = pk2(acc[m][0].z * wv, acc[m][0].w * wv); \
                    w0.z = pk2(acc[m][1].x * wv, acc[m][1].y * wv); w0.w = pk2(acc[m][1].z * wv, acc[m][1].w * wv); \
                    w1.x = pk2(acc[m][2].x * wv, acc[m][2].y * wv); w1.y = pk2(acc[m][2].z * wv, acc[m][2].w * wv); \
                    w1.z = pk2(acc[m][3].x * wv, acc[m][3].y * wv); w1.w = pk2(acc[m][3].z * wv, acc[m][3].w * wv); \
                    *(u32x4*)dst = w0; *(u32x4*)(dst + 8) = w1; } } } while (0)
#define MOE_UNIT(LT) do { \
            f32x4 r0[8], r1[8]; \
            const int s = 4 * lane, sl = s & 63; \
            const float* bpA = ((s & 32) ? Wu : Wg) + 32 * (s >> 6) + (s & 31); \
            const float* bpD = Wd + (s & 192) + 16 * ((sl >> 2) & 3) + 4 * (sl >> 4) + (sl & 3); \
            f32x4 acc[4][4]; zero_acc(acc); \
            gemm_chain<false, DM / 64, 256, LT, false, 256, DM / 64>(acc, F2, r0, r1, (const char*)H1B, ao0, ao1, bpA, bpA + 128, rot, 0); \
            MOE_EPI1(0); \
            zero_acc(acc); \
            gemm_chain<false, DM / 64, 256, LT, true, DM, 4>(acc, F2, r0, r1, (const char*)H1B, ao0, ao1, bpA + 128, bpD, rot, 1); \
            MOE_EPI1(128); \
            BLOCK_SYNC(); \
            if (it + 1 < nr + ns) { int e1, t1; MOE_ITEM(it + 1, e1, t1); MOE_FETCH(e1, t1, ptok, pyr, pwv); }       \
            zero_acc(acc); \
            gemm_chain<true, 4, DM, LT, true, DM, 4>(acc, F2, r0, r1, nullptr, 0u, 0u, bpD, bpD + 256, rot, 0); \
            MOE_EPI2(0); \
            zero_acc(acc); \
            gemm_chain<true, 4, DM, LT, true, DM, 4>(acc, F2, r0, r1, nullptr, 0u, 0u, bpD + 256, bpD + 512, rot, 0); \
            MOE_EPI2(1); \
            zero_acc(acc); \
            gemm_chain<true, 4, DM, LT, true, DM, 4>(acc, F2, r0, r1, nullptr, 0u, 0u, bpD + 512, bpD + 768, rot, 0); \
            MOE_EPI2(2); \
            zero_acc(acc); \
            gemm_chain<true, 4, DM, LT, true, 0, 4>(acc, F2, r0, r1, nullptr, 0u, 0u, bpD + 768, bpD + 768, rot, 0); \
            MOE_EPI2(3); } while (0)
        if (wave >= 4) MOE_UNIT(true); else MOE_UNIT(false);
#undef MOE_UNIT
#undef MOE_EPI1
#undef MOE_EPI2
        BLOCK_SYNC();
    }
}

__device__ __forceinline__ void phase_final(const Frame& F, const float* g, const float* b, float* out) {
    const bf16* H1B = (const bf16*)(F.ws + WS_H1B);
    const bf16* YROWS = (const bf16*)(F.ws + WS_YROWS);
    const int gw = F.vcu * 8 + F.wave, NGW = F.G * 8, lane = F.lane;
    f32x4 gv[4], bv[4];
#pragma unroll
    for (int c = 0; c < 2; ++c)
#pragma unroll
        for (int hh = 0; hh < 2; ++hh) { gv[2 * c + hh] = *(const f32x4*)(g + 8 * lane + 512 * c + 4 * hh); bv[2 * c + hh] = *(const f32x4*)(b + 8 * lane + 512 * c + 4 * hh); }
    for (int row = gw; row < T_TOK; row += NGW) {
        float v[16];
#pragma unroll
        for (int c = 0; c < 2; ++c) {
            const u32x4 hv = *(const u32x4*)(H1B + (size_t)row * DM + 8 * lane + 512 * c);
            v[8 * c + 0] = ALPHA * bflo(hv.x); v[8 * c + 1] = ALPHA * bfhi(hv.x); v[8 * c + 2] = ALPHA * bflo(hv.y); v[8 * c + 3] = ALPHA * bfhi(hv.y);
            v[8 * c + 4] = ALPHA * bflo(hv.z); v[8 * c + 5] = ALPHA * bfhi(hv.z); v[8 * c + 6] = ALPHA * bflo(hv.w); v[8 * c + 7] = ALPHA * bfhi(hv.w);
#pragma unroll
            for (int sidx = 0; sidx < 9; ++sidx) {
                const u32x4 yv = *(const u32x4*)(YROWS + ((size_t)row * 9 + sidx) * DM + 8 * lane + 512 * c);
                v[8 * c + 0] += bflo(yv.x); v[8 * c + 1] += bfhi(yv.x); v[8 * c + 2] += bflo(yv.y); v[8 * c + 3] += bfhi(yv.y);
                v[8 * c + 4] += bflo(yv.z); v[8 * c + 5] += bfhi(yv.z); v[8 * c + 6] += bflo(yv.w); v[8 * c + 7] += bfhi(yv.w);
            }
        }
        float s = 0.f;
#pragma unroll
        for (int i = 0; i < 16; ++i) s += v[i];
        const float mean = wave_sum(s) * (1.f / DM); float s2 = 0.f;
#pragma unroll
        for (int i = 0; i < 16; ++i) { v[i] -= mean; s2 += v[i] * v[i]; }
        const float rstd = 1.f / sqrtf(wave_sum(s2) * (1.f / DM) + 1e-5f);
        float* orow = out + (size_t)row * DM + 8 * lane;
#pragma unroll
        for (int c = 0; c < 2; ++c)
#pragma unroll
            for (int hh = 0; hh < 2; ++hh) {
                f32x4 y;
                y.x = v[8 * c + 4 * hh + 0] * rstd; y.y = v[8 * c + 4 * hh + 1] * rstd; y.z = v[8 * c + 4 * hh + 2] * rstd; y.w = v[8 * c + 4 * hh + 3] * rstd;
                y = y * gv[2 * c + hh] + bv[2 * c + hh];
                *(f32x4*)(orow + 512 * c + 4 * hh) = y;
            }
    }
}

__global__ void __launch_bounds__(512, 2) fwd_kernel(Args a) {
    extern __shared__ __attribute__((aligned(16))) unsigned char lds_raw[];
    Frame F;
    F.lds = (LAS unsigned char*)lds_raw;
    F.tid = threadIdx.x; F.lane = F.tid & 63; F.wave = __builtin_amdgcn_readfirstlane(F.tid >> 6);
    F.G = gridDim.x; { const int bx = blockIdx.x; F.vcu = (F.G % 8 == 0) ? (bx % 8) * (F.G / 8) + bx / 8 : bx; }
    F.ws = a.ws;
    volatile LAS unsigned* MISC = (volatile LAS unsigned*)(F.lds + L_TAB + TB_MISC);
    if (F.tid < 16) MISC[F.tid] = 0u;
    __syncthreads();
    unsigned* ctl = (unsigned*)(a.ws + WS_CTL);
    const int lo = a.ph_lo, hi = a.ph_hi;
    XcdBarrier bar; bar.bar = ctl + CW_BAR; bar.x = 0; bar.st = MISC + 8; bar.w0 = 0;
    if (hi - lo > 1) bar = xcd_barrier_post(ctl + CW_BAR, MISC + 8);
    bar.w0 = (F.wave == 0) ? 1 : 0;
#define IN(k) (lo <= (k) && (k) < hi)
#define SEAM(k) do { if (IN(k) && IN((k) + 1)) xcd_barrier(bar); } while (0)
#define FRESH(Fn) Frame Fn = F; Fn.lane = fresh_lane(); Fn.tid = F.wave * 64 + Fn.lane
    if (IN(0)) { FRESH(F0); phase0(F0, a.in[0], a.in[1], a.in[2], a.in[3], a.in[4], a.in[9]); }
    SEAM(0);
    if (IN(1)) { FRESH(F1); phase1(F1); }
    SEAM(1);
    if (IN(2)) {
        FRESH(F2);
        for (int su = F.vcu; su < 256; su += F.G) swa_unit(F2, su, a.in[5], a.in[6]);
        for (int ku = F.vcu; ku < 512; ku += F.G) kv_unit(F2, ku);
    }
    SEAM(2);
    if (IN(3)) { FRESH(F3); phase_scan(F3); }
    SEAM(3);
    if (IN(4)) { FRESH(F4); for (int ku = F.vcu; ku < 512; ku += F.G) ret_unit(F4, ku); }
    SEAM(4);
    if (IN(5)) { FRESH(F5); phase_outproj(F5); }
    SEAM(5);
    if (IN(6)) { FRESH(F6); phase_router(F6, a.in[7], a.in[8], a.in[9], a.in[10]); }
    SEAM(6);
    if (IN(7)) { FRESH(F7); phase_moe(F7, a.in[11], a.in[12], a.in[13], a.in[14], a.in[15], a.in[16]); }
    SEAM(7);
    if (IN(8)) { FRESH(F8); phase_final(F8, a.in[17], a.in[18], a.out); }
#undef FRESH
#undef IN
#undef SEAM
}

extern "C" void kernel_launch(void* const* d_in, const int* in_sizes, int n_in, void* d_out, int out_size, void* d_ws, size_t ws_size, hipStream_t stream) {
    static int grid = 0;
    if (grid == 0) {
        if (n_in != 19 || out_size != T_TOK * DM || ws_size < WS_END) { fprintf(stderr, "kernel_launch: unexpected problem shape (n_in %d out %d ws %zu)\n", n_in, out_size, ws_size); grid = -1; return; }
        int dev = 0, cus = 0, per_cu = 0;
        if (hipGetDevice(&dev) != hipSuccess || hipDeviceGetAttribute(&cus, hipDeviceAttributeMultiprocessorCount, dev) != hipSuccess) { grid = -1; return; }
        if (hipFuncSetAttribute((const void*)fwd_kernel, hipFuncAttributeMaxDynamicSharedMemorySize, LDS_BYTES) != hipSuccess) { fprintf(stderr, "kernel_launch: hipFuncSetAttribute failed\n"); grid = -1; return; }
        if (hipOccupancyMaxActiveBlocksPerMultiprocessor(&per_cu, (const void*)fwd_kernel, 512, LDS_BYTES) != hipSuccess || per_cu < 1)
            fprintf(stderr, "kernel_launch: occupancy query reports %d\n", per_cu);
        (void)hipGetLastError();
        grid = cus;
    }
    if (grid < 0) return;
    (void)hipMemsetAsync((char*)d_ws + WS_CTL, 0, CTL_BYTES, stream);
    Args a{};
    for (int i = 0; i < 19; ++i) a.in[i] = (const float*)d_in[i];
    a.out = (float*)d_out; a.ws = (unsigned char*)d_ws;
    if (MK_N_LAUNCHES == 1) {
        a.ph_lo = 0; a.ph_hi = NPHASE;
        hipLaunchKernelGGL(fwd_kernel, dim3(grid), dim3(512), LDS_BYTES, stream, a);
    } else {
        for (int p = 0; p < NPHASE; ++p) {
            a.ph_lo = p; a.ph_hi = p + 1;
            hipLaunchKernelGGL(fwd_kernel, dim3(grid), dim3(512), LDS_BYTES, stream, a);
        }
    }
}
```

```cpp
#include <hip/hip_runtime.h>
#include <cstdio>
#include <cstdint>

#ifndef MK_N_LAUNCHES
#define MK_N_LAUNCHES 1
#endif

#define LAS __attribute__((address_space(3)))
typedef unsigned short bf16;
typedef short bf16x8 __attribute__((ext_vector_type(8)));
typedef short s16x4 __attribute__((ext_vector_type(4)));
typedef float f32x4 __attribute__((ext_vector_type(4)));
typedef float f32x2 __attribute__((ext_vector_type(2)));
typedef unsigned u32x4 __attribute__((ext_vector_type(4)));
typedef unsigned u32x2 __attribute__((ext_vector_type(2)));
typedef __bf16 bf2_t __attribute__((ext_vector_type(2)));

constexpr int T_TOK = 16384, SEQ = 8192, DM = 1024, INW = 2304, NEXP = 256;
constexpr int NPHASE = 9;
constexpr float ALPHA = 1.189207115002721f;
constexpr int LCAP = 16384;

constexpr size_t MiB = 1u << 20;
constexpr size_t WS_CTL = 0, CTL_BYTES = 1 * MiB;
constexpr size_t WS_COS = 1 * MiB, WS_SIN = 2 * MiB;
constexpr size_t WS_H0B = 4 * MiB;
constexpr size_t WS_PROJ = 36 * MiB;
constexpr size_t WS_MIXIN = 108 * MiB;
constexpr size_t WS_PRE1 = 140 * MiB;
constexpr size_t WS_H1B = 204 * MiB;
constexpr size_t WS_KVT = 236 * MiB;
constexpr size_t WS_STATE = 252 * MiB;
constexpr size_t WS_LISTS = 260 * MiB;
constexpr size_t WS_ROWW = 276 * MiB;
constexpr size_t WS_YROWS = 280 * MiB;
constexpr size_t WS_WIMG = 576 * MiB;
constexpr int WIMG_IN = 0, WIMG_OUT = 144, WIMG_RT = 208, WIMG_N = 224;
constexpr size_t WS_WT_IN = 620 * MiB;
constexpr size_t WS_WT_OUT = 624 * MiB;
constexpr size_t WS_LIST2 = 584 * MiB;
constexpr size_t WS_END = 626 * MiB;
constexpr int CW_BAR = 4096;
constexpr int CW_CNT = 16384;

constexpr int L_BS0 = 0, L_AS0 = 65536, L_ACTLO = 114688, L_TAB = 147456, LDS_BYTES = 163840;
constexpr int TB_MISC = 0;
constexpr int TB_RTOK = 256;
constexpr int TB_RYROW = 768;
constexpr int TB_RW = 1280;
constexpr int TB_PREFIX = 2048;
constexpr int TB_HIST = 4096;
constexpr int TB_BASE = 5120;
constexpr int TB_SEL = 6144;
constexpr int TB_SELW = 10496;
constexpr int TB_CNT = 12544;
constexpr int TB_UNIT = 10240;

__device__ __forceinline__ unsigned pk2(float lo, float hi) { f32x2 v = {lo, hi}; bf2_t r = __builtin_convertvector(v, bf2_t); return __builtin_bit_cast(unsigned, r); }
__device__ __forceinline__ float bflo(unsigned u) { return __uint_as_float(u << 16); }
__device__ __forceinline__ float bfhi(unsigned u) { return __uint_as_float(u & 0xffff0000u); }
__device__ __forceinline__ float wave_sum(float v) {
#pragma unroll
    for (int o = 1; o < 64; o <<= 1) v += __shfl_xor(v, o);
    return v;
}
#define VM_WAIT() asm volatile("s_waitcnt vmcnt(0)" ::: "memory")
#define ALL_WAIT() asm volatile("s_waitcnt vmcnt(0) lgkmcnt(0)" ::: "memory")
#define BLOCK_SYNC() do { ALL_WAIT(); __syncthreads(); } while (0)

__device__ __forceinline__ int fresh_lane() { int l; asm volatile("v_mbcnt_lo_u32_b32 %0, -1, 0\n\tv_mbcnt_hi_u32_b32 %0, -1, %0" : "=v"(l)); return l; }
#define XB_TMO      128
#define XB_XCNT(j)  (256  + 64 * (j))
#define XB_XSUB(j)  (1280 + 64 * (j))
#define XB_XGEN(j)  (2304 + 64 * (j))
#define XB_TOP      3328
#define XB_TOPGEN   3392
#define XCD_BAR_WORDS 3456
#define XB_SPIN_CAP (1u << 18)
__device__ __forceinline__ unsigned xb_ld(unsigned* p)              { return __hip_atomic_load(p, __ATOMIC_RELAXED, __HIP_MEMORY_SCOPE_AGENT); }
__device__ __forceinline__ unsigned xb_add(unsigned* p, unsigned v) { return __hip_atomic_fetch_add(p, v, __ATOMIC_RELAXED, __HIP_MEMORY_SCOPE_AGENT); }
__device__ __forceinline__ unsigned xb_xcc_id() { return (unsigned)__builtin_amdgcn_s_getreg((3 << 11) | 20) & 0xFu; }
#define XB_SPIN(cond, bar) do { unsigned _sp = 0; while (cond) { __builtin_amdgcn_s_sleep(1); \
    if ((++_sp & 255u) == 0u) { if (xb_ld(&(bar)[XB_TMO])) break; if (_sp > XB_SPIN_CAP) { atomicAdd(&(bar)[XB_TMO], 1u); break; } } } } while (0)
struct XcdBarrier { unsigned* bar; unsigned x; volatile LAS unsigned* st; int w0; };
__device__ __forceinline__ XcdBarrier xcd_barrier_post(unsigned* bar, volatile LAS unsigned* st) {
    XcdBarrier b; b.bar = bar; b.x = xb_xcc_id(); b.st = st; b.w0 = 0;
    if (threadIdx.x == 0) (void)xb_add(&bar[XB_XCNT(b.x)], 1u);
    return b;
}
__device__ __forceinline__ void xcd_barrier_complete(unsigned* bar, unsigned x, unsigned& nloc, unsigned& nx) {
    const unsigned G = gridDim.x * gridDim.y * gridDim.z;
    unsigned sum, cnt, mine, sp = 0u;
    for (;;) {
        sum = 0u; cnt = 0u; mine = 0u;
#pragma unroll
        for (unsigned j = 0; j < 16; ++j) { const unsigned c = xb_ld(&bar[XB_XCNT(j)]); sum += c; cnt += (c > 0u) ? 1u : 0u; mine = (j == x) ? c : mine; }
        if (sum == G) break;
        __builtin_amdgcn_s_sleep(1);
        if ((++sp & 255u) == 0u) { if (xb_ld(&bar[XB_TMO])) break; if (sp > XB_SPIN_CAP) { atomicAdd(&bar[XB_TMO], 1u); break; } }
    }
    nloc = mine > 0u ? mine : 1u; nx = cnt > 0u ? cnt : 1u;
}
__device__ __forceinline__ void xcd_barrier(const XcdBarrier& b) {
    asm volatile("s_waitcnt vmcnt(0)" ::: "memory");
    __syncthreads();
    if (b.w0 && fresh_lane() == 0) {
        unsigned* bar = b.bar;
        __builtin_amdgcn_s_waitcnt(0);
        unsigned nloc = b.st[0], nx = b.st[1];
        if (nloc == 0u) { xcd_barrier_complete(bar, b.x, nloc, nx); b.st[0] = nloc; b.st[1] = nx; }
        const unsigned old = xb_add(&bar[XB_XSUB(b.x)], 1u);
        const unsigned gen = old / nloc;
        if (old + 1u == (gen + 1u) * nloc) {
            __builtin_amdgcn_fence(__ATOMIC_RELEASE, "agent");
            asm volatile("s_waitcnt vmcnt(0)" ::: "memory");
            const unsigned og = xb_add(&bar[XB_TOP], 1u);
            const unsigned tg = og / nx;
            if (og + 1u == (tg + 1u) * nx) xb_add(&bar[XB_TOPGEN], 1u);
            else XB_SPIN(xb_ld(&bar[XB_TOPGEN]) == tg, bar);
            __builtin_amdgcn_fence(__ATOMIC_ACQUIRE, "agent");
            xb_add(&bar[XB_XGEN(b.x)], 1u);
            asm volatile("s_waitcnt vmcnt(0)" ::: "memory");
        } else {
            XB_SPIN(xb_ld(&bar[XB_XGEN(b.x)]) == gen, bar);
            __builtin_amdgcn_fence(__ATOMIC_ACQUIRE, "agent");
            asm volatile("s_waitcnt vmcnt(0)" ::: "memory");
        }
    }
    __syncthreads();
}


namespace pg8 {
#define PG8_LAS __attribute__((address_space(3)))
typedef unsigned short bf16_t;
constexpr int BM = 256, BK = 64, HALF = 128, HTB = HALF * BK * 2;
__host__ __device__ __forceinline__ int lds_byte(int r, int c) { const int st = (r >> 4) * 2 + (c >> 5), rr = r & 15, cc = c & 31, ob = rr * 64 + cc * 2; return st * 1024 + (ob ^ (((ob >> 9) & 1) << 5)); }
__host__ __device__ __forceinline__ void stage_rc(int b, int& R, int& C) { const int st = b / 1024, sb = b % 1024, swz = sb ^ (((sb >> 9) & 1) << 5); R = (st >> 1) * 16 + swz / 64; C = (st & 1) * 32 + (swz % 64) / 2; }
struct Unit { int pm, pn; };
struct Gemm { const bf16_t* A; const bf16_t* Bt; int K; };
template <class Epi, class Sched>
__device__ __forceinline__ void gemm_phase(PG8_LAS unsigned char* lds, const Gemm g, const Sched& S, const Epi& E) {
    const int tid = threadIdx.x, wid = __builtin_amdgcn_readfirstlane(tid >> 6), lane = tid & 63, wr = wid >> 2, wc = wid & 3, fr = lane & 15, fq = lane >> 4;
    const int K = g.K, nt = K / BK;
    unsigned voffA[2], voffB[2];
#pragma unroll
    for (int i = 0; i < 2; ++i) { int R, C; stage_rc(tid * 16 + i * 8192, R, C); voffA[i] = (unsigned)(R * K + C) * 2u; voffB[i] = (unsigned)(R * K + C) * 2u; }
    const size_t kstep = (size_t)(BK * 2);
    const size_t hstep = (size_t)HALF * K * 2;
    const size_t tstep = 2 * hstep;
    const unsigned ldsw = (unsigned)wid * 1024u;
    const int aoff = lds_byte(wr * 64 + fr, fq * 8), boff = lds_byte(wc * 32 + fr, fq * 8);
#define PG8_SA(b, h) (((b) * 2 + (h)) * HTB)
#define PG8_SB(b, h) ((4 + (b) * 2 + (h)) * HTB)
#define PG8_STAGE(bufoff, gbase, voff) do { _Pragma("unroll") for (int _i = 0; _i < 2; ++_i) \
        __builtin_amdgcn_global_load_lds((const unsigned*)((const char*)(gbase) + (voff)[_i]), (PG8_LAS unsigned*)(lds + (bufoff) + ldsw + _i * 8192), 16, 0, 0); } while (0)
#define PG8_LDA(dst, b, h) do { _Pragma("unroll") for (int m = 0; m < 4; ++m) _Pragma("unroll") for (int k = 0; k < 2; ++k) dst[m][k] = *(const PG8_LAS bf16x8*)(lds + PG8_SA(b, h) + aoff + m * 2048 + k * 1024); } while (0)
#define PG8_LDB(dst, b, h) do { _Pragma("unroll") for (int n = 0; n < 2; ++n) _Pragma("unroll") for (int k = 0; k < 2; ++k) dst[n][k] = *(const PG8_LAS bf16x8*)(lds + PG8_SB(b, h) + boff + n * 2048 + k * 1024); } while (0)
#define PG8_MMA(ai, bj, At, Bt) do { __builtin_amdgcn_s_setprio(1); _Pragma("unroll") for (int m = 0; m < 4; ++m) _Pragma("unroll") for (int n = 0; n < 2; ++n) _Pragma("unroll") for (int k = 0; k < 2; ++k) \
        acc[ai][bj][m][n] = __builtin_amdgcn_mfma_f32_16x16x32_bf16(Bt[n][k], At[m][k], acc[ai][bj][m][n], 0, 0, 0); __builtin_amdgcn_s_setprio(0); } while (0)
#define PG8_WAIT_V(n) asm volatile("s_waitcnt vmcnt(" #n ")" ::: "memory")
#define PG8_WAIT_L(n) asm volatile("s_waitcnt lgkmcnt(" #n ")" ::: "memory")
#define PG8_BAR __builtin_amdgcn_s_barrier()
#define PG8_SCHED __builtin_amdgcn_sched_barrier(0)
    Unit cur, nxt; int ui = 0;
    if (!S.next(0, cur)) return;
    f32x4 acc[2][2][4][2];
#pragma unroll
    for (int a = 0; a < 2; ++a)
#pragma unroll
        for (int b = 0; b < 2; ++b)
#pragma unroll
            for (int m = 0; m < 4; ++m)
#pragma unroll
                for (int n = 0; n < 2; ++n) acc[a][b][m][n] = (f32x4){0.f, 0.f, 0.f, 0.f};
    bf16x8 At[4][2], B0[2][2], B1[2][2];
    const char* cA = (const char*)g.A + (size_t)cur.pm * tstep; const char* cB = (const char*)g.Bt + (size_t)cur.pn * tstep;
    PG8_STAGE(PG8_SB(0, 0), cB, voffB); PG8_STAGE(PG8_SA(0, 0), cA, voffA); PG8_STAGE(PG8_SB(0, 1), cB + hstep, voffB); PG8_STAGE(PG8_SA(0, 1), cA + hstep, voffA);
    if (wr == 1) PG8_BAR;
    PG8_WAIT_V(4); PG8_BAR;
    PG8_STAGE(PG8_SB(1, 0), cB + kstep, voffB); PG8_STAGE(PG8_SA(1, 0), cA + kstep, voffA); PG8_STAGE(PG8_SB(1, 1), cB + hstep + kstep, voffB);
    PG8_WAIT_V(6); PG8_BAR;
    for (;;) {
        const bool has_next = S.next(ui + 1, nxt);
        const char* nA = has_next ? (const char*)g.A + (size_t)nxt.pm * tstep : cA; const char* nB = has_next ? (const char*)g.Bt + (size_t)nxt.pn * tstep : cB;
        for (int t = 0; t < nt; t += 2) {
            const bool last = (t == nt - 2);
            const char* a1 = cA + (size_t)(t + 1) * kstep;
            const char* a2 = last ? nA : cA + (size_t)(t + 2) * kstep; const char* b2 = last ? nB : cB + (size_t)(t + 2) * kstep;
            const char* a3 = a2 + kstep; const char* b3 = b2 + kstep;
            PG8_LDB(B0, 0, 0); PG8_SCHED; PG8_LDA(At, 0, 0); PG8_STAGE(PG8_SA(1, 1), a1 + hstep, voffA);
            PG8_WAIT_L(8); PG8_BAR; PG8_WAIT_L(0); PG8_MMA(0, 0, At, B0); PG8_BAR; PG8_SCHED;
            PG8_LDB(B1, 0, 1); PG8_STAGE(PG8_SB(0, 0), b2, voffB);
            PG8_BAR; PG8_WAIT_L(0); PG8_MMA(0, 1, At, B1); PG8_BAR;
            PG8_LDA(At, 0, 1); PG8_STAGE(PG8_SA(0, 0), a2, voffA);
            PG8_BAR; PG8_WAIT_L(0); PG8_MMA(1, 0, At, B0); PG8_BAR; PG8_SCHED;
            PG8_STAGE(PG8_SB(0, 1), b2 + hstep, voffB);
            PG8_WAIT_V(6); PG8_BAR; PG8_MMA(1, 1, At, B1); PG8_BAR;
            PG8_LDB(B0, 1, 0); PG8_SCHED; PG8_LDA(At, 1, 0); PG8_STAGE(PG8_SA(0, 1), a2 + hstep, voffA);
            PG8_WAIT_L(8); PG8_BAR; PG8_WAIT_L(0); PG8_MMA(0, 0, At, B0); PG8_BAR; PG8_SCHED;
            PG8_LDB(B1, 1, 1); PG8_STAGE(PG8_SB(1, 0), b3, voffB);
            PG8_BAR; PG8_WAIT_L(0); PG8_MMA(0, 1, At, B1); PG8_BAR;
            PG8_LDA(At, 1, 1); PG8_STAGE(PG8_SA(1, 0), a3, voffA);
            PG8_BAR; PG8_WAIT_L(0); PG8_MMA(1, 0, At, B0); PG8_BAR; PG8_SCHED;
            PG8_STAGE(PG8_SB(1, 1), b3 + hstep, voffB);
            PG8_WAIT_V(6); PG8_BAR; PG8_MMA(1, 1, At, B1); PG8_BAR;
        }
            E(acc, cur, wr, wc, fr, fq);
            if (!has_next) break;
#pragma unroll
        for (int a = 0; a < 2; ++a)
#pragma unroll
            for (int b = 0; b < 2; ++b)
#pragma unroll
                for (int m = 0; m < 4; ++m)
#pragma unroll
                    for (int n = 0; n < 2; ++n) acc[a][b][m][n] = (f32x4){0.f, 0.f, 0.f, 0.f};
        cur = nxt; cA = nA; cB = nB; ++ui;
    }
    PG8_WAIT_V(0);
    if (wr == 0) PG8_BAR;
    PG8_BAR;
#undef PG8_SA
#undef PG8_SB
#undef PG8_STAGE
#undef PG8_LDA
#undef PG8_LDB
#undef PG8_MMA
#undef PG8_WAIT_V
#undef PG8_WAIT_L
#undef PG8_BAR
#undef PG8_SCHED
}
}

struct Args {
    const float* in[19];
    float* out;
    unsigned char* ws;
    int ph_lo, ph_hi;
};
struct Frame {
    LAS unsigned char* lds;
    int tid, lane, wave, vcu, G;
    unsigned char* ws;
};

template <int MT, int KH0 = 0, int KH1 = 2>
__device__ __forceinline__ void mma_ktile(f32x4 (&acc)[MT][4], LAS const unsigned char* As, LAS const unsigned char* Bs, const unsigned (&foa)[2], const unsigned (&fob)[2][2]) {
#pragma unroll
    for (int kh = KH0; kh < KH1; ++kh) {
        bf16x8 af[MT], bfr[4];
#pragma unroll
        for (int m = 0; m < MT; ++m) af[m] = *(LAS const bf16x8*)(As + m * 2048 + foa[kh]);
#pragma unroll
        for (int n = 0; n < 4; ++n) bfr[n] = *(LAS const bf16x8*)(Bs + n * 2048 + fob[kh][n & 1]);
#pragma unroll
        for (int m = 0; m < MT; ++m)
#pragma unroll
            for (int n = 0; n < 4; ++n)
                acc[m][n] = __builtin_amdgcn_mfma_f32_16x16x32_bf16(bfr[n], af[m], acc[m][n], 0, 0, 0);
    }
}
__device__ __forceinline__ void loadB32(f32x4 (&r)[8], const float* p, size_t ldb) {
#pragma unroll
    for (int i = 0; i < 8; ++i) { r[i] = *(const f32x4*)p; p += ldb; }
}
__device__ __forceinline__ void storeB32(const f32x4 (&r)[8], LAS unsigned char* Bs, int n0, int c) {
#pragma unroll
    for (int j = 0; j < 4; ++j) {
        u32x4 w; w.x = pk2(r[0][j], r[1][j]); w.y = pk2(r[2][j], r[3][j]); w.z = pk2(r[4][j], r[5][j]); w.w = pk2(r[6][j], r[7][j]);
        const int n = n0 + j, x = (n >> 3) & 3, g = ((x & 1) << 1) | (x >> 1);
        *(LAS u32x4*)(Bs + n * 128 + ((c ^ (n & 7) ^ g) << 4)) = w;
    }
}
template <int MT>
__device__ __forceinline__ void dmaA(LAS unsigned char* As, const bf16* p0, const bf16* p1, int wave) {
    __builtin_amdgcn_global_load_lds((const unsigned*)p0, (LAS unsigned*)(As + wave * 1024), 16, 0, 0);
    if (MT == 4) __builtin_amdgcn_global_load_lds((const unsigned*)p1, (LAS unsigned*)(As + wave * 1024 + 8192), 16, 0, 0);
}
#define LGKM_BAR() do { asm volatile("s_waitcnt lgkmcnt(0)" ::: "memory"); __builtin_amdgcn_s_barrier(); asm volatile("" ::: "memory"); } while (0)
template <bool A_LDS>
__device__ __forceinline__ int a_tile_off(int t) { return A_LDS ? ((t < 2) ? L_ACTLO + t * 16384 : L_AS0 + (t - 2) * 16384) : L_AS0 + (t % 3) * 16384; }
template <bool A_LDS, int MT = 4>
__device__ __forceinline__ void gemm_loop(f32x4 (&acc)[MT][4], const Frame& F, const bf16* ap0, const bf16* ap1, const float* bp, size_t ldb, int nk, int rot = 0) {
    LAS unsigned char* lds = F.lds;
    const int lane = F.lane, wave = F.wave, wr = wave >> 2, wc = wave & 3, fr = lane & 15, fq = lane >> 4;
    unsigned foa[2], fob[2][2];
#pragma unroll
    for (int kh = 0; kh < 2; ++kh) {
        foa[kh] = (unsigned)(fr * 128 + ((((4 * kh + fq)) ^ (fr & 7)) << 4));
#pragma unroll
        for (int par = 0; par < 2; ++par) fob[kh][par] = (unsigned)(fr * 128 + (((4 * kh + fq) ^ (fr & 7) ^ ((fr >> 3) << 1) ^ par) << 4));
    }
    const int n0 = 4 * lane;
    const float* bpp = bp + (size_t)(8 * wave) * ldb;
    const size_t tstep = 64 * ldb;
    f32x4 r0[8], r1[8];
#define WAITV(more) do { if (more) { if (A_LDS) asm volatile("s_waitcnt vmcnt(8)" ::: "memory"); else if (MT == 4) asm volatile("s_waitcnt vmcnt(10)" ::: "memory"); else asm volatile("s_waitcnt vmcnt(9)" ::: "memory"); } else asm volatile("s_waitcnt vmcnt(0)" ::: "memory"); } while (0)
#define KT(t) (((t) ^ rot) & (nk - 1))
#define ENDWAIT(nb, na) do { if (nb) { if (A_LDS) asm volatile("s_waitcnt vmcnt(8)" ::: "memory"); else if (MT == 4) asm volatile("s_waitcnt vmcnt(10)" ::: "memory"); else asm volatile("s_waitcnt vmcnt(9)" ::: "memory"); } \
                             else if ((na) && !A_LDS) { if (MT == 4) asm volatile("s_waitcnt vmcnt(2)" ::: "memory"); else asm volatile("s_waitcnt vmcnt(1)" ::: "memory"); } \
                             else asm volatile("s_waitcnt vmcnt(0)" ::: "memory"); } while (0)
    loadB32(r0, bpp + (size_t)KT(0) * tstep, ldb);
    if (!A_LDS) dmaA<MT>(lds + L_AS0, ap0 + KT(0) * 64, ap1 + KT(0) * 64, wave);
    if (nk > 1) { loadB32(r1, bpp + (size_t)KT(1) * tstep, ldb); if (!A_LDS) dmaA<MT>(lds + L_AS0 + 16384, ap0 + KT(1) * 64, ap1 + KT(1) * 64, wave); }
    __builtin_amdgcn_sched_barrier(0);
    WAITV(nk > 1);
    storeB32(r0, lds + L_BS0, n0, wave);
    if (nk > 2) loadB32(r0, bpp + (size_t)KT(2) * tstep, ldb);
    __builtin_amdgcn_sched_barrier(0);
    if (nk > 2) { asm volatile("s_waitcnt vmcnt(8)" ::: "memory"); } else asm volatile("s_waitcnt vmcnt(0)" ::: "memory");
    LGKM_BAR();
    for (int t = 0; t < nk; t += 2) {
        if (t + 1 < nk) storeB32(r1, lds + L_BS0 + 32768, n0, wave);
        if (t + 3 < nk) loadB32(r1, bpp + (size_t)KT(t + 3) * tstep, ldb);
        __builtin_amdgcn_sched_barrier(0);
        mma_ktile<MT, 0, 1>(acc, lds + (A_LDS ? a_tile_off<true>(KT(t)) : a_tile_off<false>(t)) + wr * (MT * 2048), lds + L_BS0 + wc * 8192, foa, fob);
        __builtin_amdgcn_sched_barrier(0);
        if (t + 2 < nk) { if (!A_LDS) dmaA<MT>(lds + a_tile_off<false>(t + 2), ap0 + KT(t + 2) * 64, ap1 + KT(t + 2) * 64, wave); }
        __builtin_amdgcn_sched_barrier(0);
        mma_ktile<MT, 1, 2>(acc, lds + (A_LDS ? a_tile_off<true>(KT(t)) : a_tile_off<false>(t)) + wr * (MT * 2048), lds + L_BS0 + wc * 8192, foa, fob);
        __builtin_amdgcn_sched_barrier(0);
        ENDWAIT(t + 3 < nk, t + 2 < nk);
        LGKM_BAR();
        if (t + 1 >= nk) break;
        if (t + 2 < nk) storeB32(r0, lds + L_BS0, n0, wave);
        if (t + 4 < nk) loadB32(r0, bpp + (size_t)KT(t + 4) * tstep, ldb);
        __builtin_amdgcn_sched_barrier(0);
        mma_ktile<MT, 0, 1>(acc, lds + (A_LDS ? a_tile_off<true>(KT(t + 1)) : a_tile_off<false>(t + 1)) + wr * (MT * 2048), lds + L_BS0 + 32768 + wc * 8192, foa, fob);
        __builtin_amdgcn_sched_barrier(0);
        if (t + 3 < nk) { if (!A_LDS) dmaA<MT>(lds + a_tile_off<false>(t + 3), ap0 + KT(t + 3) * 64, ap1 + KT(t + 3) * 64, wave); }
        __builtin_amdgcn_sched_barrier(0);
        mma_ktile<MT, 1, 2>(acc, lds + (A_LDS ? a_tile_off<true>(KT(t + 1)) : a_tile_off<false>(t + 1)) + wr * (MT * 2048), lds + L_BS0 + 32768 + wc * 8192, foa, fob);
        __builtin_amdgcn_sched_barrier(0);
        ENDWAIT(t + 4 < nk, t + 3 < nk);
        LGKM_BAR();
    }
#undef ENDWAIT
#undef WAITV
#undef KT
}
template <int OFF>
__device__ __forceinline__ void gld16(f32x4& d, const float* p) { asm volatile("global_load_dwordx4 %0, %1, off offset:%2" : "=&v"(d) : "v"(p), "n"(OFF) : "memory"); }
template <int LDB>
__device__ __forceinline__ void loadB32a(f32x4 (&r)[8], const float* p) {
    if (LDB == 256) {
        const float* q = p + 4 * LDB;
        gld16<-4096>(r[0], q); gld16<-3072>(r[1], q); gld16<-2048>(r[2], q); gld16<-1024>(r[3], q); gld16<0>(r[4], q); gld16<1024>(r[5], q); gld16<2048>(r[6], q); gld16<3072>(r[7], q);
    } else {
        const float* q0 = p + LDB; const float* q1 = p + 3 * LDB; const float* q2 = p + 5 * LDB; const float* q3 = p + 7 * LDB;
        gld16<-4096>(r[0], q0); gld16<0>(r[1], q0); gld16<-4096>(r[2], q1); gld16<0>(r[3], q1); gld16<-4096>(r[4], q2); gld16<0>(r[5], q2); gld16<-4096>(r[6], q3); gld16<0>(r[7], q3);
    }
}
#define TIE8(r) "+v"(r[0]), "+v"(r[1]), "+v"(r[2]), "+v"(r[3]), "+v"(r[4]), "+v"(r[5]), "+v"(r[6]), "+v"(r[7])
template <int N> __device__ __forceinline__ void wait_vmc() {
    static_assert(N >= 0 && N <= 12 && N % 2 == 0, "vmcnt");
    if (N == 0) asm volatile("s_waitcnt vmcnt(0)" ::: "memory"); else if (N == 2) asm volatile("s_waitcnt vmcnt(2)" ::: "memory"); else if (N == 4) asm volatile("s_waitcnt vmcnt(4)" ::: "memory");
    else if (N == 6) asm volatile("s_waitcnt vmcnt(6)" ::: "memory"); else if (N == 8) asm volatile("s_waitcnt vmcnt(8)" ::: "memory"); else if (N == 10) asm volatile("s_waitcnt vmcnt(10)" ::: "memory");
    else asm volatile("s_waitcnt vmcnt(12)" ::: "memory");
}
template <bool A_LDS, int NK, int LDB, bool LATE = false>
__device__ __forceinline__ void gemm_loopa(f32x4 (&acc)[4][4], const Frame& F, const bf16* ap0, const bf16* ap1, const float* bp, int rot) {
    static_assert(LDB == 256 || LDB == 1024, "row pitch of the f32 B source");
    constexpr int MT = 4;
    LAS unsigned char* lds = F.lds;
    const int lane = F.lane, wave = F.wave, wr = wave >> 2, wc = wave & 3, fr = lane & 15, fq = lane >> 4;
    unsigned foa[2], fob[2][2];
#pragma unroll
    for (int kh = 0; kh < 2; ++kh) {
        foa[kh] = (unsigned)(fr * 128 + ((((4 * kh + fq)) ^ (fr & 7)) << 4));
#pragma unroll
        for (int par = 0; par < 2; ++par) fob[kh][par] = (unsigned)(fr * 128 + (((4 * kh + fq) ^ (fr & 7) ^ ((fr >> 3) << 1) ^ par) << 4));
    }
    const int n0 = 4 * lane;
    const float* bpp = bp + (size_t)(8 * wave) * LDB;
    constexpr size_t tstep = (size_t)64 * LDB;
    f32x4 r0[8], r1[8];
#define KT(t) (((t) ^ rot) & (NK - 1))
#define XWAIT(nb, na, RS) do { if (nb) { if (A_LDS) asm volatile("s_waitcnt vmcnt(8)" : TIE8(RS) :: "memory"); else asm volatile("s_waitcnt vmcnt(10)" : TIE8(RS) :: "memory"); } \
                               else if ((na) && !A_LDS) asm volatile("s_waitcnt vmcnt(2)" : TIE8(RS) :: "memory"); \
                               else asm volatile("s_waitcnt vmcnt(0)" : TIE8(RS) :: "memory"); } while (0)
#define X_ATILE(t) (lds + (A_LDS ? a_tile_off<true>(KT(t)) : a_tile_off<false>(t)) + wr * (MT * 2048))
#define X_EVEN(t, H1, H2, H3) do { \
        if (H1) storeB32(r1, lds + L_BS0 + 32768, n0, wave); \
        if (H3) loadB32a<LDB>(r1, bpp + (size_t)KT((t) + 3) * tstep); \
        __builtin_amdgcn_sched_barrier(0); \
        mma_ktile<MT, 0, 1>(acc, X_ATILE(t), lds + L_BS0 + wc * 8192, foa, fob); \
        __builtin_amdgcn_sched_barrier(0); \
        if ((H2) && !A_LDS) dmaA<MT>(lds + a_tile_off<false>((t) + 2), ap0 + KT((t) + 2) * 64, ap1 + KT((t) + 2) * 64, wave); \
        __builtin_amdgcn_sched_barrier(0); \
        mma_ktile<MT, 1, 2>(acc, X_ATILE(t), lds + L_BS0 + wc * 8192, foa, fob); \
        __builtin_amdgcn_sched_barrier(0); \
        XWAIT(H3, H2, r0); \
        LGKM_BAR(); } while (0)
#define X_ODD(t, H2, H3, H4) do { \
        if (H2) storeB32(r0, lds + L_BS0, n0, wave); \
        if (H4) loadB32a<LDB>(r0, bpp + (size_t)KT((t) + 4) * tstep); \
        __builtin_amdgcn_sched_barrier(0); \
        mma_ktile<MT, 0, 1>(acc, X_ATILE((t) + 1), lds + L_BS0 + 32768 + wc * 8192, foa, fob); \
        __builtin_amdgcn_sched_barrier(0); \
        if ((H3) && !A_LDS) dmaA<MT>(lds + a_tile_off<false>((t) + 3), ap0 + KT((t) + 3) * 64, ap1 + KT((t) + 3) * 64, wave); \
        __builtin_amdgcn_sched_barrier(0); \
        mma_ktile<MT, 1, 2>(acc, X_ATILE((t) + 1), lds + L_BS0 + 32768 + wc * 8192, foa, fob); \
        __builtin_amdgcn_sched_barrier(0); \
        XWAIT(H4, H3, r1); \
        LGKM_BAR(); } while (0)
    loadB32a<LDB>(r0, bpp + (size_t)KT(0) * tstep);
    if (!A_LDS) dmaA<MT>(lds + L_AS0, ap0 + KT(0) * 64, ap1 + KT(0) * 64, wave);
    loadB32a<LDB>(r1, bpp + (size_t)KT(1) * tstep);
    if (!A_LDS) dmaA<MT>(lds + L_AS0 + 16384, ap0 + KT(1) * 64, ap1 + KT(1) * 64, wave);
    __builtin_amdgcn_sched_barrier(0);
    if (A_LDS) asm volatile("s_waitcnt vmcnt(8)" : TIE8(r0) :: "memory"); else asm volatile("s_waitcnt vmcnt(10)" : TIE8(r0) :: "memory");
    storeB32(r0, lds + L_BS0, n0, wave);
    loadB32a<LDB>(r0, bpp + (size_t)KT(2) * tstep);
    __builtin_amdgcn_sched_barrier(0);
    asm volatile("s_waitcnt vmcnt(8)" : TIE8(r1) :: "memory");
    LGKM_BAR();
    constexpr int T0 = (NK > 4) ? ((NK - 3) / 2) * 2 : 0;
    if (!LATE) {
#pragma unroll 1
        for (int t = 0; t < T0; t += 2) { X_EVEN(t, true, true, true); X_ODD(t, true, true, true); }
#pragma unroll
        for (int t = T0; t < NK; t += 2) { X_EVEN(t, t + 1 < NK, t + 2 < NK, t + 3 < NK); X_ODD(t, t + 2 < NK, t + 3 < NK, t + 4 < NK); }
    } else {
#define L_NB(s) ((s) + 3 < NK)
#define L_NA(s) (!A_LDS && (s) + 2 < NK)
#define L_STEP(s, RS, BOFF, WA, WB) do { \
        mma_ktile<MT, 0, 2>(acc, X_ATILE(s), lds + L_BS0 + (BOFF) + wc * 8192, foa, fob); \
        __builtin_amdgcn_sched_barrier(0); \
        if ((s) + 1 < NK) { wait_vmc<WA>(); asm volatile("" : TIE8(RS) :: "memory"); storeB32(RS, lds + L_BS0 + (32768 - (BOFF)), n0, wave); } \
        if (L_NB(s)) loadB32a<LDB>(RS, bpp + (size_t)KT((s) + 3) * tstep); \
        if (L_NA(s)) dmaA<MT>(lds + a_tile_off<false>((s) + 2), ap0 + KT((s) + 2) * 64, ap1 + KT((s) + 2) * 64, wave); \
        __builtin_amdgcn_sched_barrier(0); \
        if (!A_LDS && (s) + 1 < NK) wait_vmc<WB>(); \
        LGKM_BAR(); } while (0)
        constexpr int WAS = A_LDS ? 8 : 10, WBS = 10;
#pragma unroll 1
        for (int t = 0; t < T0; t += 2) { L_STEP(t, r1, 0, WAS, WBS); L_STEP(t + 1, r0, 32768, WAS, WBS); }
#define L_WA(s) ((((s) >= 2 ? L_NA((s) - 2) : ((s) == 0 && !A_LDS)) ? 2 : 0) + (((s) >= 1 ? L_NB((s) - 1) : true) ? 8 : 0) + (((s) >= 1 && L_NA((s) - 1)) ? 2 : 0))
#define L_WB(s) ((L_NB(s) ? 8 : 0) + (L_NA(s) ? 2 : 0))
#define L_TAIL(s, RS, BOFF) L_STEP(s, RS, BOFF, (L_WA(s) > 10 ? 10 : L_WA(s)), L_WB(s))
        static_assert(T0 % 2 == 0 && NK - T0 == 4, "tail of four steps");
        L_TAIL(T0, r1, 0); L_TAIL(T0 + 1, r0, 32768); L_TAIL(T0 + 2, r1, 0); L_TAIL(T0 + 3, r0, 32768);
#undef L_TAIL
#undef L_WA
#undef L_WB
#undef L_STEP
#undef L_NA
#undef L_NB
    }
#undef X_EVEN
#undef X_ODD
#undef X_ATILE
#undef XWAIT
#undef KT
}
template <bool A_LDS, int NK, int LDB, bool LATE, bool PRE, int NLDB, int NNK>
__device__ __forceinline__ void gemm_chain(f32x4 (&acc)[4][4], const Frame& F, f32x4 (&r0)[8], f32x4 (&r1)[8], const char* abase, unsigned ao0, unsigned ao1, const float* bp, const float* bpn, int rot, int rb) {
    static_assert(LDB == 256 || LDB == 1024, "row pitch of the f32 B source");
    static_assert(NLDB == 0 || NLDB == 256 || NLDB == 1024, "row pitch of the next f32 B source");
    constexpr int MT = 4;
    constexpr bool CHAIN = NLDB != 0;
    constexpr bool SAME = CHAIN && NLDB == LDB && NNK == NK;
    constexpr int NL = CHAIN ? NLDB : LDB, NN = CHAIN ? NNK : NK;
    LAS unsigned char* lds = F.lds;
    const int lane = F.lane, wave = F.wave, wr = wave >> 2, wc = wave & 3, fr = lane & 15, fq = lane >> 4;
    unsigned foa[2], fob[2][2];
#pragma unroll
    for (int kh = 0; kh < 2; ++kh) {
        foa[kh] = (unsigned)(fr * 128 + ((((4 * kh + fq)) ^ (fr & 7)) << 4));
#pragma unroll
        for (int par = 0; par < 2; ++par) fob[kh][par] = (unsigned)(fr * 128 + (((4 * kh + fq) ^ (fr & 7) ^ ((fr >> 3) << 1) ^ par) << 4));
    }
    const int n0 = 4 * lane;
    const float* bpp = bp + (size_t)(8 * wave) * LDB;
    const float* bppn = bpn + (size_t)(8 * wave) * NL;
    constexpr size_t tstep = (size_t)64 * LDB, tstepn = (size_t)64 * NL;
#define KT(t) (((t) ^ rot) & (NK - 1))
#define C_BPTR(j) ((((j) < NK) ? bpp : bppn) + (size_t)KT(j) * tstep)
#define C_LOAD(RS, j) do { if ((j) < NK) loadB32a<LDB>(RS, bpp + (size_t)KT(j) * tstep); else loadB32a<NL>(RS, bppn + (size_t)((((j) - NK) ^ rot) & (NN - 1)) * tstepn); } while (0)
#define C_ASLOT(j) (L_AS0 + (((j) + rb) % 3) * 16384)
#define C_ADMA(j) do { unsigned a0_ = ao0, a1_ = ao1; asm volatile("" : "+v"(a0_), "+v"(a1_)); const unsigned ko_ = (unsigned)KT(j) * 128u;     \
        dmaA<MT>(lds + C_ASLOT(j), (const bf16*)(abase + (a0_ + ko_)), (const bf16*)(abase + (a1_ + ko_)), wave); } while (0)
#define X_ATILE(t) (lds + (A_LDS ? a_tile_off<true>(KT(t)) : C_ASLOT(t)) + wr * (MT * 2048))
#define X_EVEN(t, H1, AD2, LD3, LOADSTMT) do { \
        if (H1) storeB32(r1, lds + L_BS0 + 32768, n0, wave); \
        if (LD3) { LOADSTMT; } \
        __builtin_amdgcn_sched_barrier(0); \
        __builtin_amdgcn_s_setprio(1); mma_ktile<MT, 0, 1>(acc, X_ATILE(t), lds + L_BS0 + wc * 8192, foa, fob); __builtin_amdgcn_s_setprio(0); \
        __builtin_amdgcn_sched_barrier(0); \
        if ((AD2) && !A_LDS) C_ADMA((t) + 2); \
        __builtin_amdgcn_sched_barrier(0); \
        __builtin_amdgcn_s_setprio(1); mma_ktile<MT, 1, 2>(acc, X_ATILE(t), lds + L_BS0 + wc * 8192, foa, fob); __builtin_amdgcn_s_setprio(0); \
        __builtin_amdgcn_sched_barrier(0); \
        wait_vmc<((LD3) ? 8 : 0) + (((AD2) && !A_LDS) ? 2 : 0)>(); asm volatile("" : TIE8(r0) :: "memory"); \
        LGKM_BAR(); } while (0)
#define X_ODD(t, H2, AD3, LD4, LOADSTMT) do { \
        if (H2) storeB32(r0, lds + L_BS0, n0, wave); \
        if (LD4) { LOADSTMT; } \
        __builtin_amdgcn_sched_barrier(0); \
        __builtin_amdgcn_s_setprio(1); mma_ktile<MT, 0, 1>(acc, X_ATILE((t) + 1), lds + L_BS0 + 32768 + wc * 8192, foa, fob); __builtin_amdgcn_s_setprio(0); \
        __builtin_amdgcn_sched_barrier(0); \
        if ((AD3) && !A_LDS) C_ADMA((t) + 3); \
        __builtin_amdgcn_sched_barrier(0); \
        __builtin_amdgcn_s_setprio(1); mma_ktile<MT, 1, 2>(acc, X_ATILE((t) + 1), lds + L_BS0 + 32768 + wc * 8192, foa, fob); __builtin_amdgcn_s_setprio(0); \
        __builtin_amdgcn_sched_barrier(0); \
        wait_vmc<((LD4) ? 8 : 0) + (((AD3) && !A_LDS) ? 2 : 0)>(); asm volatile("" : TIE8(r1) :: "memory"); \
        LGKM_BAR(); } while (0)
    if (!PRE) {
        loadB32a<LDB>(r0, bpp + (size_t)KT(0) * tstep);
        if (!A_LDS) C_ADMA(0);
        loadB32a<LDB>(r1, bpp + (size_t)KT(1) * tstep);
        if (!A_LDS) C_ADMA(1);
        __builtin_amdgcn_sched_barrier(0);
        if (A_LDS) asm volatile("s_waitcnt vmcnt(8)" : TIE8(r0) :: "memory"); else asm volatile("s_waitcnt vmcnt(10)" : TIE8(r0) :: "memory");
        storeB32(r0, lds + L_BS0, n0, wave);
        loadB32a<LDB>(r0, bpp + (size_t)KT(2) * tstep);
        __builtin_amdgcn_sched_barrier(0);
        asm volatile("s_waitcnt vmcnt(8)" : TIE8(r1) :: "memory");
        LGKM_BAR();
    }
    constexpr int T0 = SAME ? NK : NK - 4;
    static_assert(T0 >= 0 && T0 % 2 == 0, "step pairs");
    if (!LATE) {
#pragma unroll 1
        for (int t = 0; t < T0; t += 2) {
            X_EVEN(t, true, true, true, loadB32a<LDB>(r1, C_BPTR(t + 3)));
            X_ODD(t, true, true, true, loadB32a<LDB>(r0, C_BPTR(t + 4)));
        }
        if (!SAME) {
            X_EVEN(NK - 4, true, true, true, C_LOAD(r1, NK - 1));
            X_ODD(NK - 4, true, true, CHAIN, C_LOAD(r0, NK));
            X_EVEN(NK - 2, true, false, CHAIN, C_LOAD(r1, NK + 1));
            X_ODD(NK - 2, CHAIN, false, CHAIN, C_LOAD(r0, NK + 2));
        }
    } else {
#define L_STEP(s, RS, BOFF, ST, NB, NA, WA, WB, LOADSTMT) do { \
        __builtin_amdgcn_s_setprio(1); mma_ktile<MT, 0, 2>(acc, X_ATILE(s), lds + L_BS0 + (BOFF) + wc * 8192, foa, fob); __builtin_amdgcn_s_setprio(0); \
        __builtin_amdgcn_sched_barrier(0); \
        if (ST) { wait_vmc<WA>(); asm volatile("" : TIE8(RS) :: "memory"); storeB32(RS, lds + L_BS0 + (32768 - (BOFF)), n0, wave); } \
        if (NB) { LOADSTMT; } \
        if ((NA) && !A_LDS) C_ADMA((s) + 2); \
        __builtin_amdgcn_sched_barrier(0); \
        if (!A_LDS && (WB) >= 0) wait_vmc<((WB) >= 0 ? (WB) : 0)>(); \
        LGKM_BAR(); } while (0)
        constexpr int WAS = A_LDS ? 8 : 10, WBS = A_LDS ? -1 : 10;
#pragma unroll 1
        for (int t = 0; t < T0; t += 2) {
            L_STEP(t, r1, 0, true, true, true, WAS, WBS, loadB32a<LDB>(r1, C_BPTR(t + 3)));
            L_STEP(t + 1, r0, 32768, true, true, true, WAS, WBS, loadB32a<LDB>(r0, C_BPTR(t + 4)));
        }
        if (!SAME) {
            constexpr bool AL = A_LDS;
            constexpr int NB3 = CHAIN ? 8 : 0;
            L_STEP(NK - 4, r1, 0, true, true, true, (NK > 4 ? WAS : (AL ? 8 : 10)), (AL ? -1 : 10), C_LOAD(r1, NK - 1));
            L_STEP(NK - 3, r0, 32768, true, CHAIN, true, WAS, (AL ? -1 : NB3 + 2), C_LOAD(r0, NK));
            L_STEP(NK - 2, r1, 0, true, CHAIN, false, (AL ? NB3 : (2 + NB3 + 2 > 10 ? 10 : 2 + NB3 + 2)), (AL ? -1 : NB3), C_LOAD(r1, NK + 1));
            L_STEP(NK - 1, r0, 32768, CHAIN, CHAIN, false, (AL ? NB3 : 2 + NB3), -1, C_LOAD(r0, NK + 2));
        }
#undef L_STEP
    }
#undef X_EVEN
#undef X_ODD
#undef X_ATILE
#undef C_ADMA
#undef C_ASLOT
#undef C_LOAD
#undef C_BPTR
#undef KT
}
__device__ __forceinline__ int swz4(int row) { return (0x78 >> (2 * ((row >> 2) & 3))) & 3; }
template <int MT>
__device__ __forceinline__ void gemm_ring(f32x4 (&acc)[MT][4], const Frame& F, const bf16* abase, const unsigned (&aoff)[2], const bf16* bblk, int nst) {
    LAS unsigned char* lds = F.lds;
    const int tid = F.tid, lane = F.lane, wave = F.wave, wr = wave >> 2, wc = wave & 3, fr = lane & 15, fq = lane >> 4;
    const unsigned fo = (unsigned)(fr * 64 + ((fq ^ swz4(fr)) << 4));
    const unsigned boff = (unsigned)(tid * 16);
    const bool a_wave = (MT != 2) || (wave < 4);
#define RG_STAGE(t) do { const int sl_ = ((t) & 3) * 32768; \
        _Pragma("unroll") for (int i = 0; i < 2; ++i) __builtin_amdgcn_global_load_lds((const unsigned*)((const char*)bblk + (size_t)(t) * 16384 + boff + i * 8192), (LAS unsigned*)(lds + sl_ + 16384 + wave * 1024 + i * 8192), 16, 0, 0); \
        if (MT == 8) { _Pragma("unroll") for (int i = 0; i < 2; ++i) __builtin_amdgcn_global_load_lds((const unsigned*)((const char*)abase + (size_t)(t) * 64 + aoff[i]), (LAS unsigned*)(lds + sl_ + wave * 1024 + i * 8192), 16, 0, 0); } \
        else if (a_wave) __builtin_amdgcn_global_load_lds((const unsigned*)((const char*)abase + (size_t)(t) * 64 + aoff[0]), (LAS unsigned*)(lds + sl_ + wave * 1024), 16, 0, 0); } while (0)
#define RG_WAIT(k) do { if (MT == 8) { if ((k) == 2) asm volatile("s_waitcnt vmcnt(8)" ::: "memory"); else if ((k) == 1) asm volatile("s_waitcnt vmcnt(4)" ::: "memory"); else asm volatile("s_waitcnt vmcnt(0)" ::: "memory"); } \
        else if (a_wave) { if ((k) == 2) asm volatile("s_waitcnt vmcnt(6)" ::: "memory"); else if ((k) == 1) asm volatile("s_waitcnt vmcnt(3)" ::: "memory"); else asm volatile("s_waitcnt vmcnt(0)" ::: "memory"); } \
        else { if ((k) == 2) asm volatile("s_waitcnt vmcnt(4)" ::: "memory"); else if ((k) == 1) asm volatile("s_waitcnt vmcnt(2)" ::: "memory"); else asm volatile("s_waitcnt vmcnt(0)" ::: "memory"); } } while (0)
    RG_STAGE(0);
    if (nst > 1) RG_STAGE(1);
    if (nst > 2) RG_STAGE(2);
#pragma unroll 1
    for (int t = 0; t < nst; ++t) {
        const int ahead = (nst - 1 - t) < 2 ? (nst - 1 - t) : 2;
        if (ahead == 2) RG_WAIT(2); else if (ahead == 1) RG_WAIT(1); else RG_WAIT(0);
        LGKM_BAR();
        __builtin_amdgcn_sched_barrier(0);
        {
            LAS const unsigned char* As = lds + (t & 3) * 32768 + wr * (MT * 1024);
            LAS const unsigned char* Bs = lds + (t & 3) * 32768 + 16384 + wc * 4096;
            bf16x8 bfr[4];
#pragma unroll
            for (int n = 0; n < 4; ++n) bfr[n] = *(LAS const bf16x8*)(Bs + n * 1024 + fo);
            constexpr int MH = MT > 4 ? 4 : MT;
#pragma unroll
            for (int m0 = 0; m0 < MT; m0 += MH) {
                bf16x8 af[MH];
#pragma unroll
                for (int m = 0; m < MH; ++m) af[m] = *(LAS const bf16x8*)(As + (m0 + m) * 1024 + fo);
#pragma unroll
                for (int m = 0; m < MH; ++m)
#pragma unroll
                    for (int n = 0; n < 4; ++n)
                        acc[m0 + m][n] = __builtin_amdgcn_mfma_f32_16x16x32_bf16(bfr[n], af[m], acc[m0 + m][n], 0, 0, 0);
                if (m0 == 0) {
                    __builtin_amdgcn_sched_barrier(0);
                    if (t + 3 < nst) RG_STAGE(t + 3);
                    __builtin_amdgcn_sched_barrier(0);
                }
            }
        }
        __builtin_amdgcn_sched_barrier(0);
    }
    LGKM_BAR();
#undef RG_STAGE
#undef RG_WAIT
}
__device__ __forceinline__ void ring_aoff(unsigned (&aoff)[2], int tid, int ld_elems) {
#pragma unroll
    for (int i = 0; i < 2; ++i) { const int p = tid + 512 * i, row = p >> 2, lc = (p & 3) ^ swz4(row); aoff[i] = (unsigned)(row * ld_elems + lc * 8) * 2u; }
}
template <int MT>
__device__ __forceinline__ void zero_accT(f32x4 (&acc)[MT][4]) {
#pragma unroll
    for (int m = 0; m < MT; ++m)
#pragma unroll
        for (int n = 0; n < 4; ++n) acc[m][n] = (f32x4){0.f, 0.f, 0.f, 0.f};
}
__device__ __forceinline__ void convert_block(const Frame& F, const float* colp, size_t ldb, int kt, bf16* blk) {
    f32x4 r[8];
    loadB32(r, colp + (size_t)(kt * 64 + 8 * F.wave) * ldb, ldb);
#pragma unroll
    for (int j = 0; j < 4; ++j) {
        u32x4 w; w.x = pk2(r[0][j], r[1][j]); w.y = pk2(r[2][j], r[3][j]); w.z = pk2(r[4][j], r[5][j]); w.w = pk2(r[6][j], r[7][j]);
        const int n = 4 * F.lane + j;
        *(u32x4*)((char*)blk + (F.wave >> 2) * 16384 + n * 64 + (((F.wave & 3) ^ swz4(n)) << 4)) = w;
    }
}
__device__ __forceinline__ void zero_acc(f32x4 (&acc)[4][4]) {
#pragma unroll
    for (int m = 0; m < 4; ++m)
#pragma unroll
        for (int n = 0; n < 4; ++n) acc[m][n] = (f32x4){0.f, 0.f, 0.f, 0.f};
}

__device__ __forceinline__ void phase0(const Frame& F, const float* x, const float* g, const float* b, const float* w_in, const float* w_out, const float* w_router) {
    const int gw = F.vcu * 8 + F.wave, NGW = F.G * 8;
    bf16* H0B = (bf16*)(F.ws + WS_H0B);
    f32x4 gv[4], bv[4];
#pragma unroll
    for (int c = 0; c < 4; ++c) { gv[c] = *(const f32x4*)(g + 4 * F.lane + 256 * c); bv[c] = *(const f32x4*)(b + 4 * F.lane + 256 * c); }
    for (int row = gw; row < T_TOK; row += NGW) {
        const float* xr = x + (size_t)row * DM + 4 * F.lane;
        f32x4 v[4]; float s = 0.f;
#pragma unroll
        for (int c = 0; c < 4; ++c) { v[c] = *(const f32x4*)(xr + 256 * c); s += (v[c].x + v[c].y) + (v[c].z + v[c].w); }
        const float mean = wave_sum(s) * (1.f / DM); float s2 = 0.f;
#pragma unroll
        for (int c = 0; c < 4; ++c) { v[c] = v[c] - mean; s2 += (v[c].x * v[c].x + v[c].y * v[c].y) + (v[c].z * v[c].z + v[c].w * v[c].w); }
        const float rstd = 1.f / sqrtf(wave_sum(s2) * (1.f / DM) + 1e-5f);
        bf16* orow = H0B + (size_t)row * DM + 4 * F.lane;
#pragma unroll
        for (int c = 0; c < 4; ++c) {
            const f32x4 y = v[c] * rstd * gv[c] + bv[c];
            u32x2 w; w.x = pk2(y.x, y.y); w.y = pk2(y.z, y.w);
            *(u32x2*)(orow + 256 * c) = w;
        }
    }
    {
        bf16* WIMG = (bf16*)(F.ws + WS_WIMG);
        for (int blk = F.vcu; blk < WIMG_N; blk += F.G) {
            const int s = 4 * F.lane;
            if (blk >= 128 && blk < WIMG_OUT) convert_block(F, w_in + (blk / 16) * 256 + s, INW, blk % 16, WIMG + (size_t)blk * 16384);
            else if (blk >= WIMG_RT) convert_block(F, w_router + s, NEXP, blk - WIMG_RT, WIMG + (size_t)blk * 16384);
        }
    }
    {
        bf16* WTI = (bf16*)(F.ws + WS_WT_IN); bf16* WTO = (bf16*)(F.ws + WS_WT_OUT);
        LAS float* scr = (LAS float*)(F.lds + F.wave * 8448);
        for (int it = gw; it < 1024 + 512; it += NGW) {
            const bool isin = it < 1024; const int r = isin ? it : it - 1024;
            const int nblk = isin ? 64 : 32, kb = r / nblk, nb = r % nblk, k0 = 64 * kb, n0 = 32 * nb, N = isin ? INW : DM;
            const float* W = isin ? w_in : w_out; bf16* WT = isin ? WTI : WTO;
#pragma unroll 8
            for (int i = 0; i < 32; ++i) { const int kk = 2 * i + (F.lane >> 5); scr[kk * 33 + (F.lane & 31)] = W[(size_t)(k0 + kk) * N + n0 + (F.lane & 31)]; }
            asm volatile("s_waitcnt lgkmcnt(0)" ::: "memory");
            const int c = F.lane & 7;
#pragma unroll
            for (int j = 0; j < 4; ++j) {
                const int n = (F.lane >> 3) + 8 * j; const LAS float* sp = scr + (8 * c) * 33 + n;
                u32x4 o; o.x = pk2(sp[0 * 33], sp[1 * 33]); o.y = pk2(sp[2 * 33], sp[3 * 33]); o.z = pk2(sp[4 * 33], sp[5 * 33]); o.w = pk2(sp[6 * 33], sp[7 * 33]);
                const int col = n0 + n;
                const int row = (isin && col < 512) ? ((col & ~48) | ((col & 16) << 1) | ((col & 32) >> 1)) : col;
                *(u32x4*)(WT + (size_t)row * DM + k0 + 8 * c) = o;
            }
            asm volatile("s_waitcnt lgkmcnt(0)" ::: "memory");
        }
    }
    float* COS = (float*)(F.ws + WS_COS); float* SIN = (float*)(F.ws + WS_SIN);
    for (int i = F.vcu * 512 + F.tid; i < SEQ * 32; i += F.G * 512) {
        const int pos = i >> 5, j = i & 31;
        const float inv = exp2f(-(float)j * (13.287712379549449f / 32.0f));
        const float ang = (float)pos * inv;
        double rev = (double)ang * 0.15915494309189535;
        rev -= __builtin_rint(rev);
        const float rv = (float)rev;
        COS[i] = __builtin_amdgcn_cosf(rv); SIN[i] = __builtin_amdgcn_sinf(rv);
    }
}

template <int MT>
__device__ __forceinline__ void p1_epilogue(f32x4 (&acc)[MT][4], const Frame& F, int row_base, int nt) {
    bf16* PROJ = (bf16*)(F.ws + WS_PROJ);
    const float* COS = (const float*)(F.ws + WS_COS); const float* SIN = (const float*)(F.ws + WS_SIN);
    const int lane = F.lane, wr = F.wave >> 2, wc = F.wave & 3, fr = lane & 15, fq = lane >> 4;
    const float scale = (nt == 1 || nt == 6 || nt == 7) ? 0.125f : 1.0f;
#pragma unroll
    for (int m = 0; m < MT; ++m) {
        const int row = row_base + wr * (16 * MT) + m * 16 + fr;
        if (nt < 2) {
            const int pos = row & (SEQ - 1);
#pragma unroll
            for (int n = 0; n < 2; ++n) {
                const f32x4 c = *(const f32x4*)(COS + pos * 32 + 16 * n + 4 * fq), s = *(const f32x4*)(SIN + pos * 32 + 16 * n + 4 * fq);
                const f32x4 x1 = acc[m][n], x2 = acc[m][n + 2];
                acc[m][n] = x1 * c - x2 * s; acc[m][n + 2] = x1 * s + x2 * c;
            }
        }
        bf16* orow = PROJ + (size_t)row * INW + nt * 256 + wc * 64 + 4 * fq;
#pragma unroll
        for (int n = 0; n < 4; ++n) {
            const f32x4 v = acc[m][n] * scale;
            u32x2 w; w.x = pk2(v.x, v.y); w.y = pk2(v.z, v.w);
            *(u32x2*)(orow + 16 * n) = w;
        }
        asm volatile("" ::: "memory");
    }
}
struct SchedP1 { int vcu, G; __device__ __forceinline__ bool next(int i, pg8::Unit& u) const { const int L = vcu + i * G; if (L >= 512) return false; u.pm = L >> 3; u.pn = L & 7; return true; } };
struct EpiP1 {
    bf16* PROJ; const float* COS; const float* SIN;
    __device__ __forceinline__ void operator()(const f32x4 (&acc)[2][2][4][2], const pg8::Unit& u, int wr, int wc, int fr, int fq) const {
        const float scale = (u.pn == 1 || u.pn == 6 || u.pn == 7) ? 0.125f : 1.0f;
#pragma unroll
        for (int ai = 0; ai < 2; ++ai)
#pragma unroll
            for (int m = 0; m < 4; ++m) {
                const int row = u.pm * 256 + ai * 128 + wr * 64 + m * 16 + fr;
                if (u.pn < 2) {
                    const int pos = row & (SEQ - 1), d0 = 16 * (wc & 1) + 4 * fq;
                    const f32x4 c = *(const f32x4*)(COS + pos * 32 + d0), s = *(const f32x4*)(SIN + pos * 32 + d0);
#pragma unroll
                    for (int bj = 0; bj < 2; ++bj) {
                        const f32x4 x1 = acc[ai][bj][m][0], x2 = acc[ai][bj][m][1];
                        const f32x4 o1 = (x1 * c - x2 * s) * scale, o2 = (x1 * s + x2 * c) * scale;
                        bf16* dst = PROJ + (size_t)row * INW + u.pn * 256 + bj * 128 + (wc >> 1) * 64 + d0;
                        u32x2 w1, w2; w1.x = pk2(o1.x, o1.y); w1.y = pk2(o1.z, o1.w); w2.x = pk2(o2.x, o2.y); w2.y = pk2(o2.z, o2.w);
                        *(u32x2*)dst = w1; *(u32x2*)(dst + 32) = w2;
                    }
                } else {
#pragma unroll
                    for (int bj = 0; bj < 2; ++bj)
#pragma unroll
                        for (int n = 0; n < 2; ++n) {
                            const f32x4 v = acc[ai][bj][m][n] * scale;
                            u32x2 w; w.x = pk2(v.x, v.y); w.y = pk2(v.z, v.w);
                            *(u32x2*)(PROJ + (size_t)row * INW + u.pn * 256 + bj * 128 + wc * 32 + 16 * n + 4 * fq) = w;
                        }
                }
                asm volatile("" ::: "memory");
            }
    }
};
__device__ __forceinline__ void phase1(const Frame& F) {
    const bf16* H0B = (const bf16*)(F.ws + WS_H0B);
    const bf16* WIMG = (const bf16*)(F.ws + WS_WIMG);
    {
        const pg8::Gemm g{H0B, (const bf16*)(F.ws + WS_WT_IN), DM};
        const SchedP1 S{F.vcu, F.G};
        const EpiP1 E{(bf16*)(F.ws + WS_PROJ), (const float*)(F.ws + WS_COS), (const float*)(F.ws + WS_SIN)};
        pg8::gemm_phase<EpiP1, SchedP1>(F.lds, g, S, E);
    }
    unsigned aoff[2]; ring_aoff(aoff, F.tid, DM);
    for (int mt = F.vcu; mt < 256; mt += F.G) {
        f32x4 acc[2][4]; zero_accT<2>(acc);
        gemm_ring<2>(acc, F, H0B + (size_t)mt * 64 * DM, aoff, WIMG + (size_t)(WIMG_IN + 8 * 16) * 16384, DM / 32);
        p1_epilogue<2>(acc, F, mt * 64, 8);
    }
}

__device__ __forceinline__ bf16x8 tr_frag(LAS const unsigned char* a0, LAS const unsigned char* a1) {
    const s16x4 lo = __builtin_amdgcn_ds_read_tr16_b64_v4i16((LAS s16x4*)a0);
    const s16x4 hi = __builtin_amdgcn_ds_read_tr16_b64_v4i16((LAS s16x4*)a1);
    bf16x8 r; r[0] = lo[0]; r[1] = lo[1]; r[2] = lo[2]; r[3] = lo[3]; r[4] = hi[0]; r[5] = hi[1]; r[6] = hi[2]; r[7] = hi[3];
    return r;
}
__device__ __forceinline__ int tr128_off(int row, int col) { return row * 128 + 32 * ((col >> 4) ^ ((row >> 1) & 3)) + 2 * (col & 15); }
__device__ __forceinline__ int tr256_off(int row, int col) { return row * 256 + 32 * ((col >> 4) ^ (row & 7)) + 2 * (col & 15); }
__device__ __forceinline__ bf16x8 pack_p(const f32x4& a, const f32x4& b) {
    u32x4 w; w.x = pk2(a.x, a.y); w.y = pk2(a.z, a.w); w.z = pk2(b.x, b.y); w.w = pk2(b.z, b.w);
    return __builtin_bit_cast(bf16x8, w);
}

__device__ __forceinline__ int t5_bucket(int n) {
    if (n < 16) return n;
    const float ratio = logf((float)n / 16.0f) / 2.0794415416798357f;
    int large = 16 + (int)(ratio * 16.0f);
    return large < 31 ? large : 31;
}
__device__ __forceinline__ void swa_unit(const Frame& F, int su, const float* rel_bias, const float* sinks) {
    LAS unsigned char* lds = F.lds;
    const bf16* PROJ = (const bf16*)(F.ws + WS_PROJ);
    bf16* MIXIN = (bf16*)(F.ws + WS_MIXIN);
    const int tid = F.tid, lane = F.lane, wave = F.wave, fr = lane & 15, fq = lane >> 4;
    const int b = su >> 7, nb = (su >> 1) & 63, kvh = su & 1;
    const int tok_prev = b * SEQ + (nb > 0 ? nb - 1 : 0) * 128, tok_cur = b * SEQ + nb * 128;
    constexpr int L_K = 0, L_V = 32768, L_BT = 65536;
#pragma unroll
    for (int i = 0; i < 4; ++i) {
        const int p = tid + 512 * i, row = p >> 3, pc = p & 7;
        const int tok = (row < 128 ? tok_prev + row : tok_cur + row - 128);
        const bf16* src = PROJ + (size_t)tok * INW;
        const int lck = pc ^ (row & 7);
        __builtin_amdgcn_global_load_lds((const unsigned*)(src + 2048 + kvh * 64 + lck * 8), (LAS unsigned*)(lds + L_K + wave * 1024 + i * 8192), 16, 0, 0);
        const int vcol = 16 * ((pc >> 1) ^ ((row >> 1) & 3)) + 8 * (pc & 1);
        __builtin_amdgcn_global_load_lds((const unsigned*)(src + 2176 + kvh * 64 + vcol), (LAS unsigned*)(lds + L_V + wave * 1024 + i * 8192), 16, 0, 0);
    }
    {
        const int g = tid >> 7, dist = tid & 127;
        ((LAS float*)(lds + L_BT))[tid] = rel_bias[t5_bucket(dist) * 8 + kvh * 4 + g];
    }
    BLOCK_SYNC();
#pragma unroll 1
    for (int task = wave; task < 32; task += 8) {
        const int g = task >> 3, a = task & 7, nj0 = a & ~1, head = kvh * 4 + g;
        const float sink = sinks[head];
        LAS const float* bt = (LAS const float*)(lds + L_BT) + g * 128;
        const int i = a * 16 + fr;
        bf16x8 qf[2];
#pragma unroll
        for (int kk = 0; kk < 2; ++kk)
            qf[kk] = *(const bf16x8*)(PROJ + (size_t)(tok_cur + i) * INW + 1536 + head * 64 + kk * 32 + fq * 8);
        f32x4 s[10];
#pragma unroll
        for (int nl = 0; nl < 10; ++nl) {
            s[nl] = (f32x4){0.f, 0.f, 0.f, 0.f};
            const int krow = 16 * (nj0 + nl) + fr;
#pragma unroll
            for (int kk = 0; kk < 2; ++kk) {
                const bf16x8 kf = *(LAS const bf16x8*)(lds + L_K + krow * 128 + (((kk * 4 + fq) ^ (fr & 7)) << 4));
                s[nl] = __builtin_amdgcn_mfma_f32_16x16x32_bf16(kf, qf[kk], s[nl], 0, 0, 0);
            }
        }
        float m = sink;
#pragma unroll
        for (int nl = 0; nl < 10; ++nl)
#pragma unroll
            for (int j = 0; j < 4; ++j) {
                const int jp = 16 * (nj0 + nl) + 4 * fq + j;
                const int dist = i + 128 - jp;
                const bool ok = (dist >= 0) && (dist < 128) && (nb > 0 || jp >= 128);
                const float v = ok ? s[nl][j] + bt[dist & 127] : -INFINITY;
                s[nl][j] = v; m = fmaxf(m, v);
            }
        m = fmaxf(m, __shfl_xor(m, 16)); m = fmaxf(m, __shfl_xor(m, 32));
        float d = 0.f;
#pragma unroll
        for (int nl = 0; nl < 10; ++nl)
#pragma unroll
            for (int j = 0; j < 4; ++j) { const float p = __expf(s[nl][j] - m); s[nl][j] = p; d += p; }
        d += __shfl_xor(d, 16); d += __shfl_xor(d, 32);
        const float inv = 1.0f / (d + __expf(sink - m));
        f32x4 o[4];
#pragma unroll
        for (int ne = 0; ne < 4; ++ne) o[ne] = (f32x4){0.f, 0.f, 0.f, 0.f};
#pragma unroll
        for (int ks = 0; ks < 5; ++ks) {
            const bf16x8 pf = pack_p(s[2 * ks], s[2 * ks + 1]);
            const int r0 = 16 * (nj0 + 2 * ks) + 4 * fq + (fr >> 2);
#pragma unroll
            for (int ne = 0; ne < 4; ++ne) {
                const bf16x8 vf = tr_frag(lds + L_V + tr128_off(r0, 16 * ne) + 8 * (fr & 3), lds + L_V + tr128_off(r0 + 16, 16 * ne) + 8 * (fr & 3));
                o[ne] = __builtin_amdgcn_mfma_f32_16x16x32_bf16(vf, pf, o[ne], 0, 0, 0);
            }
        }
        bf16* orow = MIXIN + (size_t)(tok_cur + i) * DM + 512 + head * 64 + 4 * fq;
#pragma unroll
        for (int ne = 0; ne < 4; ++ne) {
            const f32x4 v = o[ne] * inv;
            u32x2 w; w.x = pk2(v.x, v.y); w.y = pk2(v.z, v.w);
            *(u32x2*)(orow + 16 * ne) = w;
        }
    }
    BLOCK_SYNC();
}

__device__ __forceinline__ float ret_log2gamma(int h) { return log2f(1.0f - exp2f(-5.0f - (float)h)); }
__device__ __forceinline__ void stage_v256(const Frame& F, const bf16* PROJ, int tok0, int h, int L_V) {
#pragma unroll
    for (int i = 0; i < 4; ++i) {
        const int p = F.tid + 512 * i, row = p >> 4, pc = p & 15;
        const int col = 16 * ((pc >> 1) ^ (row & 7)) + 8 * (pc & 1);
        __builtin_amdgcn_global_load_lds((const unsigned*)(PROJ + (size_t)(tok0 + row) * INW + 512 + h * 128 + col), (LAS unsigned*)(F.lds + L_V + F.wave * 1024 + i * 8192), 16, 0, 0);
    }
}
__device__ __forceinline__ void kv_unit(const Frame& F, int ku) {
    LAS unsigned char* lds = F.lds;
    const bf16* PROJ = (const bf16*)(F.ws + WS_PROJ);
    float* KVT = (float*)(F.ws + WS_KVT);
    const int tid = F.tid, lane = F.lane, wave = F.wave, fr = lane & 15, fq = lane >> 4;
    const int b = ku >> 8, n = (ku >> 2) & 63, h = ku & 3;
    const int tok0 = b * SEQ + n * 128;
    constexpr int L_K = 0, L_V = 16384;
    const float l2g = ret_log2gamma(h);
    stage_v256(F, PROJ, tok0, h, L_V);
#pragma unroll
    for (int i = 0; i < 2; ++i) {
        const int p = tid + 512 * i, row = p >> 3, pc = p & 7;
        const int col = 16 * ((pc >> 1) ^ ((row >> 1) & 3)) + 8 * (pc & 1);
        const u32x4 kv = *(const u32x4*)(PROJ + (size_t)(tok0 + row) * INW + 256 + h * 64 + col);
        const float z = exp2f((float)(127 - row) * l2g);
        u32x4 w;
        w.x = pk2(bflo(kv.x) * z, bfhi(kv.x) * z); w.y = pk2(bflo(kv.y) * z, bfhi(kv.y) * z);
        w.z = pk2(bflo(kv.z) * z, bfhi(kv.z) * z); w.w = pk2(bflo(kv.w) * z, bfhi(kv.w) * z);
        *(LAS u32x4*)(lds + L_K + p * 16) = w;
    }
    BLOCK_SYNC();
    const int ne = wave;
    f32x4 acc[4];
#pragma unroll
    for (int nd = 0; nd < 4; ++nd) acc[nd] = (f32x4){0.f, 0.f, 0.f, 0.f};
#pragma unroll
    for (int ks = 0; ks < 4; ++ks) {
        const int r0 = 32 * ks + 4 * fq + (fr >> 2);
        const bf16x8 vf = tr_frag(lds + L_V + tr256_off(r0, 16 * ne) + 8 * (fr & 3), lds + L_V + tr256_off(r0 + 16, 16 * ne) + 8 * (fr & 3));
#pragma unroll
        for (int nd = 0; nd < 4; ++nd) {
            const bf16x8 kf = tr_frag(lds + L_K + tr128_off(r0, 16 * nd) + 8 * (fr & 3), lds + L_K + tr128_off(r0 + 16, 16 * nd) + 8 * (fr & 3));
            acc[nd] = __builtin_amdgcn_mfma_f32_16x16x32_bf16(kf, vf, acc[nd], 0, 0, 0);
        }
    }
    float* dst = KVT + (size_t)ku * 8192 + (16 * ne + fr) * 64 + 4 * fq;
#pragma unroll
    for (int nd = 0; nd < 4; ++nd) *(f32x4*)(dst + 16 * nd) = acc[nd];
    BLOCK_SYNC();
}

__device__ __forceinline__ void phase_scan(const Frame& F) {
    const float* KVT = (const float*)(F.ws + WS_KVT);
    bf16* ST = (bf16*)(F.ws + WS_STATE);
    for (int gid = F.vcu * 512 + F.tid; gid < 65536; gid += F.G * 512) {
        const int b = gid >> 15, h = (gid >> 13) & 3, ed = gid & 8191;
        const float cd = exp2f(128.0f * ret_log2gamma(h));
        float s = 0.f;
        const size_t base = (size_t)b * 64 * 4 * 8192 + (size_t)h * 8192 + ed;
#pragma unroll 8
        for (int n = 0; n < 64; ++n) {
            const size_t idx = base + (size_t)n * 4 * 8192;
            const float kv = KVT[idx];
            ST[idx] = (bf16)(pk2(s, 0.f) & 0xffffu);
            s = s * cd + kv;
        }
    }
}

__device__ __forceinline__ void ret_unit(const Frame& F, int ku) {
    LAS unsigned char* lds = F.lds;
    const bf16* PROJ = (const bf16*)(F.ws + WS_PROJ);
    const bf16* ST = (const bf16*)(F.ws + WS_STATE);
    bf16* MIXIN = (bf16*)(F.ws + WS_MIXIN);
    const int tid = F.tid, lane = F.lane, w = F.wave, fr = lane & 15, fq = lane >> 4;
    const int b = ku >> 8, n = (ku >> 2) & 63, h = ku & 3;
    const int tok0 = b * SEQ + n * 128;
    constexpr int L_K = 0, L_V = 16384;
    const float l2g = ret_log2gamma(h);
    stage_v256(F, PROJ, tok0, h, L_V);
#pragma unroll
    for (int i = 0; i < 2; ++i) {
        const int p = tid + 512 * i, row = p >> 3, pc = p & 7;
        const int lck = pc ^ (row & 7);
        __builtin_amdgcn_global_load_lds((const unsigned*)(PROJ + (size_t)(tok0 + row) * INW + 256 + h * 64 + lck * 8), (LAS unsigned*)(lds + L_K + w * 1024 + i * 8192), 16, 0, 0);
    }
    const int i_row = 16 * w + fr;
    const size_t tok = (size_t)tok0 + i_row;
    bf16x8 qf[2];
#pragma unroll
    for (int kk = 0; kk < 2; ++kk) qf[kk] = *(const bf16x8*)(PROJ + tok * INW + h * 64 + kk * 32 + fq * 8);
    f32x4 o[8];
#pragma unroll
    for (int ne = 0; ne < 8; ++ne) o[ne] = (f32x4){0.f, 0.f, 0.f, 0.f};
    const bf16* stb = ST + (size_t)ku * 8192;
#pragma unroll
    for (int ne = 0; ne < 8; ++ne)
#pragma unroll
        for (int kk = 0; kk < 2; ++kk) {
            const bf16x8 sf = *(const bf16x8*)(stb + (16 * ne + fr) * 64 + kk * 32 + fq * 8);
            o[ne] = __builtin_amdgcn_mfma_f32_16x16x32_bf16(sf, qf[kk], o[ne], 0, 0, 0);
        }
    const float xi = exp2f((float)(i_row + 1) * l2g);
#pragma unroll
    for (int ne = 0; ne < 8; ++ne) o[ne] = o[ne] * xi;
    BLOCK_SYNC();
    f32x4 s[8];
#pragma unroll
    for (int nj = 0; nj < 8; ++nj) {
        s[nj] = (f32x4){0.f, 0.f, 0.f, 0.f};
        if (nj <= w) {
#pragma unroll
            for (int kk = 0; kk < 2; ++kk) {
                const bf16x8 kf = *(LAS const bf16x8*)(lds + L_K + (16 * nj + fr) * 128 + (((kk * 4 + fq) ^ (fr & 7)) << 4));
                s[nj] = __builtin_amdgcn_mfma_f32_16x16x32_bf16(kf, qf[kk], s[nj], 0, 0, 0);
            }
#pragma unroll
            for (int j = 0; j < 4; ++j) {
                const int jj = 16 * nj + 4 * fq + j;
                const int diff = i_row - jj;
                s[nj][j] = diff >= 0 ? s[nj][j] * exp2f((float)diff * l2g) : 0.f;
            }
        }
    }
#pragma unroll
    for (int ks = 0; ks < 4; ++ks) {
        if (2 * ks <= w) {
            const bf16x8 pf = pack_p(s[2 * ks], s[2 * ks + 1]);
            const int r0 = 32 * ks + 4 * fq + (fr >> 2);
#pragma unroll
            for (int ne = 0; ne < 8; ++ne) {
                const bf16x8 vf = tr_frag(lds + L_V + tr256_off(r0, 16 * ne) + 8 * (fr & 3), lds + L_V + tr256_off(r0 + 16, 16 * ne) + 8 * (fr & 3));
                o[ne] = __builtin_amdgcn_mfma_f32_16x16x32_bf16(vf, pf, o[ne], 0, 0, 0);
            }
        }
    }
    float sm = 0.f;
#pragma unroll
    for (int ne = 0; ne < 8; ++ne) sm += (o[ne].x + o[ne].y) + (o[ne].z + o[ne].w);
    sm += __shfl_xor(sm, 16); sm += __shfl_xor(sm, 32);
    const float mean = sm * (1.f / 128.f);
    float sq = 0.f;
#pragma unroll
    for (int ne = 0; ne < 8; ++ne) { o[ne] = o[ne] - mean; sq += (o[ne].x * o[ne].x + o[ne].y * o[ne].y) + (o[ne].z * o[ne].z + o[ne].w * o[ne].w); }
    sq += __shfl_xor(sq, 16); sq += __shfl_xor(sq, 32);
    const float rstd = 1.0f / sqrtf(sq * (1.f / 128.f) + 1e-6f);
    const bf16* grow = PROJ + tok * INW + 1024 + h * 128 + 4 * fq;
    bf16* orow = MIXIN + tok * DM + h * 128 + 4 * fq;
#pragma unroll
    for (int ne = 0; ne < 8; ++ne) {
        const u32x2 gg = *(const u32x2*)(grow + 16 * ne);
        const float g0 = bflo(gg.x), g1 = bfhi(gg.x), g2 = bflo(gg.y), g3 = bfhi(gg.y);
        const f32x4 v = o[ne] * rstd;
        const float y0 = v.x * g0 / (1.f + __expf(-g0)), y1 = v.y * g1 / (1.f + __expf(-g1)), y2 = v.z * g2 / (1.f + __expf(-g2)), y3 = v.w * g3 / (1.f + __expf(-g3));
        u32x2 wv; wv.x = pk2(y0, y1); wv.y = pk2(y2, y3);
        *(u32x2*)(orow + 16 * ne) = wv;
    }
    BLOCK_SYNC();
}

struct SchedP5 { int vcu, G; __device__ __forceinline__ bool next(int i, pg8::Unit& u) const { const int L = vcu + i * G; if (L >= 256) return false; u.pm = L >> 2; u.pn = L & 3; return true; } };
struct EpiP5 {
    const bf16* H0B; bf16* PRE1;
    __device__ __forceinline__ void operator()(const f32x4 (&acc)[2][2][4][2], const pg8::Unit& u, int wr, int wc, int fr, int fq) const {
#pragma unroll
        for (int ai = 0; ai < 2; ++ai)
#pragma unroll
            for (int m = 0; m < 4; ++m) {
                const size_t row = (size_t)(u.pm * 256 + ai * 128 + wr * 64 + m * 16 + fr);
#pragma unroll
                for (int bj = 0; bj < 2; ++bj)
#pragma unroll
                    for (int n = 0; n < 2; ++n) {
                        const size_t off = row * DM + u.pn * 256 + bj * 128 + wc * 32 + 16 * n + 4 * fq;
                        const u32x2 hh = *(const u32x2*)(H0B + off);
                        f32x4 v = acc[ai][bj][m][n];
                        v.x += ALPHA * bflo(hh.x); v.y += ALPHA * bfhi(hh.x); v.z += ALPHA * bflo(hh.y); v.w += ALPHA * bfhi(hh.y);
                        u32x2 pw; pw.x = pk2(v.x, v.y); pw.y = pk2(v.z, v.w);
                        *(u32x2*)(PRE1 + off) = pw;
                    }
                asm volatile("" ::: "memory");
            }
    }
};
__device__ __forceinline__ void phase_outproj(const Frame& F) {
    const pg8::Gemm g{(const bf16*)(F.ws + WS_MIXIN), (const bf16*)(F.ws + WS_WT_OUT), DM};
    const SchedP5 S{F.vcu, F.G};
    const EpiP5 E{(const bf16*)(F.ws + WS_H0B), (bf16*)(F.ws + WS_PRE1)};
    pg8::gemm_phase<EpiP5, SchedP5>(F.lds, g, S, E);
}

__device__ __forceinline__ unsigned fkey(float f) { const unsigned u = __float_as_uint(f); return u ^ ((u >> 31) ? 0xffffffffu : 0x80000000u); }
__device__ __forceinline__ int lanes_below(unsigned long long m) { return (int)__builtin_amdgcn_mbcnt_hi((unsigned)(m >> 32), __builtin_amdgcn_mbcnt_lo((unsigned)m, 0u)); }
__device__ __forceinline__ void phase_router(const Frame& F, const float* g, const float* bb, const float* w_router, const float* rbias) {
    LAS unsigned char* lds = F.lds;
    const bf16* PRE1 = (const bf16*)(F.ws + WS_PRE1);
    bf16* H1B = (bf16*)(F.ws + WS_H1B);
    unsigned* gcnt = (unsigned*)(F.ws + WS_CTL) + CW_CNT;
    u32x2* LIST2 = (u32x2*)(F.ws + WS_LIST2);
    const int tid = F.tid, lane = F.lane, wave = F.wave, wr = wave >> 2, wc = wave & 3, fr = lane & 15, fq = lane >> 4;
    LAS float* selw = (LAS float*)(lds + L_TAB + TB_SELW);
    LAS int* hist = (LAS int*)(lds + L_TAB + TB_HIST);
    LAS int* basee = (LAS int*)(lds + L_TAB + TB_BASE);
    LAS int* sel = (LAS int*)(lds + L_TAB + TB_SEL);
    for (int mt = F.vcu; mt < 256; mt += F.G) {
        const int row0 = mt * 64;
        asm volatile("" ::: "memory");
        {
            f32x4 gv[4], bv[4];
#pragma unroll
            for (int c = 0; c < 4; ++c) { gv[c] = *(const f32x4*)(g + 4 * lane + 256 * c); bv[c] = *(const f32x4*)(bb + 4 * lane + 256 * c); }
#pragma unroll 1
            for (int batch = 0; batch < 2; ++batch) {
                f32x4 v[4][4];
#pragma unroll
                for (int r = 0; r < 4; ++r)
#pragma unroll
                    for (int c = 0; c < 4; ++c) { const u32x2 pw = *(const u32x2*)(PRE1 + (size_t)(row0 + wave * 8 + batch * 4 + r) * DM + 4 * lane + 256 * c); v[r][c] = (f32x4){bflo(pw.x), bfhi(pw.x), bflo(pw.y), bfhi(pw.y)}; }
#pragma unroll
                for (int r = 0; r < 4; ++r) {
                    float s = 0.f;
#pragma unroll
                    for (int c = 0; c < 4; ++c) s += (v[r][c].x + v[r][c].y) + (v[r][c].z + v[r][c].w);
                    const float mean = wave_sum(s) * (1.f / DM); float s2 = 0.f;
#pragma unroll
                    for (int c = 0; c < 4; ++c) { v[r][c] = v[r][c] - mean; s2 += (v[r][c].x * v[r][c].x + v[r][c].y * v[r][c].y) + (v[r][c].z * v[r][c].z + v[r][c].w * v[r][c].w); }
                    const float rstd = 1.f / sqrtf(wave_sum(s2) * (1.f / DM) + 1e-5f);
                    bf16* orow = H1B + (size_t)(row0 + wave * 8 + batch * 4 + r) * DM + 4 * lane;
#pragma unroll
                    for (int c = 0; c < 4; ++c) {
                        const f32x4 y = v[r][c] * rstd * gv[c] + bv[c];
                        u32x2 wv; wv.x = pk2(y.x, y.y); wv.y = pk2(y.z, y.w);
                        *(u32x2*)(orow + 256 * c) = wv;
                    }
                }
            }
        }
        if (tid < 256) hist[tid] = 0;
        BLOCK_SYNC();
        asm volatile("" ::: "memory");
        unsigned aoff[2]; ring_aoff(aoff, tid, DM);
        f32x4 acc[2][4]; zero_accT<2>(acc);
        gemm_ring<2>(acc, F, H1B + (size_t)row0 * DM, aoff, (const bf16*)(F.ws + WS_WIMG) + (size_t)WIMG_RT * 16384, DM / 32);
        LAS float* sc = (LAS float*)lds;
#pragma unroll
        for (int m = 0; m < 2; ++m) {
            const int row = wr * 32 + m * 16 + fr;
#pragma unroll
            for (int n = 0; n < 4; ++n) {
                f32x4 v = acc[m][n];
                v.x = 1.f / (1.f + __expf(-v.x)); v.y = 1.f / (1.f + __expf(-v.y)); v.z = 1.f / (1.f + __expf(-v.z)); v.w = 1.f / (1.f + __expf(-v.w));
                *(LAS f32x4*)(sc + row * 260 + wc * 64 + n * 16 + 4 * fq) = v;
            }
        }
        BLOCK_SYNC();
        asm volatile("" ::: "memory");
        const f32x4 rb = *(const f32x4*)(rbias + 4 * lane);
        const int grp = lane >> 3;
#pragma unroll 1
        for (int r = 0; r < 8; ++r) {
            const int rl = wave * 8 + r;
            const f32x4 v = *(LAS const f32x4*)(sc + rl * 260 + 4 * lane);
            const f32x4 ch = v + rb;
            float a1 = fmaxf(ch.x, ch.y), a2 = fminf(ch.x, ch.y);
            { const float b1 = fmaxf(ch.z, ch.w), b2 = fminf(ch.z, ch.w); const float n1 = fmaxf(a1, b1), n2 = fmaxf(fminf(a1, b1), fmaxf(a2, b2)); a1 = n1; a2 = n2; }
#pragma unroll
            for (int o = 1; o < 8; o <<= 1) {
                const float b1 = __shfl_xor(a1, o), b2 = __shfl_xor(a2, o);
                const float n1 = fmaxf(a1, b1), n2 = fmaxf(fminf(a1, b1), fmaxf(a2, b2));
                a1 = n1; a2 = n2;
            }
            const float gsum = a1 + a2;
            int rank = 0;
#pragma unroll
            for (int j = 0; j < 8; ++j) { const float sj = __shfl(gsum, 8 * j); rank += (sj > gsum || (sj == gsum && j < grp)) ? 1 : 0; }
            const bool gsel = rank < 4;
            unsigned key[4];
            key[0] = gsel ? fkey(ch.x) : 0u; key[1] = gsel ? fkey(ch.y) : 0u; key[2] = gsel ? fkey(ch.z) : 0u; key[3] = gsel ? fkey(ch.w) : 0u;
            unsigned tau = 0u;
#pragma unroll 1
            for (int bit = 31; bit >= 0; --bit) {
                const unsigned cand = tau | (1u << bit);
                const int cnt = __popcll(__ballot(key[0] >= cand)) + __popcll(__ballot(key[1] >= cand)) + __popcll(__ballot(key[2] >= cand)) + __popcll(__ballot(key[3] >= cand));
                if (cnt >= 8) tau = cand;
            }
            unsigned long long gm[4], em[4];
            int ngt = 0;
#pragma unroll
            for (int j = 0; j < 4; ++j) { gm[j] = __ballot(key[j] > tau); em[j] = __ballot(key[j] == tau); ngt += __popcll(gm[j]); }
            const int need = 8 - ngt;
            int eqb = lanes_below(em[0]) + lanes_below(em[1]) + lanes_below(em[2]) + lanes_below(em[3]);
            bool s[4];
#pragma unroll
            for (int j = 0; j < 4; ++j) { const bool eq = key[j] == tau; s[j] = (key[j] > tau) || (eq && eqb < need); eqb += eq ? 1 : 0; }
            unsigned long long sm[4];
#pragma unroll
            for (int j = 0; j < 4; ++j) sm[j] = __ballot(s[j]);
            int kpos = lanes_below(sm[0]) + lanes_below(sm[1]) + lanes_below(sm[2]) + lanes_below(sm[3]);
            const float wl = (s[0] ? v.x : 0.f) + (s[1] ? v.y : 0.f) + (s[2] ? v.z : 0.f) + (s[3] ? v.w : 0.f);
            const float wscale = 2.5f / wave_sum(wl);
#pragma unroll
            for (int j = 0; j < 4; ++j) {
                if (s[j]) {
                    selw[rl * 8 + kpos] = v[j] * wscale;
                    const int e = 4 * lane + j;
                    const int lpos = __hip_atomic_fetch_add(hist + e, 1, __ATOMIC_RELAXED, __HIP_MEMORY_SCOPE_WORKGROUP);
                    sel[rl * 8 + kpos] = (e << 16) | lpos;
                    ++kpos;
                }
            }
        }
        BLOCK_SYNC();
        if (tid < 256) { const int c = hist[tid]; basee[tid] = c > 0 ? (int)__hip_atomic_fetch_add(gcnt + tid, (unsigned)c, __ATOMIC_RELAXED, __HIP_MEMORY_SCOPE_AGENT) : 0; }
        BLOCK_SYNC();
        {
            const int sv = sel[tid], e = sv >> 16, lpos = sv & 0xffff;
            u32x2 ent; ent.x = (unsigned)(mt * 512 + tid); ent.y = __float_as_uint(selw[tid]);
            LIST2[(size_t)e * LCAP + basee[e] + lpos] = ent;
        }
        BLOCK_SYNC();
    }
}

__device__ __forceinline__ void phase_moe(const Frame& F, const float* w_gate, const float* w_up, const float* w_down, const float* ws_gate, const float* ws_up, const float* ws_down) {
    LAS unsigned char* lds = F.lds;
    const bf16* H1B = (const bf16*)(F.ws + WS_H1B);
    const unsigned* gcnt = (const unsigned*)(F.ws + WS_CTL) + CW_CNT;
    const u32x2* LIST2 = (const u32x2*)(F.ws + WS_LIST2);
    bf16* YROWS = (bf16*)(F.ws + WS_YROWS);
    const int tid = F.tid, lane = F.lane, wave = F.wave, wr = wave >> 2, wc = wave & 3, fr = lane & 15, fq = lane >> 4;
    const int lchunk = (tid & 7) ^ ((tid >> 3) & 7);
    LAS int* prefix = (LAS int*)(lds + L_TAB + TB_PREFIX);
    LAS int* rtok = (LAS int*)(lds + L_TAB + TB_RTOK);
    LAS int* ryrow = (LAS int*)(lds + L_TAB + TB_RYROW);
    LAS float* rw = (LAS float*)(lds + L_TAB + TB_RW);
    LAS int* cntl = (LAS int*)(lds + L_TAB + TB_CNT);
    if (tid < 256) cntl[tid] = (int)gcnt[tid];
    if (wave == 0) {
        int c4[4], loc = 0;
#pragma unroll
        for (int j = 0; j < 4; ++j) { c4[j] = ((int)gcnt[lane * 4 + j] + 127) >> 7; loc += c4[j]; }
        int incl = loc;
#pragma unroll
        for (int o = 1; o < 64; o <<= 1) { const int t = __shfl_up(incl, o); if (lane >= o) incl += t; }
        int run = incl - loc;
#pragma unroll
        for (int j = 0; j < 4; ++j) { prefix[lane * 4 + j] = run; run += c4[j]; }
        if (lane == 63) prefix[256] = run;
    }
    BLOCK_SYNC();
    const int R = prefix[256];
    const int nr = (R > F.vcu) ? (R - F.vcu + F.G - 1) / F.G : 0;
    const int base = R % F.G, L = F.G - base;
    const bool lightonly = L >= 64;
    const int sd = (F.vcu - base + F.G) % F.G;
    const int ns = lightonly ? ((sd < L && sd < 128) ? (128 - sd + L - 1) / L : 0) : ((sd < 128) ? 1 : 0);
    const int sstep = lightonly ? L : F.G;
#define MOE_ITEM(it_, e_, tile_) do { if ((it_) >= nr) { e_ = 256; tile_ = sd + ((it_) - nr) * sstep; } else { const int u_ = F.vcu + (it_) * F.G; int lo_ = 0, hi_ = 255; \
        while (lo_ < hi_) { const int mid_ = (lo_ + hi_ + 1) >> 1; if (prefix[mid_] <= u_) lo_ = mid_; else hi_ = mid_ - 1; } e_ = lo_; tile_ = u_ - prefix[lo_]; } } while (0)
#define MOE_FETCH(e_, tile_, tok_, yr_, wv_) do { tok_ = 0; yr_ = -1; wv_ = 0.f; const int ft_ = F.wave * 64 + fresh_lane(); if (ft_ < 128) { const int idx_ = (tile_) * 128 + ft_; \
        if ((e_) == 256) { tok_ = idx_; yr_ = idx_ * 9 + 8; wv_ = 1.0f; } \
        else if (idx_ < cntl[e_]) { const u32x2 en_ = LIST2[(size_t)(e_) * LCAP + idx_]; tok_ = (int)(en_.x >> 3); yr_ = tok_ * 9 + (int)(en_.x & 7u); wv_ = __uint_as_float(en_.y); } } } while (0)
    int ptok = 0, pyr = -1; float pwv = 0.f;
    if (nr + ns > 0) { int e0, t0; MOE_ITEM(0, e0, t0); MOE_FETCH(e0, t0, ptok, pyr, pwv); }
    for (int it = 0; it < nr + ns; ++it) {
        int e, tile;
        MOE_ITEM(it, e, tile);
        const int otid = F.wave * 64 + fresh_lane();
        Frame F2 = F; F2.tid = otid; F2.lane = otid & 63;
        const int lane = F2.lane, fr = lane & 15, fq = lane >> 4;
        const int lchunk = (otid & 7) ^ ((otid >> 3) & 7);
        if (otid < 128) { rtok[otid] = ptok; ryrow[otid] = pyr; rw[otid] = pwv; }
        BLOCK_SYNC();
        const float* Wg = (e == 256) ? ws_gate : w_gate + (size_t)e * 262144;
        const float* Wu = (e == 256) ? ws_up : w_up + (size_t)e * 262144;
        const float* Wd = (e == 256) ? ws_down : w_down + (size_t)e * 262144;
        const unsigned ao0 = (unsigned)rtok[otid >> 3] * (unsigned)(DM * 2) + (unsigned)lchunk * 16u, ao1 = (unsigned)rtok[(otid >> 3) + 64] * (unsigned)(DM * 2) + (unsigned)lchunk * 16u;
        const int rot = tile & 3;
#define MOE_EPI1(C0) do { const int ol_ = fresh_lane(); const int efr = ol_ & 15, efq = ol_ >> 4; \
            _Pragma("unroll") for (int m = 0; m < 4; ++m) { const int row = wr * 64 + m * 16 + efr; \
                _Pragma("unroll") for (int n = 0; n < 2; ++n) { const f32x4 gt = acc[m][n], up = acc[m][n + 2]; \
                    const float a0 = gt.x / (1.f + __expf(-gt.x)) * up.x, a1 = gt.y / (1.f + __expf(-gt.y)) * up.y, a2 = gt.z / (1.f + __expf(-gt.z)) * up.z, a3 = gt.w / (1.f + __expf(-gt.w)) * up.w; \
                    const int col = (C0) + 32 * wc + 16 * n + 4 * efq, kt = col >> 6, c64 = col & 63; \
                    u32x2 wv; wv.x = pk2(a0, a1); wv.y = pk2(a2, a3); \
                    *(LAS u32x2*)(lds + a_tile_off<true>(kt) + row * 128 + (((c64 >> 3) ^ (row & 7)) << 4) + (c64 & 7) * 2) = wv; } } } while (0)
#define MOE_EPI2(NC) do { const int ol_ = fresh_lane(); const int efr = ol_ & 15, efq = ol_ >> 4; \
            _Pragma("unroll") for (int m = 0; m < 4; ++m) { const int row = wr * 64 + m * 16 + efr; const int yr = ryrow[row]; const float wv = rw[row]; \
                if (yr >= 0) { bf16* dst = YROWS + (size_t)yr * DM + (NC) * 256 + wc * 64 + 16 * efq; u32x4 w0, w1; \
                    w0.x = pk2(acc[m][0].x * wv, acc[m][0].y * wv); w0.y = pk2(acc[m][0].z * wv, acc[m][0].w * wv); \
                    w0.z = pk2(acc[m][1].x * wv, acc[m][1].y * wv); w0.w = pk2(acc[m][1].z * wv, acc[m][1].w * wv); \
                    w1.x = pk2(acc[m][2].x * wv, acc[m][2].y * wv); w1.y = pk2(acc[m][2].z * wv, acc[m][2].w * wv); \
                    w1.z = pk2(acc[m][3].x * wv, acc[m][3].y * wv); w1.w = pk2(acc[m][3].z * wv, acc[m][3].w * wv); \
                    *(u32x4*)dst = w0; *(u32x4*)(dst + 8) = w1; } } } while (0)
#define MOE_UNIT(LT) do { \
            f32x4 r0[8], r1[8]; \
            const int s = 4 * lane, sl = s & 63; \
            const float* bpA = ((s & 32) ? Wu : Wg) + 32 * (s >> 6) + (s & 31); \
            const float* bpD = Wd + (s & 192) + 16 * ((sl >> 2) & 3) + 4 * (sl >> 4) + (sl & 3); \
            f32x4 acc[4][4]; zero_acc(acc); \
            gemm_chain<false, DM / 64, 256, LT, false, 256, DM / 64>(acc, F2, r0, r1, (const char*)H1B, ao0, ao1, bpA, bpA + 128, rot, 0); \
            MOE_EPI1(0); \
            zero_acc(acc); \
            gemm_chain<false, DM / 64, 256, LT, true, DM, 4>(acc, F2, r0, r1, (const char*)H1B, ao0, ao1, bpA + 128, bpD, rot, 1); \
            MOE_EPI1(128); \
            BLOCK_SYNC(); \
            if (it + 1 < nr + ns) { int e1, t1; MOE_ITEM(it + 1, e1, t1); MOE_FETCH(e1, t1, ptok, pyr, pwv); }       \
            zero_acc(acc); \
            gemm_chain<true, 4, DM, LT, true, DM, 4>(acc, F2, r0, r1, nullptr, 0u, 0u, bpD, bpD + 256, rot, 0); \
            MOE_EPI2(0); \
            zero_acc(acc); \
            gemm_chain<true, 4, DM, LT, true, DM, 4>(acc, F2, r0, r1, nullptr, 0u, 0u, bpD + 256, bpD + 512, rot, 0); \
            MOE_EPI2(1); \
            zero_acc(acc); \
            gemm_chain<true, 4, DM, LT, true, DM, 4>(acc, F2, r0, r1, nullptr, 0u, 0u, bpD + 512, bpD + 768, rot, 0); \
            MOE_EPI2(2); \
            zero_acc(acc); \
            gemm_chain<true, 4, DM, LT, true, 0, 4>(acc, F2, r0, r1, nullptr, 0u, 0u, bpD + 768, bpD + 768, rot, 0); \
            MOE_EPI2(3); } while (0)
        if (wave >= 4) MOE_UNIT(true); else MOE_UNIT(false);
#undef MOE_UNIT
#undef MOE_EPI1
#undef MOE_EPI2
        BLOCK_SYNC();
    }
}

__device__ __forceinline__ void phase_final(const Frame& F, const float* g, const float* b, float* out) {
    const bf16* H1B = (const bf16*)(F.ws + WS_H1B);
    const bf16* YROWS = (const bf16*)(F.ws + WS_YROWS);
    const int gw = F.vcu * 8 + F.wave, NGW = F.G * 8, lane = F.lane;
    f32x4 gv[4], bv[4];
#pragma unroll
    for (int c = 0; c < 2; ++c)
#pragma unroll
        for (int hh = 0; hh < 2; ++hh) { gv[2 * c + hh] = *(const f32x4*)(g + 8 * lane + 512 * c + 4 * hh); bv[2 * c + hh] = *(const f32x4*)(b + 8 * lane + 512 * c + 4 * hh); }
    for (int row = gw; row < T_TOK; row += NGW) {
        float v[16];
#pragma unroll
        for (int c = 0; c < 2; ++c) {
            const u32x4 hv = *(const u32x4*)(H1B + (size_t)row * DM + 8 * lane + 512 * c);
            v[8 * c + 0] = ALPHA * bflo(hv.x); v[8 * c + 1] = ALPHA * bfhi(hv.x); v[8 * c + 2] = ALPHA * bflo(hv.y); v[8 * c + 3] = ALPHA * bfhi(hv.y);
            v[8 * c + 4] = ALPHA * bflo(hv.z); v[8 * c + 5] = ALPHA * bfhi(hv.z); v[8 * c + 6] = ALPHA * bflo(hv.w); v[8 * c + 7] = ALPHA * bfhi(hv.w);
#pragma unroll
            for (int sidx = 0; sidx < 9; ++sidx) {
                const u32x4 yv = *(const u32x4*)(YROWS + ((size_t)row * 9 + sidx) * DM + 8 * lane + 512 * c);
                v[8 * c + 0] += bflo(yv.x); v[8 * c + 1] += bfhi(yv.x); v[8 * c + 2] += bflo(yv.y); v[8 * c + 3] += bfhi(yv.y);
                v[8 * c + 4] += bflo(yv.z); v[8 * c + 5] += bfhi(yv.z); v[8 * c + 6] += bflo(yv.w); v[8 * c + 7] += bfhi(yv.w);
            }
        }
        float s = 0.f;
#pragma unroll
        for (int i = 0; i < 16; ++i) s += v[i];
        const float mean = wave_sum(s) * (1.f / DM); float s2 = 0.f;
#pragma unroll
        for (int i = 0; i < 16; ++i) { v[i] -= mean; s2 += v[i] * v[i]; }
        const float rstd = 1.f / sqrtf(wave_sum(s2) * (1.f / DM) + 1e-5f);
        float* orow = out + (size_t)row * DM + 8 * lane;
#pragma unroll
        for (int c = 0; c < 2; ++c)
#pragma unroll
            for (int hh = 0; hh < 2; ++hh) {
                f32x4 y;
                y.x = v[8 * c + 4 * hh + 0] * rstd; y.y = v[8 * c + 4 * hh + 1] * rstd; y.z = v[8 * c + 4 * hh + 2] * rstd; y.w = v[8 * c + 4 * hh + 3] * rstd;
                y = y * gv[2 * c + hh] + bv[2 * c + hh];
                *(f32x4*)(orow + 512 * c + 4 * hh) = y;
            }
    }
}

__global__ void __launch_bounds__(512, 2) fwd_kernel(Args a) {
    extern __shared__ __attribute__((aligned(16))) unsigned char lds_raw[];
    Frame F;
    F.lds = (LAS unsigned char*)lds_raw;
    F.tid = threadIdx.x; F.lane = F.tid & 63; F.wave = __builtin_amdgcn_readfirstlane(F.tid >> 6);
    F.G = gridDim.x; { const int bx = blockIdx.x; F.vcu = (F.G % 8 == 0) ? (bx % 8) * (F.G / 8) + bx / 8 : bx; }
    F.ws = a.ws;
    volatile LAS unsigned* MISC = (volatile LAS unsigned*)(F.lds + L_TAB + TB_MISC);
    if (F.tid < 16) MISC[F.tid] = 0u;
    __syncthreads();
    unsigned* ctl = (unsigned*)(a.ws + WS_CTL);
    const int lo = a.ph_lo, hi = a.ph_hi;
    XcdBarrier bar; bar.bar = ctl + CW_BAR; bar.x = 0; bar.st = MISC + 8; bar.w0 = 0;
    if (hi - lo > 1) bar = xcd_barrier_post(ctl + CW_BAR, MISC + 8);
    bar.w0 = (F.wave == 0) ? 1 : 0;
#define IN(k) (lo <= (k) && (k) < hi)
#define SEAM(k) do { if (IN(k) && IN((k) + 1)) xcd_barrier(bar); } while (0)
#define FRESH(Fn) Frame Fn = F; Fn.lane = fresh_lane(); Fn.tid = F.wave * 64 + Fn.lane
    if (IN(0)) { FRESH(F0); phase0(F0, a.in[0], a.in[1], a.in[2], a.in[3], a.in[4], a.in[9]); }
    SEAM(0);
    if (IN(1)) { FRESH(F1); phase1(F1); }
    SEAM(1);
    if (IN(2)) {
        FRESH(F2);
        for (int su = F.vcu; su < 256; su += F.G) swa_unit(F2, su, a.in[5], a.in[6]);
        for (int ku = F.vcu; ku < 512; ku += F.G) kv_unit(F2, ku);
    }
    SEAM(2);
    if (IN(3)) { FRESH(F3); phase_scan(F3); }
    SEAM(3);
    if (IN(4)) { FRESH(F4); for (int ku = F.vcu; ku < 512; ku += F.G) ret_unit(F4, ku); }
    SEAM(4);
    if (IN(5)) { FRESH(F5); phase_outproj(F5); }
    SEAM(5);
    if (IN(6)) { FRESH(F6); phase_router(F6, a.in[7], a.in[8], a.in[9], a.in[10]); }
    SEAM(6);
    if (IN(7)) { FRESH(F7); phase_moe(F7, a.in[11], a.in[12], a.in[13], a.in[14], a.in[15], a.in[16]); }
    SEAM(7);
    if (IN(8)) { FRESH(F8); phase_final(F8, a.in[17], a.in[18], a.out); }
#undef FRESH
#undef IN
#undef SEAM
}

extern "C" void kernel_launch(void* const* d_in, const int* in_sizes, int n_in, void* d_out, int out_size, void* d_ws, size_t ws_size, hipStream_t stream) {
    static int grid = 0;
    if (grid == 0) {
        if (n_in != 19 || out_size != T_TOK * DM || ws_size < WS_END) { fprintf(stderr, "kernel_launch: unexpected problem shape (n_in %d out %d ws %zu)\n", n_in, out_size, ws_size); grid = -1; return; }
        int dev = 0, cus = 0, per_cu = 0;
        if (hipGetDevice(&dev) != hipSuccess || hipDeviceGetAttribute(&cus, hipDeviceAttributeMultiprocessorCount, dev) != hipSuccess) { grid = -1; return; }
        if (hipFuncSetAttribute((const void*)fwd_kernel, hipFuncAttributeMaxDynamicSharedMemorySize, LDS_BYTES) != hipSuccess) { fprintf(stderr, "kernel_launch: hipFuncSetAttribute failed\n"); grid = -1; return; }
        if (hipOccupancyMaxActiveBlocksPerMultiprocessor(&per_cu, (const void*)fwd_kernel, 512, LDS_BYTES) != hipSuccess || per_cu < 1)
            fprintf(stderr, "kernel_launch: occupancy query reports %d\n", per_cu);
        (void)hipGetLastError();
        grid = cus;
    }
    if (grid < 0) return;
    (void)hipMemsetAsync((char*)d_ws + WS_CTL, 0, CTL_BYTES, stream);
    Args a{};
    for (int i = 0; i < 19; ++i) a.in[i] = (const float*)d_in[i];
    a.out = (float*)d_out; a.ws = (unsigned char*)d_ws;
    if (MK_N_LAUNCHES == 1) {
        a.ph_lo = 0; a.ph_hi = NPHASE;
        hipLaunchKernelGGL(fwd_kernel, dim3(grid), dim3(512), LDS_BYTES, stream, a);
    } else {
        for (int p = 0; p < NPHASE; ++p) {
            a.ph_lo = p; a.ph_hi = p + 1;
            hipLaunchKernelGGL(fwd_kernel, dim3(grid), dim3(512), LDS_BYTES, stream, a);
        }
    }
}
```
